# Optimizing an MI355X kernel written in HIP

```python
import math
import jax, jax.numpy as jnp
from jax import lax
import numpy as np

D_MODEL = 2048
BATCH = 8
SEQ = 2048
DEPTH = 1
DEC_BATCH = 32
DEC_SEQ = 4
PAST_LEN = 8192
PAGE_SIZE = 128

D_FF = 5632
RMS_EPS = 1e-6
RW_HEADS = 16
RW_HEAD_DIM = 64
RW_DIM = RW_HEADS * RW_HEAD_DIM
RW_LORA_W = 64
RW_LORA_A = 64
RW_LORA_G = 128
RW_PROJ = 3 * RW_DIM + RW_LORA_W + RW_LORA_A + RW_LORA_G
RW_LN_EPS = 64e-5
NSA_HEADS = 8
NSA_KV_HEADS = 2
NSA_HPG = NSA_HEADS // NSA_KV_HEADS
NSA_HEAD_DIM = 128
NSA_DIM = NSA_HEADS * NSA_HEAD_DIM
NSA_KV_DIM = NSA_KV_HEADS * NSA_HEAD_DIM
CMP_BLOCK = 32
CMP_HID = 256
SEL_BLOCK = 64
TOP_N = 16
WINDOW = 512
N_BUCKETS = 32
REL_MAX_EXACT = 16
REL_MAX_DIST = 1024
Q_BLOCK = 128
NEG_BIG = -1e30
FORCE_BONUS = 1e4
IN_COLS = RW_PROJ + NSA_DIM + 6 * NSA_KV_DIM + 3 * NSA_HEADS + 2 * D_MODEL

kernel_name = "rwkv7_nsa_parallel_macaron_step"


def rmsnorm(x, g):
    xf = x.astype(jnp.float32)
    y = xf * lax.rsqrt(jnp.mean(xf * xf, axis=-1, keepdims=True) + RMS_EPS)
    return (y * g.astype(jnp.float32)).astype(x.dtype)


def swiglu_half_step(x, pre_g, post_g, w1, w3, w2):
    h = rmsnorm(x, pre_g)
    f = (jax.nn.silu(h @ w1) * (h @ w3)) @ w2
    return x + 0.5 * rmsnorm(f, post_g)


def rel_bucket(dist):
    n = jnp.maximum(dist, 0)
    nf = jnp.maximum(n, 1).astype(jnp.float32)
    large = REL_MAX_EXACT + (jnp.log(nf / REL_MAX_EXACT) / math.log(REL_MAX_DIST / REL_MAX_EXACT)
                             * (N_BUCKETS - REL_MAX_EXACT)).astype(jnp.int32)
    large = jnp.minimum(large, N_BUCKETS - 1)
    return jnp.where(n < REL_MAX_EXACT, n, large)


def masked_softmax(s, mask):
    s = jnp.where(mask, s.astype(jnp.float32), NEG_BIG)
    e = jnp.where(mask, jnp.exp(s - jnp.max(s, axis=-1, keepdims=True)), 0.0)
    return e / jnp.maximum(jnp.sum(e, axis=-1, keepdims=True), 1e-30)


def rwkv7_time_mix(p, prev_row, s0, mu, w0, w2, a0, a2, g2, k_k, k_a, r_k, lnx_w, lnx_b):
    f32 = jnp.float32
    b, t, _ = p.shape
    p_prev = jnp.concatenate([prev_row[:, None].astype(p.dtype), p[:, :-1]], axis=1)
    xs = p + (p_prev - p) * mu
    sp = [RW_DIM, 2 * RW_DIM, 3 * RW_DIM, 3 * RW_DIM + RW_LORA_W, 3 * RW_DIM + RW_LORA_W + RW_LORA_A]
    r, k, v, wd, ad, gd = jnp.split(xs, sp, axis=-1)
    w = -jax.nn.softplus(-(w0 + jnp.tanh(wd) @ w2).astype(f32)) - 0.5
    decay = jnp.exp(-jnp.exp(w))
    a = jax.nn.sigmoid((a0 + ad @ a2).astype(f32))
    g = jax.nn.sigmoid(gd) @ g2
    k_mod = k.astype(f32) * (1.0 + (a - 1.0) * k_a)

    def heads(z):
        return z.astype(f32).reshape(b, t, RW_HEADS, RW_HEAD_DIM)

    kk = heads(k * k_k)
    kk = kk / jnp.maximum(jnp.sqrt(jnp.sum(kk * kk, axis=-1, keepdims=True)), 1e-12)
    r_h, k_h, v_h, w_h, a_h = heads(r), heads(k_mod), heads(v), heads(decay), heads(a)

    def step(S, inp):
        r_t, k_t, v_t, w_t, kk_t, a_t = inp
        sk = jnp.einsum('bhij,bhj->bhi', S, kk_t)
        S = (S * w_t[:, :, None, :] - sk[..., None] * (kk_t * a_t)[:, :, None, :]
             + v_t[..., None] * k_t[:, :, None, :])
        return S, jnp.einsum('bhij,bhj->bhi', S, r_t)

    seq_first = [jnp.moveaxis(z, 1, 0) for z in (r_h, k_h, v_h, w_h, kk, a_h)]
    s_fin, y = lax.scan(step, s0.astype(f32), tuple(seq_first))
    y = jnp.moveaxis(y, 0, 1)
    mean = jnp.mean(y, axis=-1, keepdims=True)
    var = jnp.mean(jnp.square(y - mean), axis=-1, keepdims=True)
    y = ((y - mean) * lax.rsqrt(var + RW_LN_EPS)).reshape(b, t, RW_DIM) * lnx_w + lnx_b
    bonus = jnp.sum(r_h * k_h * r_k, axis=-1, keepdims=True) * v_h
    y = (y + bonus.reshape(b, t, RW_DIM)) * g
    return y.astype(p.dtype), s_fin, p[:, -1]


def nsa_attention(q, gates, kv_all, win_all, q_off, k_off, rel_bias, cmp_pe, cmp_w1, cmp_w2):
    f32 = jnp.float32
    G, HPG, hd = NSA_KV_HEADS, NSA_HPG, NSA_HEAD_DIM
    b, t = q.shape[:2]
    L0 = kv_all.shape[1]
    L = -(-L0 // SEL_BLOCK) * SEL_BLOCK
    kv_all = jnp.pad(kv_all, ((0, 0), (0, L - L0), (0, 0), (0, 0), (0, 0)))
    n_cmp, n_sel = L // CMP_BLOCK, L // SEL_BLOCK
    top_n = min(TOP_N, n_sel)
    blocks = kv_all[:, :, :2].reshape(b, n_cmp, CMP_BLOCK, 2, G, hd) + cmp_pe[:, :, None, :]
    flat = blocks.transpose(0, 1, 3, 4, 2, 5).reshape(b, n_cmp, 2, G, CMP_BLOCK * hd)
    hid = jax.nn.gelu(jnp.einsum('bnkgf,kfc->bnkgc', flat, cmp_w1))
    kc = jnp.einsum('bnkgc,kcd->bnkgd', hid, cmp_w2)
    sel = kv_all[:, :, 2:].reshape(b, n_sel, SEL_BLOCK, 2, G, hd)
    win_pad = jnp.pad(win_all, ((0, 0), (WINDOW, 0), (0, 0), (0, 0), (0, 0)))
    qb = math.gcd(t, Q_BLOCK)
    nqb = t // qb
    q_blocks = q.reshape(b, nqb, qb, G, HPG, hd)
    g_blocks = jax.nn.sigmoid(gates.astype(f32)).reshape(b, nqb, qb, 3, G, HPG)
    scale = NSA_HEAD_DIM ** -0.5
    bias_g = rel_bias.reshape(N_BUCKETS, G, HPG).transpose(1, 0, 2)
    cmp_end = jnp.arange(n_cmp) * CMP_BLOCK + CMP_BLOCK - 1
    sel_ids = jnp.arange(n_sel)
    band = WINDOW + qb
    base = q_off - k_off

    def per_block(kc_b, sel_b, win_b, q_i, g_i, i):
        dt = q_i.dtype
        pos = q_off + i * qb + jnp.arange(qb)
        d_c = pos[:, None] - cmp_end[None, :]
        bias_c = jax.vmap(lambda tb: tb[rel_bucket(d_c)])(bias_g)
        s_c = jnp.einsum('qghd,ngd->ghqn', q_i, kc_b[:, 0]).astype(f32) * scale + bias_c.transpose(0, 3, 1, 2)
        p_c = masked_softmax(s_c, (d_c >= 0)[None, None])
        o_c = jnp.einsum('ghqn,ngd->qghd', p_c.astype(dt), kc_b[:, 1])
        imp = p_c.sum(axis=1).reshape(G, qb, n_sel, SEL_BLOCK // CMP_BLOCK).sum(axis=-1)
        cur = pos // SEL_BLOCK
        forced = (sel_ids[None, :] == 0) | (sel_ids[None, :] == cur[:, None]) | (sel_ids[None, :] == cur[:, None] - 1)
        imp = jnp.where(forced[None], imp + FORCE_BONUS, imp)
        imp = jnp.where((sel_ids[None, :] * SEL_BLOCK <= pos[:, None])[None], imp, NEG_BIG)
        idx = lax.top_k(imp, top_n)[1]
        gath = jax.vmap(lambda s, ix: s[ix])(sel_b.transpose(3, 0, 1, 2, 4), idx)
        gath = gath.reshape(G, qb, top_n * SEL_BLOCK, 2, hd)
        kpos = (idx[..., None] * SEL_BLOCK + jnp.arange(SEL_BLOCK)).reshape(G, qb, top_n * SEL_BLOCK)
        d_s = pos[None, :, None] - kpos
        bias_s = jax.vmap(lambda tb, d: tb[rel_bucket(d)])(bias_g, d_s)
        s_s = jnp.einsum('qghd,gqkd->ghqk', q_i, gath[..., 0, :]).astype(f32) * scale + bias_s.transpose(0, 3, 1, 2)
        p_s = masked_softmax(s_s, (d_s >= 0)[:, None])
        o_s = jnp.einsum('ghqk,gqkd->qghd', p_s.astype(dt), gath[..., 1, :])
        start = base + i * qb
        kw = lax.dynamic_slice_in_dim(win_b, start, band, axis=0)
        kpos_w = k_off - WINDOW + start + jnp.arange(band)
        d_w = pos[:, None] - kpos_w[None, :]
        mask_w = (d_w >= 0) & (d_w < WINDOW) & (kpos_w >= k_off)[None, :]
        bias_w = jax.vmap(lambda tb: tb[rel_bucket(d_w)])(bias_g)
        s_w = jnp.einsum('qghd,kgd->ghqk', q_i, kw[:, 0]).astype(f32) * scale + bias_w.transpose(0, 3, 1, 2)
        p_w = masked_softmax(s_w, mask_w[None, None])
        o_w = jnp.einsum('ghqk,kgd->qghd', p_w.astype(dt), kw[:, 1])
        o = g_i[:, 0, ..., None] * o_c + g_i[:, 1, ..., None] * o_s + g_i[:, 2, ..., None] * o_w
        return o.astype(dt)

    def per_seq(args):
        kc_b, sel_b, win_b, q_b, g_b = args
        return lax.map(lambda a: per_block(kc_b, sel_b, win_b, a[0], a[1], a[2]),
                       (q_b, g_b, jnp.arange(nqb)))

    out = lax.map(per_seq, (kc, sel, win_pad, q_blocks, g_blocks))
    return out.reshape(b, t, NSA_DIM)


def hybrid_layer(x, q_off, kv_past, win_past, s0, shift0, lw, rel_bias):
    (f1_pre, f1_post, f1_w1, f1_w3, f1_w2, mix_pre, mix_post, w_in,
     rw_mu, rw_w0, rw_w2, rw_a0, rw_a2, rw_g2, rw_k_k, rw_k_a, rw_r_k, rw_lnx_w, rw_lnx_b,
     cmp_pe, cmp_w1, cmp_w2, w_br_rw, w_br_nsa, w_out,
     f2_pre, f2_post, f2_w1, f2_w3, f2_w2) = lw
    b, t, _ = x.shape
    x = swiglu_half_step(x, f1_pre, f1_post, f1_w1, f1_w3, f1_w2)
    xn = rmsnorm(x, mix_pre)
    splits = np.cumsum([RW_PROJ, NSA_DIM, 4 * NSA_KV_DIM, 2 * NSA_KV_DIM, 3 * NSA_HEADS, D_MODEL]).tolist()
    p_rw, q, kv_rows, win_rows, nsa_gate, gate_rw, gate_nsa = jnp.split(xn @ w_in, splits, axis=-1)
    y_rw, s_fin, shift_new = rwkv7_time_mix(p_rw, shift0, s0, rw_mu, rw_w0, rw_w2, rw_a0, rw_a2, rw_g2,
                                            rw_k_k, rw_k_a, rw_r_k, rw_lnx_w, rw_lnx_b)
    kv_new = kv_rows.reshape(b, t, 4, NSA_KV_HEADS, NSA_HEAD_DIM)
    win_new = win_rows.reshape(b, t, 2, NSA_KV_HEADS, NSA_HEAD_DIM)
    kv_all = jnp.concatenate([kv_past.astype(x.dtype), kv_new], axis=1)
    win_all = jnp.concatenate([win_past.astype(x.dtype), win_new], axis=1)
    y_nsa = nsa_attention(q.reshape(b, t, NSA_HEADS, NSA_HEAD_DIM), nsa_gate.reshape(b, t, 3, NSA_HEADS),
                          kv_all, win_all, q_off, q_off - win_past.shape[1], rel_bias, cmp_pe, cmp_w1, cmp_w2)
    merged = jax.nn.sigmoid(gate_rw) * (y_rw @ w_br_rw) + jax.nn.sigmoid(gate_nsa) * (y_nsa @ w_br_nsa)
    x = x + rmsnorm(merged @ w_out, mix_post)
    x = swiglu_half_step(x, f2_pre, f2_post, f2_w1, f2_w3, f2_w2)
    keep = min(WINDOW, win_all.shape[1])
    return x, kv_new, win_all[:, win_all.shape[1] - keep:], s_fin, shift_new


def setup_inputs(seed: int = 0) -> dict:
    key = jax.random.key(seed)
    keys = jax.random.split(key, 48)
    cnt = [0]
    f32 = jnp.float32

    def nk():
        cnt[0] += 1
        return keys[cnt[0] - 1]

    def nrm(shape, scale):
        return scale * jax.random.normal(nk(), shape, f32)

    def gain(shape):
        return 1.0 + nrm(shape, 0.05)

    G, hd = NSA_KV_HEADS, NSA_HEAD_DIM
    n_pages = PAST_LEN // PAGE_SIZE
    n_pool = (DEC_BATCH * n_pages * 5) // 4
    win_buf = min(WINDOW, PAST_LEN)
    Dp = (DEPTH,)
    return {
        "x_prompt": nrm((BATCH, SEQ, D_MODEL), 1.0),
        "x_sample": nrm((DEC_BATCH, DEC_SEQ, D_MODEL), 1.0),
        "cache_kv": nrm(Dp + (n_pool, PAGE_SIZE, 4, G, hd), 1.0),
        "cache_win": nrm(Dp + (DEC_BATCH, win_buf, 2, G, hd), 1.0),
        "state_rwkv": nrm(Dp + (DEC_BATCH, RW_HEADS, RW_HEAD_DIM, RW_HEAD_DIM), 0.3),
        "state_shift": nrm(Dp + (DEC_BATCH, RW_PROJ), 1.0),
        "page_table": jax.random.permutation(nk(), n_pool)[:DEC_BATCH * n_pages].reshape(DEC_BATCH, n_pages).astype(jnp.int32),
        "ffn1_pre_g": gain(Dp + (D_MODEL,)),
        "ffn1_post_g": gain(Dp + (D_MODEL,)),
        "ffn1_w1": nrm(Dp + (D_MODEL, D_FF), D_MODEL ** -0.5),
        "ffn1_w3": nrm(Dp + (D_MODEL, D_FF), D_MODEL ** -0.5),
        "ffn1_w2": nrm(Dp + (D_FF, D_MODEL), D_FF ** -0.5),
        "mix_pre_g": gain(Dp + (D_MODEL,)),
        "mix_post_g": gain(Dp + (D_MODEL,)),
        "w_in": nrm(Dp + (D_MODEL, IN_COLS), D_MODEL ** -0.5),
        "rw_mu": jax.random.uniform(nk(), Dp + (RW_PROJ,), f32),
        "rw_w0": -0.6 + nrm(Dp + (RW_DIM,), 0.5),
        "rw_w2": nrm(Dp + (RW_LORA_W, RW_DIM), 0.5 * RW_LORA_W ** -0.5),
        "rw_a0": nrm(Dp + (RW_DIM,), 0.3),
        "rw_a2": nrm(Dp + (RW_LORA_A, RW_DIM), 0.5 * RW_LORA_A ** -0.5),
        "rw_g2": nrm(Dp + (RW_LORA_G, RW_DIM), RW_LORA_G ** -0.5),
        "rw_k_k": 0.85 + nrm(Dp + (RW_DIM,), 0.05),
        "rw_k_a": 1.0 + nrm(Dp + (RW_DIM,), 0.05),
        "rw_r_k": nrm(Dp + (RW_HEADS, RW_HEAD_DIM), 0.1),
        "rw_lnx_w": gain(Dp + (RW_DIM,)),
        "rw_lnx_b": nrm(Dp + (RW_DIM,), 0.02),
        "cmp_pe": nrm(Dp + (CMP_BLOCK, 2, hd), 0.1),
        "cmp_w1": nrm(Dp + (2, CMP_BLOCK * hd, CMP_HID), (CMP_BLOCK * hd) ** -0.5),
        "cmp_w2": nrm(Dp + (2, CMP_HID, hd), CMP_HID ** -0.5),
        "w_br_rw": nrm(Dp + (RW_DIM, D_MODEL), RW_DIM ** -0.5),
        "w_br_nsa": nrm(Dp + (NSA_DIM, D_MODEL), NSA_DIM ** -0.5),
        "w_out": nrm(Dp + (D_MODEL, D_MODEL), D_MODEL ** -0.5),
        "ffn2_pre_g": gain(Dp + (D_MODEL,)),
        "ffn2_post_g": gain(Dp + (D_MODEL,)),
        "ffn2_w1": nrm(Dp + (D_MODEL, D_FF), D_MODEL ** -0.5),
        "ffn2_w3": nrm(Dp + (D_MODEL, D_FF), D_MODEL ** -0.5),
        "ffn2_w2": nrm(Dp + (D_FF, D_MODEL), D_FF ** -0.5),
        "rel_bias": nrm((N_BUCKETS, NSA_HEADS), 0.5),
    }


def reference(x_prompt, x_sample, cache_kv, cache_win, state_rwkv, state_shift, page_table,
              ffn1_pre_g, ffn1_post_g, ffn1_w1, ffn1_w3, ffn1_w2, mix_pre_g, mix_post_g, w_in,
              rw_mu, rw_w0, rw_w2, rw_a0, rw_a2, rw_g2, rw_k_k, rw_k_a, rw_r_k, rw_lnx_w, rw_lnx_b,
              cmp_pe, cmp_w1, cmp_w2, w_br_rw, w_br_nsa, w_out,
              ffn2_pre_g, ffn2_post_g, ffn2_w1, ffn2_w3, ffn2_w2, rel_bias):
    G, hd = NSA_KV_HEADS, NSA_HEAD_DIM
    b_p = x_prompt.shape[0]
    b_s, n_pages = page_table.shape
    past_len = n_pages * cache_kv.shape[2]
    y_prompt, y_sample = x_prompt, x_sample
    kvp, kvs, wp, ws, rp, rs, sp, ss = [], [], [], [], [], [], [], []
    for l in range(DEPTH):
        lw = tuple(w[l] for w in (ffn1_pre_g, ffn1_post_g, ffn1_w1, ffn1_w3, ffn1_w2, mix_pre_g, mix_post_g, w_in,
                                  rw_mu, rw_w0, rw_w2, rw_a0, rw_a2, rw_g2, rw_k_k, rw_k_a, rw_r_k, rw_lnx_w, rw_lnx_b,
                                  cmp_pe, cmp_w1, cmp_w2, w_br_rw, w_br_nsa, w_out,
                                  ffn2_pre_g, ffn2_post_g, ffn2_w1, ffn2_w3, ffn2_w2))
        y_prompt, kv_p, win_p, rw_p, sh_p = hybrid_layer(
            y_prompt, 0,
            jnp.zeros((b_p, 0, 4, G, hd), x_prompt.dtype),
            jnp.zeros((b_p, 0, 2, G, hd), x_prompt.dtype),
            jnp.zeros((b_p, RW_HEADS, RW_HEAD_DIM, RW_HEAD_DIM), jnp.float32),
            jnp.zeros((b_p, RW_PROJ), x_prompt.dtype), lw, rel_bias)
        past_kv = cache_kv[l][page_table].reshape(b_s, past_len, 4, G, hd)
        y_sample, kv_s, win_s, rw_s, sh_s = hybrid_layer(
            y_sample, past_len, past_kv, cache_win[l], state_rwkv[l], state_shift[l], lw, rel_bias)
        kvp.append(kv_p); kvs.append(kv_s); wp.append(win_p); ws.append(win_s)
        rp.append(rw_p); rs.append(rw_s); sp.append(sh_p); ss.append(sh_s)
    return (y_prompt, y_sample, jnp.stack(kvp), jnp.stack(kvs), jnp.stack(wp), jnp.stack(ws),
            jnp.stack(rp), jnp.stack(rs), jnp.stack(sp), jnp.stack(ss))
```

```cpp
#include <hip/hip_runtime.h>
#include <cstdio>
#include <cstdint>
#include <cmath>
#define MK_FUSED 1
namespace pg8 {
#define PG8_LAS __attribute__((address_space(3)))
typedef unsigned short bf16_t;
typedef short bf16x8 __attribute__((ext_vector_type(8)));
typedef float f32x4 __attribute__((ext_vector_type(4)));
typedef unsigned u32x4 __attribute__((ext_vector_type(4)));
constexpr int BM = 256, BK = 64, HALF = 128, HTB = HALF * BK * 2  , STAGE_BYTES = 8 * HTB, NXCD = 8, WGM = 8;

__host__ __device__ __forceinline__ int lds_byte(int r, int c) { const int st = (r >> 4) * 2 + (c >> 5), rr = r & 15, cc = c & 31, ob = rr * 64 + cc * 2; return st * 1024 + (ob ^ (((ob >> 9) & 1) << 5)); }
__host__ __device__ __forceinline__ void stage_rc(int b, int& R, int& C) { const int st = b / 1024, sb = b % 1024, swz = sb ^ (((sb >> 9) & 1) << 5); R = (st >> 1) * 16 + swz / 64; C = (st & 1) * 32 + (swz % 64) / 2; }
__host__ __device__ __forceinline__ int perm32(int rho) { const int n = rho >> 4, i = rho & 15; return 8 * (i >> 2) + 4 * n + (i & 3); }

struct Unit { int pm, pn; };
struct Gemm { const bf16_t* A; const bf16_t* Bt; int M, N, K; };

struct StaticOrder {
    int nM, nN, nwg, G, c;
    __host__ __device__ void init(int M, int N, int G_, int c_) { nM = M / BM; nN = N / BM; nwg = nM * nN; G = G_; c = c_; }
    __host__ __device__ bool next(int i, Unit& u) const {
        const long L = (long)i * G + c; if (L >= nwg) return false;
        int wgid = (int)L; { const int q = nwg / NXCD, r = nwg % NXCD, xcd = wgid % NXCD, off = wgid / NXCD; wgid = (xcd < r ? xcd * (q + 1) : r * (q + 1) + (xcd - r) * q) + off; }
        const int nig = WGM * nN, gid = wgid / nig, fm = gid * WGM, gsz = (nM - fm) < WGM ? (nM - fm) : WGM;
        u.pm = fm + ((wgid % nig) % gsz); u.pn = (wgid % nig) / gsz; return true;
    }
    __device__ __forceinline__ void a_ready(const Unit&) const {}
    __device__ __forceinline__ void done(const Unit&) const {}
};

__device__ __forceinline__ unsigned cvt_pk_bf16(float lo, float hi) { unsigned r; asm volatile("v_cvt_pk_bf16_f32 %0, %1, %2" : "=v"(r) : "v"(lo), "v"(hi)); return r; }
typedef float f32x2 __attribute__((ext_vector_type(2)));
template <class Epi, class Sched, bool ALIGN_EPI = false, bool SP2 = false>
__device__ __forceinline__ void gemm_phase(PG8_LAS unsigned char* lds, const Gemm g, const Sched& S, const Epi& E) {
    int tid_ = threadIdx.x; asm volatile("" : "+v"(tid_));
    const int tid = tid_, wid = __builtin_amdgcn_readfirstlane(tid >> 6), lane = tid & 63, wr = wid >> 2, wc = wid & 3, fr = lane & 15, fq = lane >> 4;
    const int K = g.K, nt = K / BK;
    unsigned voffA[2], voffB[2];
#pragma unroll
    for (int i = 0; i < 2; ++i) { int R, C; stage_rc(tid * 16 + i * 8192, R, C); const int Rb = Epi::PERM ? ((R & ~31) + perm32(R & 31)) : R;
        voffA[i] = (unsigned)(R * K + C) * 2u; voffB[i] = (unsigned)(Rb * K + C) * 2u; }
    const size_t kstep = (size_t)(BK * 2);
    const size_t hstep = (size_t)HALF * K * 2;
    const size_t tstep = 2 * hstep;
    const unsigned ldsw = (unsigned)wid * 1024u;
    const int aoff = lds_byte(wr * 64 + fr, fq * 8), boff = lds_byte(wc * 32 + fr, fq * 8);
#define PG8_SA(b, h) (((b) * 2 + (h)) * HTB)
#define PG8_SB(b, h) ((4 + (b) * 2 + (h)) * HTB)
#define PG8_STAGE(bufoff, gbase, voff) do { _Pragma("unroll") for (int _i = 0; _i < 2; ++_i) \
        __builtin_amdgcn_global_load_lds((const unsigned*)((const char*)(gbase) + (voff)[_i]), (PG8_LAS unsigned*)(lds + (bufoff) + ldsw + _i * 8192), 16, 0, 0); } while (0)
#define PG8_LDA(dst, b, h) do { _Pragma("unroll") for (int m = 0; m < 4; ++m) _Pragma("unroll") for (int k = 0; k < 2; ++k) dst[m][k] = *(const PG8_LAS bf16x8*)(lds + PG8_SA(b, h) + aoff + m * 2048 + k * 1024); } while (0)
#define PG8_LDB(dst, b, h) do { _Pragma("unroll") for (int n = 0; n < 2; ++n) _Pragma("unroll") for (int k = 0; k < 2; ++k) dst[n][k] = *(const PG8_LAS bf16x8*)(lds + PG8_SB(b, h) + boff + n * 2048 + k * 1024); } while (0)
#define PG8_MMA(ai, bj, At, Bt) do { __builtin_amdgcn_s_setprio(1); _Pragma("unroll") for (int m = 0; m < 4; ++m) _Pragma("unroll") for (int n = 0; n < 2; ++n) _Pragma("unroll") for (int k = 0; k < 2; ++k) \
        acc[ai][bj][m][n] = __builtin_amdgcn_mfma_f32_16x16x32_bf16(Bt[n][k], At[m][k], acc[ai][bj][m][n], 0, 0, 0); __builtin_amdgcn_s_setprio(0); } while (0)
#define PG8_WAIT_V(n) asm volatile("s_waitcnt vmcnt(" #n ")" ::: "memory")
#define PG8_WAIT_L(n) asm volatile("s_waitcnt lgkmcnt(" #n ")" ::: "memory")
#define PG8_BAR __builtin_amdgcn_s_barrier()
#define PG8_SCHED __builtin_amdgcn_sched_barrier(0)
    Unit cur, nxt; int ui = 0;
    if (!S.next(0, cur)) return;
    f32x4 acc[2][2][4][2];
#pragma unroll
    for (int a = 0; a < 2; ++a)
#pragma unroll
        for (int b = 0; b < 2; ++b)
#pragma unroll
            for (int m = 0; m < 4; ++m)
#pragma unroll
                for (int n = 0; n < 2; ++n) acc[a][b][m][n] = (f32x4){0.f, 0.f, 0.f, 0.f};
    bf16x8 At[4][2], B0[2][2], B1[2][2];
    const char* cA = (const char*)g.A + (size_t)cur.pm * tstep; const char* cB = (const char*)g.Bt + (size_t)cur.pn * tstep;
    S.a_ready(cur);
    if constexpr (SP2) {
        PG8_STAGE(PG8_SB(0, 0), cB, voffB); PG8_STAGE(PG8_SB(0, 1), cB + hstep, voffB); PG8_STAGE(PG8_SA(0, 0), cA, voffA); PG8_STAGE(PG8_SA(0, 1), cA + hstep, voffA);
        if (wr == 1) PG8_BAR;
        PG8_WAIT_V(2); PG8_BAR;
        PG8_STAGE(PG8_SB(1, 0), cB + kstep, voffB); PG8_STAGE(PG8_SA(1, 0), cA + kstep, voffA); PG8_STAGE(PG8_SB(1, 1), cB + hstep + kstep, voffB);
        PG8_WAIT_V(6); PG8_BAR;
    } else {
        PG8_STAGE(PG8_SB(0, 0), cB, voffB); PG8_STAGE(PG8_SA(0, 0), cA, voffA); PG8_STAGE(PG8_SB(0, 1), cB + hstep, voffB); PG8_STAGE(PG8_SA(0, 1), cA + hstep, voffA);
        if (wr == 1) PG8_BAR;
        PG8_WAIT_V(4); PG8_BAR;
        PG8_STAGE(PG8_SB(1, 0), cB + kstep, voffB); PG8_STAGE(PG8_SA(1, 0), cA + kstep, voffA); PG8_STAGE(PG8_SB(1, 1), cB + hstep + kstep, voffB);
        PG8_WAIT_V(6); PG8_BAR;
    }
    for (;;) {
        const bool has_next = S.next(ui + 1, nxt);
        const char* nA = has_next ? (const char*)g.A + (size_t)nxt.pm * tstep : cA; const char* nB = has_next ? (const char*)g.Bt + (size_t)nxt.pn * tstep : cB;
        for (int t = 0; t < nt; t += 2) {
            const bool last = (t == nt - 2);
            const char* a1 = cA + (size_t)(t + 1) * kstep;
            const char* a2 = last ? nA : cA + (size_t)(t + 2) * kstep; const char* b2 = last ? nB : cB + (size_t)(t + 2) * kstep;
            const char* a3 = a2 + kstep; const char* b3 = b2 + kstep;
            if (last && has_next) S.a_ready(nxt);
            if constexpr (SP2) {
            PG8_LDB(B0, 0, 0); PG8_LDB(B1, 0, 1); PG8_SCHED; PG8_LDA(At, 0, 0); PG8_STAGE(PG8_SA(1, 1), a1 + hstep, voffA);
            PG8_WAIT_V(8); PG8_WAIT_L(0); PG8_BAR; PG8_MMA(0, 0, At, B0); PG8_MMA(0, 1, At, B1); PG8_BAR; PG8_SCHED;
            PG8_LDA(At, 0, 1); PG8_STAGE(PG8_SB(0, 0), b2, voffB); PG8_STAGE(PG8_SB(0, 1), b2 + hstep, voffB); PG8_STAGE(PG8_SA(0, 0), a2, voffA);
            PG8_WAIT_V(8); PG8_WAIT_L(0); PG8_BAR; PG8_MMA(1, 0, At, B0); PG8_MMA(1, 1, At, B1); PG8_BAR; PG8_SCHED;
            PG8_LDB(B0, 1, 0); PG8_LDB(B1, 1, 1); PG8_SCHED; PG8_LDA(At, 1, 0); PG8_STAGE(PG8_SA(0, 1), a2 + hstep, voffA);
            PG8_WAIT_V(8); PG8_WAIT_L(0); PG8_BAR; PG8_MMA(0, 0, At, B0); PG8_MMA(0, 1, At, B1); PG8_BAR; PG8_SCHED;
            PG8_LDA(At, 1, 1); PG8_STAGE(PG8_SB(1, 0), b3, voffB); PG8_STAGE(PG8_SB(1, 1), b3 + hstep, voffB); PG8_STAGE(PG8_SA(1, 0), a3, voffA);
            PG8_WAIT_V(8); PG8_WAIT_L(0); PG8_BAR; PG8_MMA(1, 0, At, B0); PG8_MMA(1, 1, At, B1); PG8_BAR; PG8_SCHED;
            } else {
            PG8_LDB(B0, 0, 0); PG8_SCHED; PG8_LDA(At, 0, 0); PG8_STAGE(PG8_SA(1, 1), a1 + hstep, voffA);
            PG8_WAIT_L(8); PG8_BAR; PG8_WAIT_L(0); PG8_MMA(0, 0, At, B0); PG8_BAR; PG8_SCHED;
            PG8_LDB(B1, 0, 1); PG8_STAGE(PG8_SB(0, 0), b2, voffB);
            PG8_BAR; PG8_WAIT_L(0); PG8_MMA(0, 1, At, B1); PG8_BAR;
            PG8_LDA(At, 0, 1); PG8_STAGE(PG8_SA(0, 0), a2, voffA);
            PG8_BAR; PG8_WAIT_L(0); PG8_MMA(1, 0, At, B0); PG8_BAR; PG8_SCHED;
            PG8_STAGE(PG8_SB(0, 1), b2 + hstep, voffB);
            PG8_WAIT_V(6); PG8_BAR; PG8_MMA(1, 1, At, B1); PG8_BAR;
            PG8_LDB(B0, 1, 0); PG8_SCHED; PG8_LDA(At, 1, 0); PG8_STAGE(PG8_SA(0, 1), a2 + hstep, voffA);
            PG8_WAIT_L(8); PG8_BAR; PG8_WAIT_L(0); PG8_MMA(0, 0, At, B0); PG8_BAR; PG8_SCHED;
            PG8_LDB(B1, 1, 1); PG8_STAGE(PG8_SB(1, 0), b3, voffB);
            PG8_BAR; PG8_WAIT_L(0); PG8_MMA(0, 1, At, B1); PG8_BAR;
            PG8_LDA(At, 1, 1); PG8_STAGE(PG8_SA(1, 0), a3, voffA);
            PG8_BAR; PG8_WAIT_L(0); PG8_MMA(1, 0, At, B0); PG8_BAR; PG8_SCHED;
            PG8_STAGE(PG8_SB(1, 1), b3 + hstep, voffB);
            PG8_WAIT_V(6); PG8_BAR; PG8_MMA(1, 1, At, B1); PG8_BAR;
            }
        }
        if constexpr (ALIGN_EPI) { if (wr == 0) PG8_BAR; }
        if constexpr (!Epi::AFTER_DRAIN) { E(acc, cur, wr, wc, fr, fq); S.done(cur); }
        if (!has_next) break;
#pragma unroll
        for (int a = 0; a < 2; ++a)
#pragma unroll
            for (int b = 0; b < 2; ++b)
#pragma unroll
                for (int m = 0; m < 4; ++m)
#pragma unroll
                    for (int n = 0; n < 2; ++n) acc[a][b][m][n] = (f32x4){0.f, 0.f, 0.f, 0.f};
        cur = nxt; cA = nA; cB = nB; ++ui;
        if constexpr (ALIGN_EPI) { if (wr == 1) PG8_BAR; }
    }
    PG8_WAIT_V(0);
    if constexpr (!ALIGN_EPI) { if (wr == 0) PG8_BAR; }
    PG8_BAR;
    if constexpr (Epi::AFTER_DRAIN) { E.fused(acc, cur, wr, wc, fr, fq, lds, wid, lane); S.done(cur); }
#undef PG8_SA
#undef PG8_SB
#undef PG8_STAGE
#undef PG8_LDA
#undef PG8_LDB
#undef PG8_MMA
#undef PG8_WAIT_V
#undef PG8_WAIT_L
#undef PG8_BAR
#undef PG8_SCHED
}
}
#define LAS __attribute__((address_space(3)))
#define GAS __attribute__((address_space(1)))
typedef unsigned short bf16;
typedef float f32x2 __attribute__((ext_vector_type(2)));
typedef float f32x4 __attribute__((ext_vector_type(4)));
typedef float f32x16 __attribute__((ext_vector_type(16)));
typedef unsigned u32x2 __attribute__((ext_vector_type(2)));
typedef unsigned u32x4 __attribute__((ext_vector_type(4)));
typedef short bf16x8 __attribute__((ext_vector_type(8)));
typedef short s16x4 __attribute__((ext_vector_type(4)));
typedef __bf16 bfx2 __attribute__((ext_vector_type(2)));

constexpr int D = 2048, BP = 8, TP = 2048, BS = 32, TS = 4, PAST = 8192, PAGE = 128, NPAGES = PAST / PAGE;
constexpr int MP = BP * TP, MS = BS * TS, MT = MP + MS, MPAD = 16640;
constexpr int DFF = 5632, RWD = 1024, RWP = 3328, NH = 8, NG_ = 2, HD = 128, KVD = 256;
constexpr int NCOLS = 10008, NPADW = 10240;
constexpr int RWH = 16, RWN = 64;
constexpr float RMS_EPS = 1e-6f, RW_LN_EPS = 64e-5f;
constexpr int CMPROWS = 17408;
constexpr int NSEQ_P = BP * RWH, NSEQ_S = BS * RWH;
constexpr int NSTEPROWS = NSEQ_P * TP + NSEQ_S * TS;

constexpr size_t O_Y = 0, O_KV = (size_t)MT * D, O_WP = O_KV + (size_t)MT * 1024, O_WS = O_WP + (size_t)BP * 512 * 512,
                 O_RP = O_WS + (size_t)BS * 512 * 512, O_RS = O_RP + (size_t)BP * RWH * 4096, O_SP = O_RS + (size_t)BS * RWH * 4096,
                 O_SS = O_SP + (size_t)BP * RWP, O_END = O_SS + (size_t)BS * RWP;
static_assert(O_END == 63965184, "d_out size");

constexpr size_t al256(size_t x) { return (x + 255) & ~(size_t)255; }
constexpr size_t WS_CTL = 0, CTL_BYTES = 1u << 20;
constexpr size_t WS_W13A = CTL_BYTES;
constexpr size_t WS_W2A = WS_W13A + (size_t)2 * DFF * D * 2;
constexpr size_t WS_WINT = WS_W2A + (size_t)D * DFF * 2;
constexpr size_t WS_WLORA = WS_WINT + (size_t)NPADW * D * 2;
constexpr size_t WS_WBRW = WS_WLORA + (size_t)3072 * 256 * 2;
constexpr size_t WS_WBNSA = WS_WBRW + (size_t)D * 1024 * 2;
constexpr size_t WS_WOUT = WS_WBNSA + (size_t)D * 1024 * 2;
constexpr size_t WS_W13B = WS_WOUT + (size_t)D * D * 2;
constexpr size_t WS_W2B = WS_W13B + (size_t)2 * DFF * D * 2;
constexpr size_t WS_CW1 = WS_W2B + (size_t)D * DFF * 2;
constexpr size_t WS_CW2 = WS_CW1 + (size_t)2 * 256 * 4096 * 2;
constexpr size_t WS_BTAB = WS_CW2 + (size_t)2 * 256 * 256 * 2;
constexpr size_t WS_H = WS_BTAB + (size_t)8 * 1024 * 4;
constexpr size_t WS_ACT = WS_H + (size_t)MPAD * D * 2;
constexpr size_t WS_F = WS_ACT + (size_t)MPAD * DFF * 2;
constexpr size_t WS_X1 = WS_F + (size_t)MPAD * D * 2;
constexpr size_t WS_PRW = WS_X1 + (size_t)MPAD * D * 4;
constexpr size_t WS_Q = WS_PRW + (size_t)MPAD * RWP * 2;
constexpr size_t WS_KVN = WS_Q + (size_t)MPAD * 1024 * 2;
constexpr size_t WS_WINN = WS_KVN + (size_t)MPAD * 1024 * 2;
constexpr size_t WS_GRW = WS_WINN + (size_t)MPAD * 512 * 2;
constexpr size_t WS_GNSA = WS_GRW + (size_t)MPAD * D * 2;
constexpr size_t WS_NG = WS_GNSA + (size_t)MPAD * D * 2;
constexpr size_t WS_ALORA = WS_NG + (size_t)MPAD * 32 * 4;
constexpr size_t WS_DEC = WS_ALORA + (size_t)MPAD * 256 * 2;
constexpr size_t WS_AA = WS_DEC + (size_t)MPAD * 1024 * 4;
constexpr size_t WS_GG = WS_AA + (size_t)MPAD * 1024 * 4;
constexpr size_t WS_YRW = WS_GG + (size_t)MPAD * 1024 * 4;
constexpr size_t WS_YNSA = WS_YRW + (size_t)MPAD * 1024 * 2;
constexpr size_t WS_MRG = WS_YNSA + (size_t)MPAD * 1024 * 2;
constexpr size_t WS_ACMP = WS_MRG + (size_t)MPAD * D * 2;
constexpr size_t WS_HID = WS_ACMP + (size_t)2 * CMPROWS * 4096 * 2;
constexpr size_t WS_KC = WS_HID + (size_t)2 * CMPROWS * 256 * 2;
constexpr size_t WS_OPS = WS_KC + (size_t)2 * CMPROWS * 256 * 4;
constexpr size_t WS_WQ = WS_OPS + (size_t)NSTEPROWS * 256 * 2;
constexpr size_t WS_VV = WS_OPS + (size_t)NSTEPROWS * 320 * 4;
constexpr size_t WS_CB = WS_VV + (size_t)NSTEPROWS * 64 * 4;
constexpr size_t WS_VTS = WS_CB + (size_t)MPAD * 16 * 4;
constexpr size_t WS_VTW = WS_VTS + (size_t)512 * 128 * 64 * 2;
constexpr size_t WS_YRAW = WS_VTW + (size_t)512 * 128 * 64 * 2;
constexpr size_t WS_CHK = WS_YRAW + (size_t)MPAD * 1024 * 4;
constexpr size_t WS_PARK = WS_CHK + (size_t)NSEQ_P * 32 * 32768;
constexpr size_t WS_C12 = WS_CHK + (size_t)NSEQ_P * 32 * 49152;
static_assert((size_t)576 * 65536 <= (size_t)NSEQ_P * 32 * 16384, "parking area");
constexpr size_t WS_END = WS_C12 + (size_t)(NSTEPROWS + 64) * 2 * 4 + 256;
static_assert(WS_END % 256 == 0, "ws alignment");

constexpr int NWAVES = 8, NTHR = 512;
constexpr int LDS_BYTES = 147456;
constexpr int RING_OFF = 0, MISC_OFF = 147456 - 256;
constexpr int CW_BAR = 4096;
#define XB_TMO      128
#define XB_XCNT(j)  (256  + 64 * (j))
#define XB_XSUB(j)  (1280 + 64 * (j))
#define XB_XGEN(j)  (2304 + 64 * (j))
#define XB_TOP      3328
#define XB_TOPGEN   3392
#define XCD_BAR_WORDS 3456
#define XB_SPIN_CAP (1u << 18)

__device__ __forceinline__ unsigned xb_ld(unsigned* p)              { return __hip_atomic_load(p, __ATOMIC_RELAXED, __HIP_MEMORY_SCOPE_AGENT); }
__device__ __forceinline__ unsigned xb_add(unsigned* p, unsigned v) { return __hip_atomic_fetch_add(p, v, __ATOMIC_RELAXED, __HIP_MEMORY_SCOPE_AGENT); }
__device__ __forceinline__ unsigned xb_xcc_id() { return (unsigned)__builtin_amdgcn_s_getreg((3 << 11) | 20) & 0xFu; }
#define XB_SPIN(cond, bar) do { unsigned _sp = 0; while (cond) { __builtin_amdgcn_s_sleep(1); \
    if ((++_sp & 255u) == 0u) { if (xb_ld(&(bar)[XB_TMO])) break; if (_sp > XB_SPIN_CAP) { atomicAdd(&(bar)[XB_TMO], 1u); break; } } } } while (0)

struct XcdBarrier {
    unsigned* bar; unsigned x;
    volatile LAS unsigned* st;
};

__device__ __forceinline__ XcdBarrier xcd_barrier_post(unsigned* bar, volatile LAS unsigned* st) {
    XcdBarrier b; b.bar = bar; b.x = xb_xcc_id(); b.st = st;
    if (threadIdx.x == 0) (void)xb_add(&bar[XB_XCNT(b.x)], 1u);
    return b;
}
__device__ __forceinline__ void xcd_barrier_complete(unsigned* bar, unsigned x, unsigned& nloc, unsigned& nx) {
    const unsigned G = gridDim.x * gridDim.y * gridDim.z;
    unsigned sum, cnt, mine, sp = 0u;
    for (;;) {
        sum = 0u; cnt = 0u; mine = 0u;
#pragma unroll
        for (unsigned j = 0; j < 16; ++j) { const unsigned c = xb_ld(&bar[XB_XCNT(j)]); sum += c; cnt += (c > 0u) ? 1u : 0u; mine = (j == x) ? c : mine; }
        if (sum == G) break;
        __builtin_amdgcn_s_sleep(1);
        if ((++sp & 255u) == 0u) { if (xb_ld(&bar[XB_TMO])) break; if (sp > XB_SPIN_CAP) { atomicAdd(&bar[XB_TMO], 1u); break; } }
    }
    nloc = mine > 0u ? mine : 1u; nx = cnt > 0u ? cnt : 1u;
}

__device__ __forceinline__ void xcd_barrier(const XcdBarrier& b) {
    asm volatile("s_waitcnt vmcnt(0)" ::: "memory");
    __syncthreads();
    if (threadIdx.x == 0) {
        unsigned* bar = b.bar;
        __builtin_amdgcn_s_waitcnt(0);
        unsigned nloc = b.st[0], nx = b.st[1];
        if (nloc == 0u) { xcd_barrier_complete(bar, b.x, nloc, nx); b.st[0] = nloc; b.st[1] = nx; }
        const unsigned old = xb_add(&bar[XB_XSUB(b.x)], 1u);
        const unsigned gen = old / nloc;
        if (old + 1u == (gen + 1u) * nloc) {
            __builtin_amdgcn_fence(__ATOMIC_RELEASE, "agent");
            asm volatile("s_waitcnt vmcnt(0)" ::: "memory");
            const unsigned og = xb_add(&bar[XB_TOP], 1u);
            const unsigned tg = og / nx;
            if (og + 1u == (tg + 1u) * nx) xb_add(&bar[XB_TOPGEN], 1u);
            else XB_SPIN(xb_ld(&bar[XB_TOPGEN]) == tg, bar);
            __builtin_amdgcn_fence(__ATOMIC_ACQUIRE, "agent");
            xb_add(&bar[XB_XGEN(b.x)], 1u);
            asm volatile("s_waitcnt vmcnt(0)" ::: "memory");
        } else {
            XB_SPIN(xb_ld(&bar[XB_XGEN(b.x)]) == gen, bar);
            __builtin_amdgcn_fence(__ATOMIC_ACQUIRE, "agent");
            asm volatile("s_waitcnt vmcnt(0)" ::: "memory");
        }
    }
    __syncthreads();
}
#define LDS_WAIT() asm volatile("s_waitcnt lgkmcnt(0)" ::: "memory")
#define VM_WAIT() asm volatile("s_waitcnt vmcnt(0)" ::: "memory")
__device__ __forceinline__ unsigned pk2(float lo, float hi) { const bfx2 b = __builtin_convertvector((f32x2){lo, hi}, bfx2); return __builtin_bit_cast(unsigned, b); }
__device__ __forceinline__ float bflo(unsigned w) { return __uint_as_float(w << 16); }
__device__ __forceinline__ float bfhi(unsigned w) { return __uint_as_float(w & 0xffff0000u); }
__device__ __forceinline__ float bf2f(bf16 v) { return __uint_as_float((unsigned)v << 16); }
__device__ __forceinline__ float wave_sum(float v) {
    v += __builtin_bit_cast(float, __builtin_amdgcn_update_dpp(0, __builtin_bit_cast(int, v), 0xB1, 0xF, 0xF, true));
    v += __builtin_bit_cast(float, __builtin_amdgcn_update_dpp(0, __builtin_bit_cast(int, v), 0x4E, 0xF, 0xF, true));
    v += __builtin_bit_cast(float, __builtin_amdgcn_update_dpp(0, __builtin_bit_cast(int, v), 0x141, 0xF, 0xF, true));
    v += __builtin_bit_cast(float, __builtin_amdgcn_update_dpp(0, __builtin_bit_cast(int, v), 0x140, 0xF, 0xF, true));
    const int vi = __builtin_bit_cast(int, v);
    const float r0 = __builtin_bit_cast(float, __builtin_amdgcn_readlane(vi, 0)), r1 = __builtin_bit_cast(float, __builtin_amdgcn_readlane(vi, 16)),
                r2 = __builtin_bit_cast(float, __builtin_amdgcn_readlane(vi, 32)), r3 = __builtin_bit_cast(float, __builtin_amdgcn_readlane(vi, 48));
    return (r0 + r1) + (r2 + r3);
}
__device__ __forceinline__ float sigmoidf_(float x) { return __builtin_amdgcn_rcpf(1.0f + __builtin_amdgcn_exp2f(-1.4426950408889634f * x)); }

struct P {
    const float* in[38];
    float* out; unsigned char* ws;
    int ph_lo, ph_hi;
};
struct Frame {
    LAS unsigned char* lds;
    int tid, lane, wave, G, bid;
};
enum { I_XP = 0, I_XS, I_CKV, I_CWIN, I_SRW, I_SSH, I_PT, I_F1PRE, I_F1POST, I_F1W1, I_F1W3, I_F1W2, I_MIXPRE, I_MIXPOST, I_WIN,
       I_MU, I_W0, I_W2, I_A0, I_A2, I_G2, I_KK, I_KA, I_RK, I_LNW, I_LNB, I_PE, I_CW1, I_CW2, I_BRW, I_BNSA, I_WOUT,
       I_F2PRE, I_F2POST, I_F2W1, I_F2W3, I_F2W2, I_RELB };
__device__ __forceinline__ void tr_item(const float* W, int K, int Nsrc, int sc, int nv, bf16* WT, int dr, int k0, LAS float* scr, int lane) {
    const int n4 = 4 * (lane & 15), kr = lane >> 4;
    f32x4 v[16];
    const bool vec = ((sc & 3) == 0) && ((Nsrc & 3) == 0) && nv == 64;
#pragma unroll
    for (int i = 0; i < 16; ++i) { const float* src = W + (size_t)(k0 + kr + 4 * i) * Nsrc + sc + n4;
        if (vec) v[i] = *(const f32x4*)src;
        else { v[i].x = n4 + 0 < nv ? src[0] : 0.f; v[i].y = n4 + 1 < nv ? src[1] : 0.f; v[i].z = n4 + 2 < nv ? src[2] : 0.f; v[i].w = n4 + 3 < nv ? src[3] : 0.f; } }
#pragma unroll
    for (int i = 0; i < 16; ++i) { LAS float* d = scr + (kr + 4 * i) * 65 + n4; d[0] = v[i].x; d[1] = v[i].y; d[2] = v[i].z; d[3] = v[i].w; }
    LDS_WAIT(); asm volatile("" ::: "memory");
    const int c = lane & 7;
#pragma unroll
    for (int j = 0; j < 8; ++j) { const int nn = (lane >> 3) + 8 * j; const LAS float* s = scr + (8 * c) * 65 + nn;
        u32x4 o; o.x = pk2(s[0 * 65], s[1 * 65]); o.y = pk2(s[2 * 65], s[3 * 65]); o.z = pk2(s[4 * 65], s[5 * 65]); o.w = pk2(s[6 * 65], s[7 * 65]);
        *(u32x4*)(WT + (size_t)(dr + nn) * K + k0 + 8 * c) = o; }
    LDS_WAIT(); asm volatile("" ::: "memory");
}
constexpr int TR_SCR = 64 * 65 * 4;
__device__ __forceinline__ void tr_plain(const float* W, int K, int N, bf16* WT, int item, LAS float* scr, int lane) {
    const int ncb = N / 64, kb = item / ncb, nb = item % ncb; tr_item(W, K, N, 64 * nb, 64, WT, 64 * nb, 64 * kb, scr, lane);
}
__device__ __forceinline__ void tr_up(const float* W, int which, bf16* WT, int item, LAS float* scr, int lane) {
    const int ncb = DFF / 64, kb = item / ncb, nb = item % ncb; const int dr = (nb >> 1) * 256 + which * 128 + (nb & 1) * 64;
    tr_item(W, D, DFF, 64 * nb, 64, WT, dr, 64 * kb, scr, lane);
}
__device__ __forceinline__ void tr_win(const float* W, bf16* WT, int item, LAS float* scr, int lane) {
    const int ncb = NPADW / 64, kb = item / ncb, nb = item % ncb; const int dr = 64 * nb; int sc, nv;
    if (dr < 5888) { sc = dr; nv = 64; } else if (dr < 9984) { sc = dr + 24; nv = 64; } else if (dr == 9984) { sc = 5888; nv = 24; } else { sc = 0; nv = 0; }
    tr_item(W, D, NCOLS, sc, nv, WT, dr, 64 * kb, scr, lane);
}
constexpr int TI_UP = (D / 64) * (DFF / 64), TI_DN = (DFF / 64) * (D / 64), TI_IN = (D / 64) * (NPADW / 64), TI_BR = (1024 / 64) * (D / 64), TI_OUT = (D / 64) * (D / 64), TI_C1 = (4096 / 64) * (256 / 64);
constexpr int TR_NITEMS = 4 * TI_UP + 2 * TI_DN + TI_IN + 2 * TI_BR + TI_OUT + 2 * TI_C1;
constexpr int TR_LATE0 = 2 * TI_UP + TI_DN + TI_IN, TR_NLATE = 2 * TI_BR + TI_OUT + 2 * TI_UP + TI_DN;
__device__ __forceinline__ void tr_dispatch(const P& p, int it, LAS float* scr, int lane) {
    unsigned char* ws = p.ws;
    constexpr int I_UP = TI_UP, I_DN = TI_DN, I_IN = TI_IN, I_BR = TI_BR, I_OUT = TI_OUT, I_C1 = TI_C1;
        int r = it;
        if (r < I_UP) { tr_up(p.in[I_F1W1], 0, (bf16*)(ws + WS_W13A), r, scr, lane); return; } r -= I_UP;
        if (r < I_UP) { tr_up(p.in[I_F1W3], 1, (bf16*)(ws + WS_W13A), r, scr, lane); return; } r -= I_UP;
        if (r < I_DN) { tr_plain(p.in[I_F1W2], DFF, D, (bf16*)(ws + WS_W2A), r, scr, lane); return; } r -= I_DN;
        if (r < I_IN) { tr_win(p.in[I_WIN], (bf16*)(ws + WS_WINT), r, scr, lane); return; } r -= I_IN;
        if (r < I_BR) { tr_plain(p.in[I_BRW], 1024, D, (bf16*)(ws + WS_WBRW), r, scr, lane); return; } r -= I_BR;
        if (r < I_BR) { tr_plain(p.in[I_BNSA], 1024, D, (bf16*)(ws + WS_WBNSA), r, scr, lane); return; } r -= I_BR;
        if (r < I_OUT) { tr_plain(p.in[I_WOUT], D, D, (bf16*)(ws + WS_WOUT), r, scr, lane); return; } r -= I_OUT;
        if (r < I_UP) { tr_up(p.in[I_F2W1], 0, (bf16*)(ws + WS_W13B), r, scr, lane); return; } r -= I_UP;
        if (r < I_UP) { tr_up(p.in[I_F2W3], 1, (bf16*)(ws + WS_W13B), r, scr, lane); return; } r -= I_UP;
        if (r < I_DN) { tr_plain(p.in[I_F2W2], DFF, D, (bf16*)(ws + WS_W2B), r, scr, lane); return; } r -= I_DN;
        if (r < I_C1) { tr_plain(p.in[I_CW1], 4096, 256, (bf16*)(ws + WS_CW1), r, scr, lane); return; } r -= I_C1;
        tr_plain(p.in[I_CW1] + (size_t)4096 * 256, 4096, 256, (bf16*)(ws + WS_CW1) + (size_t)256 * 4096, r, scr, lane);
}
__device__ __forceinline__ void rms_row_to_bf16(const float* xrow, const float* g, bf16* orow, int lane) {
    f32x4 v[8]; float s = 0.f;
#pragma unroll
    for (int j = 0; j < 4; ++j) { const float* p = xrow + (j * 64 + lane) * 8; v[2 * j] = *(const f32x4*)p; v[2 * j + 1] = *(const f32x4*)(p + 4);
        s += (v[2*j].x * v[2*j].x + v[2*j].y * v[2*j].y) + (v[2*j].z * v[2*j].z + v[2*j].w * v[2*j].w) + (v[2*j+1].x * v[2*j+1].x + v[2*j+1].y * v[2*j+1].y) + (v[2*j+1].z * v[2*j+1].z + v[2*j+1].w * v[2*j+1].w); }
    const float r = 1.0f / sqrtf(wave_sum(s) * (1.0f / D) + RMS_EPS);
#pragma unroll
    for (int j = 0; j < 4; ++j) { const int c = (j * 64 + lane) * 8; const f32x4 g0 = *(const f32x4*)(g + c), g1 = *(const f32x4*)(g + c + 4); const f32x4 a = v[2 * j] * r * g0, b = v[2 * j + 1] * r * g1;
        u32x4 o; o.x = pk2(a.x, a.y); o.y = pk2(a.z, a.w); o.z = pk2(b.x, b.y); o.w = pk2(b.z, b.w); *(u32x4*)(orow + c) = o; }
}
__device__ __forceinline__ void p0_prologue(const P& p, Frame& F) {
    unsigned char* ws = p.ws;
    LAS float* scr = (LAS float*)(F.lds + F.wave * TR_SCR);
    const int gw = F.bid * NWAVES + F.wave, NGW = F.G * NWAVES;
    for (int n = gw; n < TR_NITEMS - TR_NLATE; n += NGW) tr_dispatch(p, n < TR_LATE0 ? n : n + TR_NLATE, scr, F.lane);
    bf16* H = (bf16*)(ws + WS_H);
    for (int m = gw; m < MPAD; m += NGW) {
        if (m < MT) { const float* xr = m < MP ? p.in[I_XP] + (size_t)m * D : p.in[I_XS] + (size_t)(m - MP) * D; rms_row_to_bf16(xr, p.in[I_F1PRE], H + (size_t)m * D, F.lane); }
        else { for (int j = 0; j < 4; ++j) *(u32x4*)(H + (size_t)m * D + (j * 64 + F.lane) * 8) = (u32x4){0u, 0u, 0u, 0u}; }
    }
    const int gt = F.bid * NTHR + F.tid, NGT = F.G * NTHR;
    { bf16* WL = (bf16*)(ws + WS_WLORA);
      for (int i = gt; i < 3072 * 256; i += NGT) { const int n = i >> 8, k = i & 255, seg = n >> 10, nn = n & 1023; float v = 0.f;
          if (seg == 0) { if (k < 64) v = p.in[I_W2][k * 1024 + nn]; } else if (seg == 1) { if (k >= 64 && k < 128) v = p.in[I_A2][(k - 64) * 1024 + nn]; } else { if (k >= 128) v = p.in[I_G2][(k - 128) * 1024 + nn]; }
          WL[i] = (bf16)(pk2(v, 0.f) & 0xffffu); } }
    { bf16* C2 = (bf16*)(ws + WS_CW2);
      for (int i = gt; i < 2 * 256 * 256; i += NGT) { const int kv = i >> 16, n = (i >> 8) & 255, k = i & 255; const float v = n < 128 ? p.in[I_CW2][((size_t)kv * 256 + k) * 128 + n] : 0.f; C2[i] = (bf16)(pk2(v, 0.f) & 0xffffu); } }
    { float* BT = (float*)(ws + WS_BTAB);
      for (int i = gt; i < 8 * 1024; i += NGT) { const int h = i >> 10, n = i & 1023; int b;
          if (n < 16) b = n; else { b = 16 + (int)(log((double)n / 16.0) / log(64.0) * 16.0 + 1e-9);     if (b > 31) b = 31; }
          BT[i] = p.in[I_RELB][b * 8 + h]; } }
    { float* wsO = p.out + O_WS; const float* cw = p.in[I_CWIN];
      for (int i = gt; i < BS * 508 * 128; i += NGT) { const int b = i / (508 * 128), r = i % (508 * 128); *(f32x4*)(wsO + (size_t)b * 512 * 512 + (size_t)r * 4) = *(const f32x4*)(cw + (size_t)b * 512 * 512 + 4 * 512 + (size_t)r * 4); } }
}

__device__ __forceinline__ void tr_late_batch(const P& p, Frame& F, int q) {
    __syncthreads();
    int t_ = threadIdx.x; asm volatile("" : "+v"(t_));
    const int lane = t_ & 63, wave = __builtin_amdgcn_readfirstlane(t_ >> 6);
    LAS float* scr = (LAS float*)(F.lds + wave * TR_SCR);
#pragma nounroll
    for (int i = 0; i < 2; ++i) { const int it = TR_LATE0 + 16 * q + 2 * wave + i; if (it < TR_LATE0 + TR_NLATE) tr_dispatch(p, it, scr, lane); }
}
__device__ __forceinline__ u32x4 pack8(const f32x4 a, const f32x4 b) { u32x4 o; o.x = pk2(a.x, a.y); o.y = pk2(a.z, a.w); o.z = pk2(b.x, b.y); o.w = pk2(b.z, b.w); return o; }
__device__ __forceinline__ f32x4 sig4(const f32x4 v) { f32x4 r; r.x = sigmoidf_(v.x); r.y = sigmoidf_(v.y); r.z = sigmoidf_(v.z); r.w = sigmoidf_(v.w); return r; }
__device__ __forceinline__ u32x4 epi_perm(const u32x4 v, const int src4) { u32x4 r;
    r.x = (unsigned)__builtin_amdgcn_ds_bpermute(src4, (int)v.x); r.y = (unsigned)__builtin_amdgcn_ds_bpermute(src4, (int)v.y); r.z = (unsigned)__builtin_amdgcn_ds_bpermute(src4, (int)v.z); r.w = (unsigned)__builtin_amdgcn_ds_bpermute(src4, (int)v.w); return r; }
__device__ __forceinline__ f32x4 epi_permf(const f32x4 v, const int src4) { return __builtin_bit_cast(f32x4, epi_perm(__builtin_bit_cast(u32x4, v), src4)); }
#define EPI_REMAP() const int fr2 = 4 * fq + (fr >> 2), fq2 = fr & 3, src4 = (fr2 + 16 * fq2) << 2
struct EpiSwiglu {
    static constexpr bool PERM = true, AFTER_DRAIN = false; bf16* O;
    __device__ __forceinline__ void operator()(const pg8::f32x4 (&acc)[2][2][4][2], const pg8::Unit& u, int wr, int wc, int fr, int fq) const {
        EPI_REMAP(); const int row0 = u.pm * 256 + wr * 64 + fr2, col0 = u.pn * 128 + wc * 32 + 8 * fq2;
#pragma unroll
        for (int ai = 0; ai < 2; ++ai)
#pragma unroll
            for (int m = 0; m < 4; ++m) { bf16* rowp = O + (size_t)(row0 + ai * 128 + m * 16) * DFF + col0;
                const f32x4 a0 = acc[ai][0][m][0], a1 = acc[ai][0][m][1], b0 = acc[ai][1][m][0], b1 = acc[ai][1][m][1];
                *(u32x4*)rowp = epi_perm(pack8(a0 * sig4(a0) * b0, a1 * sig4(a1) * b1), src4); }
    }
};
struct EpiStore {
    static constexpr bool PERM = true, AFTER_DRAIN = false; bf16* O; int ldc;
    __device__ __forceinline__ void operator()(const pg8::f32x4 (&acc)[2][2][4][2], const pg8::Unit& u, int wr, int wc, int fr, int fq) const {
        EPI_REMAP(); const int row0 = u.pm * 256 + wr * 64 + fr2, col0 = u.pn * 256 + wc * 32 + 8 * fq2;
#pragma unroll
        for (int ai = 0; ai < 2; ++ai)
#pragma unroll
            for (int m = 0; m < 4; ++m) { bf16* rowp = O + (size_t)(row0 + ai * 128 + m * 16) * ldc + col0;
#pragma unroll
                for (int bj = 0; bj < 2; ++bj) *(u32x4*)(rowp + bj * 128) = epi_perm(pack8(acc[ai][bj][m][0], acc[ai][bj][m][1]), src4); }
    }
};
__device__ __forceinline__ size_t tile_native(int pm, int pt, int wr, int wc, int fr, int fq) { return ((size_t)((pm * 8 + pt) * 8 + wr * 4 + wc)) * 8192 + (size_t)(fr + 16 * fq) * 8; }
struct EpiWin {
    static constexpr bool PERM = true, AFTER_DRAIN = false;
    bf16 *PRW, *Q, *KVN, *WINN, *GRW, *GNSA; float* NG; float* out;
    __device__ __forceinline__ void operator()(const pg8::f32x4 (&acc)[2][2][4][2], const pg8::Unit& u, int wr, int wc, int fr, int fq) const {
        EPI_REMAP(); const int pn = u.pn, row0 = u.pm * 256 + wr * 64 + fr2, cw = wc * 32 + 8 * fq2;
#pragma unroll
        for (int ai = 0; ai < 2; ++ai)
#pragma unroll
            for (int m = 0; m < 4; ++m) { const int row = row0 + ai * 128 + m * 16;
#pragma unroll
                for (int bj = 0; bj < 2; ++bj) { const int ct = bj * 128 + cw; f32x4 v0 = acc[ai][bj][m][0], v1 = acc[ai][bj][m][1];
                    if (pn < 23 || pn >= 39) { v0 = epi_permf(v0, src4); v1 = epi_permf(v1, src4); }
                    if (pn < 13) { const int col = pn * 256 + ct; *(u32x4*)(PRW + (size_t)row * RWP + col) = pack8(v0, v1);
                        float* so = nullptr;
                        if (row < MP) { if ((row & (TP - 1)) == TP - 1) so = out + O_SP + (size_t)(row >> 11) * RWP + col; }
                        else if (row < MT) { if (((row - MP) & 3) == 3) so = out + O_SS + (size_t)((row - MP) >> 2) * RWP + col; }
                        if (so) { *(f32x4*)so = v0; *(f32x4*)(so + 4) = v1; } }
                    else if (pn < 17) { const int col = (pn - 13) * 256 + ct; *(u32x4*)(Q + (size_t)row * 1024 + col) = pack8(v0, v1); }
                    else if (pn < 21) { const int col = (pn - 17) * 256 + ct; *(u32x4*)(KVN + (size_t)row * 1024 + col) = pack8(v0, v1);
                        if (row < MT) { float* so = out + O_KV + (size_t)row * 1024 + col; *(f32x4*)so = v0; *(f32x4*)(so + 4) = v1; } }
                    else if (pn < 23) { const int col = (pn - 21) * 256 + ct; *(u32x4*)(WINN + (size_t)row * 512 + col) = pack8(v0, v1);
                        float* so = nullptr;
                        if (row < MP) { const int t = row & (TP - 1); if (t >= TP - 512) so = out + O_WP + ((size_t)(row >> 11) * 512 + (t - (TP - 512))) * 512 + col; }
                        else if (row < MT) { const int b = (row - MP) >> 2, t = (row - MP) & 3; so = out + O_WS + ((size_t)b * 512 + 508 + t) * 512 + col; }
                        if (so) { *(f32x4*)so = v0; *(f32x4*)(so + 4) = v1; } }
                    else if (pn < 31) { *(u32x4*)(GRW + tile_native(u.pm, pn - 23, wr, wc, fr, fq) + (size_t)(((ai * 2 + bj) * 4 + m) * 512)) = pack8(sig4(v0), sig4(v1)); }
                    else if (pn < 39) { *(u32x4*)(GNSA + tile_native(u.pm, pn - 31, wr, wc, fr, fq) + (size_t)(((ai * 2 + bj) * 4 + m) * 512)) = pack8(sig4(v0), sig4(v1)); }
                    else { if (ct < 24) { float* so = NG + (size_t)row * 32 + ct; *(f32x4*)so = sig4(v0); *(f32x4*)(so + 4) = sig4(v1); } } } }
    }
};
struct EpiLora {
    static constexpr bool PERM = true, AFTER_DRAIN = false; float *DEC, *AA, *GG; const float *w0, *a0;
    template <int SEG> __device__ __forceinline__ void run(const pg8::f32x4 (&acc)[2][2][4][2], const pg8::Unit& u, int wr, int wc, int fr, int fq) const {
        const int row0 = u.pm * 256 + wr * 64 + fr, cb = (u.pn & 3) * 256 + wc * 32 + 8 * fq;
        float* O = SEG == 0 ? DEC : (SEG == 1 ? AA : GG); const float* bias = SEG == 0 ? w0 : a0;
#pragma unroll
        for (int bj = 0; bj < 2; ++bj)
#pragma unroll
            for (int n = 0; n < 2; ++n) { const int col = cb + bj * 128 + 4 * n; f32x4 b = (f32x4){0.f, 0.f, 0.f, 0.f}; if (SEG < 2) b = *(const f32x4*)(bias + col);
#pragma unroll
                for (int ai = 0; ai < 2; ++ai)
#pragma unroll
                    for (int m = 0; m < 4; ++m) { const int row = row0 + ai * 128 + m * 16; f32x4 v = acc[ai][bj][m][n] + b;
                        if (SEG == 0) {
                            const f32x4 sg = sig4(v);
#pragma unroll
                            for (int i = 0; i < 4; ++i) v[i] = __builtin_amdgcn_exp2f(-0.8750387749145276f * sg[i]); }
                        else if (SEG == 1) v = sig4(v);
                        if (SEG == 2) { u32x2 w; w.x = pk2(v.x, v.y); w.y = pk2(v.z, v.w); *(u32x2*)((bf16*)GG + (size_t)row * 1024 + col) = w; }
                        else *(f32x4*)(O + (size_t)row * 1024 + col) = v; }
                asm volatile("" ::: "memory"); }
    }
    __device__ __forceinline__ void operator()(const pg8::f32x4 (&acc)[2][2][4][2], const pg8::Unit& u, int wr, int wc, int fr, int fq) const {
        const int seg = u.pn >> 2;
        if (seg == 0) run<0>(acc, u, wr, wc, fr, fq); else if (seg == 1) run<1>(acc, u, wr, wc, fr, fq); else run<2>(acc, u, wr, wc, fr, fq);
    }
};
struct DiagOrder {
    int G, c;
    __device__ bool next(int i, pg8::Unit& u) const { const int L = i * G + c; if (L >= 2 * (CMPROWS / 256)) return false; u.pm = L; u.pn = L >= (CMPROWS / 256) ? 1 : 0; return true; }
    __device__ __forceinline__ void a_ready(const pg8::Unit&) const {}
    __device__ __forceinline__ void done(const pg8::Unit&) const {}
};
__device__ __forceinline__ float gelu_tanh(float x) { const float u = 0.7978845608028654f * (x + 0.044715f * x * x * x); const float th = 1.0f - 2.0f / (1.0f + __expf(2.0f * u)); return 0.5f * x * (1.0f + th); }
struct EpiCmp1 {
    static constexpr bool PERM = true, AFTER_DRAIN = false; bf16* O;
    __device__ __forceinline__ void operator()(const pg8::f32x4 (&acc)[2][2][4][2], const pg8::Unit& u, int wr, int wc, int fr, int fq) const {
        const int row0 = u.pm * 256 + wr * 64 + fr, col0 = wc * 32 + 8 * fq;
#pragma unroll
        for (int ai = 0; ai < 2; ++ai)
#pragma unroll
            for (int m = 0; m < 4; ++m) { bf16* rowp = O + (size_t)(row0 + ai * 128 + m * 16) * 256 + col0;
#pragma unroll
                for (int bj = 0; bj < 2; ++bj) { f32x4 a = acc[ai][bj][m][0], b = acc[ai][bj][m][1];
#pragma unroll
                    for (int i = 0; i < 4; ++i) { a[i] = gelu_tanh(a[i]); b[i] = gelu_tanh(b[i]); }
                    *(u32x4*)(rowp + bj * 128) = pack8(a, b); } }
    }
};
struct EpiCmp2 {
    static constexpr bool PERM = true, AFTER_DRAIN = false; float* O;
    __device__ __forceinline__ void operator()(const pg8::f32x4 (&acc)[2][2][4][2], const pg8::Unit& u, int wr, int wc, int fr, int fq) const {
        const int row0 = u.pm * 256 + wr * 64 + fr, col0 = wc * 32 + 8 * fq;
#pragma unroll
        for (int ai = 0; ai < 2; ++ai)
#pragma unroll
            for (int m = 0; m < 4; ++m) { float* rowp = O + (size_t)(row0 + ai * 128 + m * 16) * 256 + col0; *(f32x4*)rowp = acc[ai][0][m][0]; *(f32x4*)(rowp + 4) = acc[ai][0][m][1]; }
    }
};
template <int STAGE> struct EpiMerge {
    static constexpr bool PERM = true, AFTER_DRAIN = false; const bf16* GATE; bf16* MRG; bf16* PART;
    __device__ __forceinline__ void operator()(const pg8::f32x4 (&acc)[2][2][4][2], const pg8::Unit& u, int wr, int wc, int fr, int fq) const {
        EPI_REMAP(); const int row0 = u.pm * 256 + wr * 64 + fr2, col0 = u.pn * 256 + wc * 32 + 8 * fq2; const size_t nat = tile_native(u.pm, u.pn, wr, wc, fr, fq);
#pragma unroll
        for (int ai = 0; ai < 2; ++ai)
#pragma unroll
            for (int m = 0; m < 4; ++m) { const size_t off = (size_t)(row0 + ai * 128 + m * 16) * D + col0;
#pragma unroll
                for (int bj = 0; bj < 2; ++bj) { const size_t no = nat + (size_t)(((ai * 2 + bj) * 4 + m) * 512); const u32x4 gw = *(const u32x4*)(GATE + no);
                    f32x4 a = acc[ai][bj][m][0] * (f32x4){bflo(gw.x), bfhi(gw.x), bflo(gw.y), bfhi(gw.y)}, b = acc[ai][bj][m][1] * (f32x4){bflo(gw.z), bfhi(gw.z), bflo(gw.w), bfhi(gw.w)};
                    if (STAGE == 0) *(u32x4*)(PART + no) = pack8(a, b);
                    else { const u32x4 pw = *(const u32x4*)(PART + no); a += (f32x4){bflo(pw.x), bfhi(pw.x), bflo(pw.y), bfhi(pw.y)}; b += (f32x4){bflo(pw.z), bfhi(pw.z), bflo(pw.w), bfhi(pw.w)};
                        *(u32x4*)(MRG + off + bj * 128) = epi_perm(pack8(a, b), src4); } } }
    }
};
#define MFMA16(a, b, c) __builtin_amdgcn_mfma_f32_16x16x32_bf16((a), (b), (c), 0, 0, 0)
template <int CW, int NB, int NS, class Epi>
__device__ __forceinline__ void skinny_gemm(Frame& F, const bf16* A, int K, const bf16* Bt, int nchunks, const Epi& E) {
    constexpr int NT = (CW + 15) / 16, NBT = NT * NB, SROWS = 32 + 16 * NBT, SBYTES = SROWS * 144;
    int t_ = threadIdx.x; asm volatile("" : "+v"(t_));
    const int lane = t_ & 63, wave = __builtin_amdgcn_readfirstlane(t_ >> 6), lr = lane & 15, lq = lane >> 4, ks = wave & 1, rg = wave >> 1;
    const int srow = lane >> 3, sp = lane & 7;
    asm volatile("" : "+s"(K));
    const int kh = K >> 1;
    LAS pg8::f32x4* red = (LAS pg8::f32x4*)F.lds;
    LAS unsigned char* stg = F.lds + wave * SBYTES;
    const int woff = srow * 144 + sp * 16, roff = lr * 144 + lq * 32;
    __syncthreads();
    for (int chunk = F.bid; chunk < nchunks; chunk += F.G) {
        const int c0 = chunk * CW;
        const unsigned ao = (unsigned)((32 * rg + srow) * K + ks * kh + 8 * sp);
        unsigned bo[NBT][2];
#pragma unroll
        for (int j = 0; j < NT; ++j)
#pragma unroll
            for (int nb = 0; nb < NB; ++nb)
#pragma unroll
                for (int u = 0; u < 2; ++u) { const int cc = 16 * j + srow + 8 * u, col = c0 + (cc < CW ? cc : CW - 1); bo[j * NB + nb][u] = (unsigned)(E.brow(col, nb) * K + ks * kh + 8 * sp); }
        pg8::f32x4 acc[2][NT][NB];
#pragma unroll
        for (int i = 0; i < 2; ++i)
#pragma unroll
            for (int j = 0; j < NT; ++j)
#pragma unroll
                for (int nb = 0; nb < NB; ++nb) acc[i][j][nb] = (pg8::f32x4){0.f, 0.f, 0.f, 0.f};
        bf16x8 ga[NS][4], gb[NS][NBT][2];
#define SK_LOAD(set, blk_) do { const int kk_ = (blk_) * 64; _Pragma("unroll") for (int u_ = 0; u_ < 4; ++u_) ga[set][u_] = *(const bf16x8*)(A + (ao + (unsigned)(8 * u_ * K + kk_))); \
            _Pragma("unroll") for (int q_ = 0; q_ < NBT; ++q_) _Pragma("unroll") for (int u_ = 0; u_ < 2; ++u_) gb[set][q_][u_] = *(const bf16x8*)(Bt + (bo[q_][u_] + (unsigned)kk_)); } while (0)
#define SK_MMA(set) do { \
            _Pragma("unroll") for (int u_ = 0; u_ < 4; ++u_) *(LAS bf16x8*)(stg + woff + u_ * 8 * 144) = ga[set][u_]; \
            _Pragma("unroll") for (int q_ = 0; q_ < NBT; ++q_) _Pragma("unroll") for (int u_ = 0; u_ < 2; ++u_) *(LAS bf16x8*)(stg + (32 + 16 * q_ + 8 * u_) * 144 + woff) = gb[set][q_][u_]; \
            __builtin_amdgcn_fence(__ATOMIC_RELEASE, "wavefront"); __builtin_amdgcn_wave_barrier(); __builtin_amdgcn_fence(__ATOMIC_ACQUIRE, "wavefront"); \
            bf16x8 fa_[2][2], fb_[NBT][2]; \
            _Pragma("unroll") for (int i_ = 0; i_ < 2; ++i_) _Pragma("unroll") for (int s_ = 0; s_ < 2; ++s_) fa_[i_][s_] = *(const LAS bf16x8*)(stg + i_ * 16 * 144 + roff + 16 * s_); \
            _Pragma("unroll") for (int q_ = 0; q_ < NBT; ++q_) _Pragma("unroll") for (int s_ = 0; s_ < 2; ++s_) fb_[q_][s_] = *(const LAS bf16x8*)(stg + (32 + 16 * q_) * 144 + roff + 16 * s_); \
            __builtin_amdgcn_fence(__ATOMIC_RELEASE, "wavefront"); __builtin_amdgcn_wave_barrier(); __builtin_amdgcn_fence(__ATOMIC_ACQUIRE, "wavefront"); \
            _Pragma("unroll") for (int s_ = 0; s_ < 2; ++s_) _Pragma("unroll") for (int i_ = 0; i_ < 2; ++i_) _Pragma("unroll") for (int j_ = 0; j_ < NT; ++j_) \
            _Pragma("unroll") for (int nb_ = 0; nb_ < NB; ++nb_) acc[i_][j_][nb_] = MFMA16(fb_[j_ * NB + nb_][s_], fa_[i_][s_], acc[i_][j_][nb_]); } while (0)
        const int nblk = kh >> 6;
#pragma unroll
        for (int s = 0; s < NS - 1; ++s) SK_LOAD(s, s);
        for (int blk = 0; blk < nblk; blk += NS) {
#pragma unroll
            for (int s = 0; s < NS; ++s) {
                if (blk + s + NS - 1 < nblk) SK_LOAD((s + NS - 1) % NS, blk + s + NS - 1);
                if (blk + s < nblk) SK_MMA(s);
            }
        }
#undef SK_LOAD
#undef SK_MMA
        __syncthreads();
        if (ks == 1) {
#pragma unroll
            for (int i = 0; i < 2; ++i)
#pragma unroll
                for (int j = 0; j < NT; ++j)
#pragma unroll
                    for (int nb = 0; nb < NB; ++nb) red[((i * NT + j) * NB + nb) * 256 + rg * 64 + lane] = acc[i][j][nb];
        }
        __syncthreads();
        if (ks == 0) {
#pragma unroll
            for (int i = 0; i < 2; ++i)
#pragma unroll
                for (int j = 0; j < NT; ++j) {
#pragma unroll
                    for (int nb = 0; nb < NB; ++nb) acc[i][j][nb] += red[((i * NT + j) * NB + nb) * 256 + rg * 64 + lane];
                    if (16 * j + 4 * lq < CW) E(32 * rg + 16 * i + lr, c0 + 16 * j + 4 * lq, acc[i][j][0], acc[i][j][NB - 1]); }
        }
        __syncthreads();
    }
}
template <int NS, class Epi>
__device__ __forceinline__ void skinny_gemm2d(Frame& F, const bf16* A, int K, const bf16* Bt, const Epi& E) {
    int t_ = threadIdx.x; asm volatile("" : "+v"(t_));
    const int lane = t_ & 63, wave = __builtin_amdgcn_readfirstlane(t_ >> 6), lr = lane & 15, lq = lane >> 4, ks = wave & 1, mt = (wave >> 1) & 1, nt = wave >> 2;
    const int srow = lane >> 3, sp = lane & 7;
    const int kh = K >> 1;
    LAS pg8::f32x4* red = (LAS pg8::f32x4*)F.lds;
    LAS unsigned char* stg = F.lds + 4096 + wave * 9216;
    const int woff = srow * 144 + sp * 16, roff = lr * 144 + lq * 32;
    __syncthreads();
    for (int chunk = F.bid; chunk < 256; chunk += F.G) {
        const int cx = chunk & 7, cy = chunk >> 3;
        const int r0 = 32 * (cy & 3) + 16 * mt, c0 = 32 * (cx + 8 * (cy >> 2)) + 16 * nt;
        const bf16* ap0 = A + (size_t)(r0 + srow) * K + ks * kh + 8 * sp; const bf16* ap1 = ap0 + (size_t)8 * K;
        const bf16* bp0 = Bt + (size_t)E.brow(c0 + srow, 0) * K + ks * kh + 8 * sp; const bf16* bp1 = Bt + (size_t)E.brow(c0 + srow + 8, 0) * K + ks * kh + 8 * sp;
        pg8::f32x4 acc = (pg8::f32x4){0.f, 0.f, 0.f, 0.f};
        bf16x8 g[NS][4];
#define SK_LOAD(set, blk_) do { const int kk_ = (blk_) * 64; g[set][0] = *(const bf16x8*)(ap0 + kk_); g[set][1] = *(const bf16x8*)(ap1 + kk_); g[set][2] = *(const bf16x8*)(bp0 + kk_); g[set][3] = *(const bf16x8*)(bp1 + kk_); } while (0)
#define SK_MMA(set, buf_) do { LAS unsigned char* sb_ = stg + (buf_) * 4608; \
            *(LAS bf16x8*)(sb_ + woff) = g[set][0]; *(LAS bf16x8*)(sb_ + woff + 8 * 144) = g[set][1]; *(LAS bf16x8*)(sb_ + 2304 + woff) = g[set][2]; *(LAS bf16x8*)(sb_ + 2304 + woff + 8 * 144) = g[set][3]; \
            __builtin_amdgcn_fence(__ATOMIC_RELEASE, "wavefront"); __builtin_amdgcn_wave_barrier(); __builtin_amdgcn_fence(__ATOMIC_ACQUIRE, "wavefront"); \
            const bf16x8 a0_ = *(const LAS bf16x8*)(sb_ + roff), a1_ = *(const LAS bf16x8*)(sb_ + roff + 16), b0_ = *(const LAS bf16x8*)(sb_ + 2304 + roff), b1_ = *(const LAS bf16x8*)(sb_ + 2304 + roff + 16); \
            acc = MFMA16(b0_, a0_, acc); acc = MFMA16(b1_, a1_, acc); } while (0)
        const int nblk = kh >> 6;
#pragma unroll
        for (int s = 0; s < NS - 1; ++s) SK_LOAD(s, s);
        for (int blk = 0; blk < nblk; blk += NS) {
#pragma unroll
            for (int s = 0; s < NS; ++s) {
                if (blk + s + NS - 1 < nblk) SK_LOAD((s + NS - 1) % NS, blk + s + NS - 1);
                if (blk + s < nblk) SK_MMA(s, s & 1);
            }
        }
#undef SK_LOAD
#undef SK_MMA
        if (ks == 1) red[(mt * 2 + nt) * 64 + lane] = acc;
        __syncthreads();
        if (ks == 0) { acc += red[(mt * 2 + nt) * 64 + lane]; E(r0 + lr, c0 + 4 * lq, acc, acc); }
        __syncthreads();
    }
}
struct SkSwiglu {
    bf16* ACT;
    __device__ __forceinline__ int brow(int c, int which) const { return (c >> 7) * 256 + (c & 127) + which * 128; }
    __device__ __forceinline__ void operator()(int r, int c, const pg8::f32x4 a, const pg8::f32x4 b) const {
        const f32x4 v = a * sig4(a) * b; u32x2 w; w.x = pk2(v.x, v.y); w.y = pk2(v.z, v.w); *(u32x2*)(ACT + (size_t)(MP + r) * DFF + c) = w; }
};
struct SkStore {
    bf16* O; int ldc;
    __device__ __forceinline__ int brow(int c, int) const { return c; }
    __device__ __forceinline__ void operator()(int r, int c, const pg8::f32x4 a, const pg8::f32x4) const {
        u32x2 w; w.x = pk2(a.x, a.y); w.y = pk2(a.z, a.w); *(u32x2*)(O + (size_t)(MP + r) * ldc + c) = w; }
};
struct SkWin {
    bf16 *PRW, *Q, *KVN, *WINN, *GRW, *GNSA; float* NG; float* out;
    __device__ __forceinline__ int brow(int c, int) const { return c; }
    __device__ __forceinline__ void operator()(int r, int n, const pg8::f32x4 a, const pg8::f32x4) const {
        const int row = MP + r, b = r >> 2, t = r & 3;
        u32x2 w; w.x = pk2(a.x, a.y); w.y = pk2(a.z, a.w);
        if (n < 3328) { *(u32x2*)(PRW + (size_t)row * RWP + n) = w; if (t == 3) *(f32x4*)(out + O_SS + (size_t)b * RWP + n) = a; }
        else if (n < 4352) { *(u32x2*)(Q + (size_t)row * 1024 + (n - 3328)) = w; }
        else if (n < 5376) { *(u32x2*)(KVN + (size_t)row * 1024 + (n - 4352)) = w; *(f32x4*)(out + O_KV + (size_t)row * 1024 + (n - 4352)) = a; }
        else if (n < 5888) { *(u32x2*)(WINN + (size_t)row * 512 + (n - 5376)) = w; *(f32x4*)(out + O_WS + ((size_t)b * 512 + 508 + t) * 512 + (n - 5376)) = a; }
        else if (n < 7936) { const f32x4 s = sig4(a); u32x2 x; x.x = pk2(s.x, s.y); x.y = pk2(s.z, s.w); *(u32x2*)(GRW + (size_t)row * D + (n - 5888)) = x; }
        else if (n < 9984) { const f32x4 s = sig4(a); u32x2 x; x.x = pk2(s.x, s.y); x.y = pk2(s.z, s.w); *(u32x2*)(GNSA + (size_t)row * D + (n - 7936)) = x; }
        else if (n < 10008) { *(f32x4*)(NG + (size_t)row * 32 + (n - 9984)) = sig4(a); }
    }
};
struct SkLora {
    float *DEC, *AA, *GG; const float *w0, *a0;
    __device__ __forceinline__ int brow(int c, int) const { return c; }
    __device__ __forceinline__ void operator()(int r, int n, const pg8::f32x4 a, const pg8::f32x4) const {
        const int seg = n >> 10, col = n & 1023, row = MP + r; f32x4 v = a;
        if (seg == 0) { const f32x4 sg = sig4(v + *(const f32x4*)(w0 + col));
#pragma unroll
            for (int i = 0; i < 4; ++i) v[i] = __builtin_amdgcn_exp2f(-0.8750387749145276f * sg[i]);
            *(f32x4*)(DEC + (size_t)row * 1024 + col) = v; }
        else if (seg == 1) { *(f32x4*)(AA + (size_t)row * 1024 + col) = sig4(v + *(const f32x4*)(a0 + col)); }
        else { u32x2 w; w.x = pk2(v.x, v.y); w.y = pk2(v.z, v.w); *(u32x2*)((bf16*)GG + (size_t)row * 1024 + col) = w; }
    }
};
template <int STAGE> struct SkMerge {
    const bf16* GATE; bf16* MRG;
    __device__ __forceinline__ int brow(int c, int) const { return c; }
    __device__ __forceinline__ void operator()(int r, int c, const pg8::f32x4 a, const pg8::f32x4) const {
        const size_t off = (size_t)(MP + r) * D + c; const u32x2 gw = *(const u32x2*)(GATE + off);
        f32x4 v = a * (f32x4){bflo(gw.x), bfhi(gw.x), bflo(gw.y), bfhi(gw.y)};
        if (STAGE == 1) { const u32x2 pw = *(const u32x2*)(MRG + off); v += (f32x4){bflo(pw.x), bfhi(pw.x), bflo(pw.y), bfhi(pw.y)}; }
        u32x2 w; w.x = pk2(v.x, v.y); w.y = pk2(v.z, v.w); *(u32x2*)(MRG + off) = w; }
};
template <bool INB, bool OUTB>
__device__ __forceinline__ void thin_phase(Frame& F, const bf16* Fb, const void* xin_p, const void* xin_s, const float* post_g, float half, void* xout, const float* next_g, bf16* H) {
    const int gw = F.bid * NWAVES + F.wave, NGW = F.G * NWAVES, lane = F.lane;
    for (int m0 = 2 * gw; m0 < MT; m0 += 2 * NGW) {
        f32x4 f[2][8], x[2][8]; float s[2] = {0.f, 0.f};
#pragma unroll
        for (int r = 0; r < 2; ++r) { const int m = m0 + r;
#pragma unroll
            for (int j = 0; j < 4; ++j) { const int c = (j * 64 + lane) * 8; const u32x4 w = *(const u32x4*)(Fb + (size_t)m * D + c);
                f[r][2 * j] = (f32x4){bflo(w.x), bfhi(w.x), bflo(w.y), bfhi(w.y)}; f[r][2 * j + 1] = (f32x4){bflo(w.z), bfhi(w.z), bflo(w.w), bfhi(w.w)};
                if (INB) { const bf16* xr = m < MP ? (const bf16*)xin_p + (size_t)m * D : (const bf16*)xin_s + (size_t)(m - MP) * D; const u32x4 xw = *(const u32x4*)(xr + c);
                    x[r][2 * j] = (f32x4){bflo(xw.x), bfhi(xw.x), bflo(xw.y), bfhi(xw.y)}; x[r][2 * j + 1] = (f32x4){bflo(xw.z), bfhi(xw.z), bflo(xw.w), bfhi(xw.w)}; }
                else { const float* xr = m < MP ? (const float*)xin_p + (size_t)m * D : (const float*)xin_s + (size_t)(m - MP) * D; x[r][2 * j] = *(const f32x4*)(xr + c); x[r][2 * j + 1] = *(const f32x4*)(xr + c + 4); } } }
#pragma unroll
        for (int r = 0; r < 2; ++r)
#pragma unroll
            for (int q = 0; q < 8; ++q) s[r] += (f[r][q].x * f[r][q].x + f[r][q].y * f[r][q].y) + (f[r][q].z * f[r][q].z + f[r][q].w * f[r][q].w);
        const float r0 = half / sqrtf(wave_sum(s[0]) * (1.0f / D) + RMS_EPS), r1 = half / sqrtf(wave_sum(s[1]) * (1.0f / D) + RMS_EPS);
        float s2[2] = {0.f, 0.f};
#pragma unroll
        for (int j = 0; j < 4; ++j) { const int c = (j * 64 + lane) * 8; const f32x4 g0 = *(const f32x4*)(post_g + c), g1 = *(const f32x4*)(post_g + c + 4);
#pragma unroll
            for (int r = 0; r < 2; ++r) { const f32x4 o0 = x[r][2 * j] + f[r][2 * j] * (r == 0 ? r0 : r1) * g0, o1 = x[r][2 * j + 1] + f[r][2 * j + 1] * (r == 0 ? r0 : r1) * g1; f[r][2 * j] = o0; f[r][2 * j + 1] = o1;
                if (OUTB) *(u32x4*)((bf16*)xout + (size_t)(m0 + r) * D + c) = pack8(o0, o1);
                else { *(f32x4*)((float*)xout + (size_t)(m0 + r) * D + c) = o0; *(f32x4*)((float*)xout + (size_t)(m0 + r) * D + c + 4) = o1; }
                s2[r] += ((o0.x * o0.x + o0.y * o0.y) + (o0.z * o0.z + o0.w * o0.w)) + ((o1.x * o1.x + o1.y * o1.y) + (o1.z * o1.z + o1.w * o1.w)); } }
        if (next_g) { const float q0 = 1.0f / sqrtf(wave_sum(s2[0]) * (1.0f / D) + RMS_EPS), q1 = 1.0f / sqrtf(wave_sum(s2[1]) * (1.0f / D) + RMS_EPS);
#pragma unroll
            for (int j = 0; j < 4; ++j) { const int c = (j * 64 + lane) * 8; const f32x4 g0 = *(const f32x4*)(next_g + c), g1 = *(const f32x4*)(next_g + c + 4);
#pragma unroll
                for (int r = 0; r < 2; ++r) *(u32x4*)(H + (size_t)(m0 + r) * D + c) = pack8(f[r][2 * j] * (r == 0 ? q0 : q1) * g0, f[r][2 * j + 1] * (r == 0 ? q0 : q1) * g1); } }
    }
}
constexpr int BTX = 2112;
constexpr int FAR_D = 800;
constexpr int A_KT = 0, A_VT = 17408, A_BT = 34816, A_IMP = 68608, A_SELM = 102400, A_UL = 102656, A_UM = 103168, A_NU = 103680, A_SELB = 103936;
constexpr int KT_PITCH = 272, VT_PITCH = 136;
constexpr float NEGB = -1e30f;
#ifndef PREFETCH_TILES
#define PREFETCH_TILES 0
#endif
#define MFMA32(a, b, c) __builtin_amdgcn_mfma_f32_32x32x16_bf16((a), (b), (c), 0, 0, 0)

__device__ __forceinline__ void stage_tile(Frame& F, const void* kp, const void* vp, int pitch, bool isf32, int nvalid) {
    LAS unsigned char* KT = F.lds + A_KT; LAS unsigned char* VT = F.lds + A_VT;
    int tid = F.tid; asm volatile("" : "+v"(tid));
    { const int key = tid >> 3, ch = tid & 7; u32x4 o0 = (u32x4){0u, 0u, 0u, 0u}, o1 = o0;
      if (key < nvalid) {
          if (isf32) { const float* s = (const float*)kp + (size_t)key * pitch + ch * 16; const f32x4 a = *(const f32x4*)s, b = *(const f32x4*)(s + 4), c = *(const f32x4*)(s + 8), d = *(const f32x4*)(s + 12); o0 = pack8(a, b); o1 = pack8(c, d); }
          else { const bf16* s = (const bf16*)kp + (size_t)key * pitch + ch * 16; o0 = *(const u32x4*)s; o1 = *(const u32x4*)(s + 8); } }
      *(LAS u32x4*)(KT + key * KT_PITCH + ch * 32) = o0; *(LAS u32x4*)(KT + key * KT_PITCH + ch * 32 + 16) = o1; }
    { const int key = tid >> 3, dc = tid & 7; u32x4 o0 = (u32x4){0u, 0u, 0u, 0u}, o1 = o0;
      if (key < nvalid) {
          if (isf32) { const float* s = (const float*)vp + (size_t)key * pitch + dc * 16; const f32x4 a = *(const f32x4*)s, b = *(const f32x4*)(s + 4), c = *(const f32x4*)(s + 8), d = *(const f32x4*)(s + 12); o0 = pack8(a, b); o1 = pack8(c, d); }
          else { const bf16* s = (const bf16*)vp + (size_t)key * pitch + dc * 16; o0 = *(const u32x4*)s; o1 = *(const u32x4*)(s + 8); } }
      LAS unsigned short* vt = (LAS unsigned short*)(VT + (dc * 16) * VT_PITCH + key * 2);
      const unsigned w[8] = {o0.x, o0.y, o0.z, o0.w, o1.x, o1.y, o1.z, o1.w};
#pragma unroll
      for (int i = 0; i < 8; ++i) { vt[(2 * i) * (VT_PITCH / 2)] = (unsigned short)(w[i] & 0xffffu); vt[(2 * i + 1) * (VT_PITCH / 2)] = (unsigned short)(w[i] >> 16); } }
}

struct TileRegs { u32x4 k0, k1, v0, v1; };
__device__ __forceinline__ void tile_load(TileRegs& r, const bf16* kp, const bf16* vp, int pitch, int tid) {
    const bf16* ks = kp + (size_t)(tid >> 3) * pitch + (tid & 7) * 16; r.k0 = *(const u32x4*)ks; r.k1 = *(const u32x4*)(ks + 8);
    const bf16* vs = vp + (tid >> 2) * 64 + (tid & 3) * 16; r.v0 = *(const u32x4*)vs; r.v1 = *(const u32x4*)(vs + 8);
}
__device__ __forceinline__ void tile_store(Frame& F, const TileRegs& r, int tid, int boff) {
    LAS unsigned char* kd = F.lds + A_KT + boff + (tid >> 3) * KT_PITCH + (tid & 7) * 32; *(LAS u32x4*)kd = r.k0; *(LAS u32x4*)(kd + 16) = r.k1;
    LAS unsigned char* vd = F.lds + A_VT + boff + (tid >> 2) * VT_PITCH + (tid & 3) * 32;
    *(LAS u32x2*)vd = (u32x2){r.v0.x, r.v0.y}; *(LAS u32x2*)(vd + 8) = (u32x2){r.v0.z, r.v0.w}; *(LAS u32x2*)(vd + 16) = (u32x2){r.v1.x, r.v1.y}; *(LAS u32x2*)(vd + 24) = (u32x2){r.v1.z, r.v1.w};
}
constexpr int A_BUF2 = 106240;
__device__ __forceinline__ void loader_stage(Frame& F, const void* kp, const void* vp, int pitch, bool isf32, int nvalid, int lt, int boff) {
    const int key = lt >> 2, ch = lt & 3;
#pragma unroll
    for (int kv = 0; kv < 2; ++kv) { const void* sp = kv ? vp : kp; u32x2 r[8];
#pragma unroll
        for (int j = 0; j < 8; ++j) r[j] = (u32x2){0u, 0u};
        if (key < nvalid) {
            if (isf32) { const float* s = (const float*)sp + (size_t)key * pitch + 4 * ch; f32x4 a[8];
#pragma unroll
                for (int j = 0; j < 8; ++j) a[j] = *(const f32x4*)(s + 16 * j);
#pragma unroll
                for (int j = 0; j < 8; ++j) { r[j].x = pk2(a[j].x, a[j].y); r[j].y = pk2(a[j].z, a[j].w); } }
            else { const bf16* s = (const bf16*)sp + (size_t)key * pitch + 4 * ch;
#pragma unroll
                for (int j = 0; j < 8; ++j) r[j] = *(const u32x2*)(s + 16 * j); } }
        if (kv == 0) { LAS unsigned char* kd = F.lds + A_KT + boff + key * KT_PITCH + 8 * ch;
#pragma unroll
            for (int j = 0; j < 8; ++j) *(LAS u32x2*)(kd + 32 * j) = r[j]; }
        else { LAS unsigned short* vt = (LAS unsigned short*)(F.lds + A_VT + boff + (4 * ch) * VT_PITCH + key * 2);
#pragma unroll
            for (int j = 0; j < 8; ++j) { const unsigned w[2] = {r[j].x, r[j].y};
#pragma unroll
                for (int e = 0; e < 2; ++e) { vt[(16 * j + 2 * e) * (VT_PITCH / 2)] = (unsigned short)(w[e] & 0xffffu); vt[(16 * j + 2 * e + 1) * (VT_PITCH / 2)] = (unsigned short)(w[e] >> 16); } } } }
}
#define SAMPLE_TILE(ii, kpX, vpX, pitchX, f32X, nvX) do { nvX = 64; \
    if (ph < 2) { kpX = kc_k + (size_t)(64 * (ii)) * 512; vpX = kc_v + (size_t)(64 * (ii)) * 512; pitchX = 512; f32X = true; } \
    else if (ph == 2) { const int j_ = UL[ii]; pitchX = 1024; \
        if (j_ < 128) { const int page_ = pt[j_ >> 1]; const float* kb_ = ckv + ((size_t)(page_ * PAGE + (j_ & 1) * 64) * 4 + 2) * 256 + g * 128; kpX = kb_; vpX = kb_ + 256; f32X = true; } \
        else { const bf16* kb_ = KVN + (size_t)(MP + b * 4) * 1024 + 2 * 256 + g * 128; kpX = kb_; vpX = kb_ + 256; f32X = false; nvX = 4; } } \
    else { pitchX = 512; \
        if ((ii) < 8) { const float* kb_ = cw + ((size_t)(b * 512 + 64 * (ii)) * 2) * 256 + g * 128; kpX = kb_; vpX = kb_ + 256; f32X = true; } \
        else { const bf16* kb_ = WINN + (size_t)(MP + b * 4) * 512 + g * 128; kpX = kb_; vpX = kb_ + 256; f32X = false; nvX = 4; } } } while (0)
constexpr float NEG_M = -1e30f, NEG_S = -3e30f;
template <int MODE>
__device__ __forceinline__ void tile_compute(Frame& F, const int boff, const LAS float* btab, const bf16x8 (&qf)[8], int t, bool lanevalid, int kp0, int kstride, int nvalid, int wlimit, bool far, bool interior,
                                             float& m, float& l, f32x16 (&ot)[4], float invl, LAS float* imp_row, int jbase, bool impwrite) {
    const LAS unsigned char* KT = F.lds + A_KT + boff; const LAS unsigned char* VT = F.lds + A_VT + boff;
    const int ql = F.lane & 31, half = F.lane >> 5;
    const float SC = 0.08838834764831845f * 1.4426950408889634f;
#pragma nounroll
    for (int nt = 0; nt < 2; ++nt) {
        f32x16 st;
#pragma unroll
        for (int i = 0; i < 16; ++i) st[i] = 0.f;
        { const LAS unsigned char* ka = KT + (32 * nt + ql) * KT_PITCH + 16 * half;
#pragma unroll
          for (int kg = 0; kg < 2; ++kg) { bf16x8 kf[4];
#pragma unroll
              for (int ks = 0; ks < 4; ++ks) kf[ks] = *(const LAS bf16x8*)(ka + 32 * (4 * kg + ks));
#pragma unroll
              for (int ks = 0; ks < 4; ++ks) st = MFMA32(kf[ks], qf[4 * kg + ks], st); } }
        float mloc = NEG_S;
        if (far) { const float bfar = btab[1023];
#pragma unroll
            for (int r = 0; r < 16; ++r) { const float s2 = st[r] * SC + bfar; st[r] = s2; mloc = fmaxf(mloc, s2); }
            if (!lanevalid) mloc = NEG_S;
        } else if (interior) {
            const LAS float* bp = btab + (t - kp0 - (32 * nt + 4 * half));
#pragma unroll
            for (int rg = 0; rg < 4; ++rg) { float bv[4];
#pragma unroll
                for (int r4 = 0; r4 < 4; ++r4) bv[r4] = *(bp - (8 * rg + r4));
#pragma unroll
                for (int r4 = 0; r4 < 4; ++r4) asm volatile("" : "+v"(bv[r4]));
#pragma unroll
                for (int r4 = 0; r4 < 4; ++r4) { const int r = 4 * rg + r4; const float s2 = st[r] * SC + bv[r4]; st[r] = s2; mloc = fmaxf(mloc, s2); } }
            if (!lanevalid) mloc = NEG_S;
        } else {
            const int key0 = 32 * nt + 4 * half, d0 = t - kp0 - kstride * key0, nvk = lanevalid ? nvalid - key0 : 0;
#pragma unroll
            for (int rg = 0; rg < 2; ++rg) { float bv[8];
#pragma unroll
                for (int r8 = 0; r8 < 8; ++r8) { const int r = 8 * rg + r8; const int cr = (r & 3) + 8 * (r >> 2); const int dist = d0 - kstride * cr; bv[r8] = btab[min(max(dist, 0), 1023)]; }
#pragma unroll
                for (int r8 = 0; r8 < 8; ++r8) asm volatile("" : "+v"(bv[r8]));
#pragma unroll
                for (int r8 = 0; r8 < 8; ++r8) { const int r = 8 * rg + r8; const int cr = (r & 3) + 8 * (r >> 2); const int dist = d0 - kstride * cr;
                    const bool ok = cr < nvk && (unsigned)dist < (unsigned)wlimit;
                    const float s2 = ok ? st[r] * SC + bv[r8] : NEG_S; st[r] = s2; mloc = fmaxf(mloc, s2); } }
        }
        if (MODE == 0) {
            mloc = fmaxf(mloc, __shfl_xor(mloc, 32));
            const float mnew = mloc > m + 8.0f ? mloc : m;
            if (__ballot(mnew != m) != 0ull) { const float alpha = __builtin_amdgcn_exp2f(m - mnew); m = mnew; l *= alpha;
#pragma unroll
                for (int dt = 0; dt < 4; ++dt)
#pragma unroll
                    for (int i = 0; i < 16; ++i) ot[dt][i] *= alpha; }
            float ls = 0.f; const float meff = lanevalid ? m : 3.0e30f;
#pragma unroll
            for (int r = 0; r < 16; ++r) { const float pv = __builtin_amdgcn_exp2f(st[r] - meff); st[r] = pv; ls += pv; }
            l += ls;
#pragma unroll
            for (int s = 0; s < 2; ++s) {
                u32x4 pb; pb.x = pk2(st[8 * s + 0], st[8 * s + 1]); pb.y = pk2(st[8 * s + 2], st[8 * s + 3]); pb.z = pk2(st[8 * s + 4], st[8 * s + 5]); pb.w = pk2(st[8 * s + 6], st[8 * s + 7]);
                const bf16x8 bfrag = __builtin_bit_cast(bf16x8, pb);
                const LAS unsigned char* va = VT + ql * VT_PITCH + (32 * nt + 16 * s + 4 * half) * 2;
                s16x4 lo[4], hi[4];
#pragma unroll
                for (int dt = 0; dt < 4; ++dt) { lo[dt] = *(const LAS s16x4*)(va + 32 * dt * VT_PITCH); hi[dt] = *(const LAS s16x4*)(va + 32 * dt * VT_PITCH + 16); }
#pragma unroll
                for (int dt = 0; dt < 4; ++dt) { const bf16x8 afrag = __builtin_shufflevector(lo[dt], hi[dt], 0, 1, 2, 3, 4, 5, 6, 7); ot[dt] = MFMA32(afrag, bfrag, ot[dt]); }
            }
        } else {
            if (impwrite) {
                const float meff = lanevalid ? m : 3.0e30f;
#pragma unroll
                for (int r = 0; r < 16; r += 2) { const float p0 = __builtin_amdgcn_exp2f(st[r] - meff) * invl, p1 = __builtin_amdgcn_exp2f(st[r + 1] - meff) * invl;
                    imp_row[jbase + 16 * nt + ((r & 3) >> 1) + 4 * (r >> 2) + 2 * half] = p0 + p1; }
            }
        }
    }
}

__device__ __forceinline__ void attn_item(const P& p, Frame& F, const bool is_s, const int b, const int g, const int c) {
    unsigned char* ws = p.ws;
    const bf16* Q = (const bf16*)(ws + WS_Q); const bf16* KVN = (const bf16*)(ws + WS_KVN); const bf16* WINN = (const bf16*)(ws + WS_WINN);
    const bf16* VTS = (const bf16*)(ws + WS_VTS); const bf16* VTW = (const bf16*)(ws + WS_VTW);
    const float* KC = (const float*)(ws + WS_KC); const float* NGt = (const float*)(ws + WS_NG); bf16* YN = (bf16*)(ws + WS_YNSA);
    { int t_ = threadIdx.x; asm volatile("" : "+v"(t_)); F.tid = t_; F.lane = t_ & 63; }
    const int hh = F.wave & 3, qh = F.wave >> 2, ql = F.lane & 31, half = F.lane >> 5, h = 4 * g + hh, iq = 32 * qh + ql;
    const bool qvalid = is_s ? (qh == 0 && ql < 4) : true;
    const int t = is_s ? PAST + ql : 64 * c + iq;
    const int mrow = is_s ? (qvalid ? MP + b * 4 + ql : MP) : b * TP + t;
    const int item8 = (is_s ? 512 + b * 2 + g : (b * 2 + g) * 32 + c) * 8;
#define PKP(var) unsigned char* var; { int l_ = threadIdx.x; asm volatile("" : "+v"(l_)); var = ws + WS_PARK + (size_t)(item8 + (l_ >> 6)) * 8192 + (l_ & 63) * 16; }
    LAS float* BT4 = (LAS float*)(F.lds + A_BT); LAS float* IMP = (LAS float*)(F.lds + A_IMP); LAS unsigned* SELM = (LAS unsigned*)(F.lds + A_SELM);
    LAS int* UL = (LAS int*)(F.lds + A_UL); LAS int* UM = (LAS int*)(F.lds + A_UM); LAS int* NU = (LAS int*)(F.lds + A_NU); LAS int* SELB = (LAS int*)(F.lds + A_SELB);
    __syncthreads();
    { const float* BTg = (const float*)(ws + WS_BTAB) + (size_t)(4 * g) * 1024;
      constexpr int NBT = (4 * BTX + NTHR - 1) / NTHR; float bt_[NBT];
#pragma unroll
      for (int k = 0; k < NBT; ++k) { const int i = F.tid + k * NTHR; const int hq = i / BTX, dd = i - hq * BTX; bt_[k] = i < 4 * BTX ? BTg[hq * 1024 + (dd < 1023 ? dd : 1023)] : 0.f; }
#pragma unroll
      for (int k = 0; k < NBT; ++k) { const int i = F.tid + k * NTHR; if (i < 4 * BTX) BT4[i] = bt_[k] * 1.4426950408889634f; }
      if (F.tid < 64) SELM[F.tid] = 0u; }
    const LAS float* btab = BT4 + hh * BTX;
    bf16x8 qf[8];
#pragma unroll
    for (int ks = 0; ks < 8; ++ks) { u32x4 w = (u32x4){0u, 0u, 0u, 0u}; if (qvalid) w = *(const u32x4*)(Q + (size_t)mrow * 1024 + h * 128 + 16 * ks + 8 * half); qf[ks] = __builtin_bit_cast(bf16x8, w); }
    f32x16 ot[4];
#pragma unroll
    for (int dt = 0; dt < 4; ++dt)
#pragma unroll
        for (int i = 0; i < 16; ++i) ot[dt][i] = 0.f;
    float m = NEG_M, l = 0.f;
    const int HUGE_W = 0x3fffffff;
    const int ncmp = is_s ? 4 : 1;
    const float* kc_k = KC + (size_t)(is_s ? 1024 + (b * 256) * 2 + g : (b * 64) * 2 + g) * 256;
    const float* kc_v = kc_k + (size_t)CMPROWS * 256;
    const int* pt = (const int*)p.in[I_PT] + b * NPAGES; const float* ckv = p.in[I_CKV]; const float* cw = p.in[I_CWIN];
    unsigned selm = 0u; int nu = 0; float invl = 0.f;
#pragma nounroll
    for (int ph = 0; ph < 4; ++ph) {
        if (ph == 1) { const float lt = l + __shfl_xor(l, 32); invl = lt > 0.f ? 1.0f / lt : 0.f; const float sc = NGt[(size_t)mrow * 32 + 0 * 8 + h] * invl;
            if (qvalid) {
                PKP(PK);
#pragma unroll
                for (int dt = 0; dt < 4; ++dt)
#pragma unroll
                    for (int hf = 0; hf < 2; ++hf) { u32x4 w; w.x = pk2(ot[dt][8 * hf + 0] * sc, ot[dt][8 * hf + 1] * sc); w.y = pk2(ot[dt][8 * hf + 2] * sc, ot[dt][8 * hf + 3] * sc);
                        w.z = pk2(ot[dt][8 * hf + 4] * sc, ot[dt][8 * hf + 5] * sc); w.w = pk2(ot[dt][8 * hf + 6] * sc, ot[dt][8 * hf + 7] * sc); *(u32x4*)(PK + (2 * dt + hf) * 1024) = w; } } }
        if (ph == 2) {
            __syncthreads();
            int tid2 = F.tid; asm volatile("" : "+v"(tid2));
            if (!is_s) {
                { const int q = tid2 >> 3, jg = tid2 & 7; const int tq = 64 * c + q;
#pragma unroll
                  for (int jj = 0; jj < 4; ++jj) { const int j = jg * 4 + jj; float v = ((IMP[(0 * 64 + q) * 33 + j] + IMP[(1 * 64 + q) * 33 + j]) + IMP[(2 * 64 + q) * 33 + j]) + IMP[(3 * 64 + q) * 33 + j];
                      if (j == 0 || j == c || j == c - 1) v += 1e4f; if (j * 64 > tq) v = NEGB; IMP[q * 33 + j] = v; } }
                __syncthreads();
                { const int q = tid2 >> 3, jg = tid2 & 7; unsigned bits = 0u;
                  for (int jj = 0; jj < 4; ++jj) { const int j = jg * 4 + jj; const float vj = IMP[q * 33 + j]; int rank = 0;
#pragma nounroll
                      for (int i = 0; i < 32; ++i) { const float vi = IMP[q * 33 + i]; rank += (vi > vj || (vi == vj && i < j)) ? 1 : 0; }
                      if (rank < 16) bits |= 1u << j; }
                  if (bits) atomicOr((unsigned*)&SELM[q], bits); }
                __syncthreads();
                selm = SELM[iq];
            } else {
                for (int i = tid2; i < 4 * 129; i += NTHR) { const int q = i / 129, j = i % 129; float v = 0.f;
                    if (j < 128) v = ((IMP[(0 * 4 + q) * 132 + j] + IMP[(1 * 4 + q) * 132 + j]) + IMP[(2 * 4 + q) * 132 + j]) + IMP[(3 * 4 + q) * 132 + j];
                    if (j == 0 || j == 128 || j == 127) v += 1e4f;
                    SELB[q * 132 + j] = __float_as_int(v); }
                __syncthreads();
                int sel0 = 0, sel1 = 0;
                { const int i = tid2; const int q = i / 129, j = i % 129; const float vj = __int_as_float(SELB[q * 132 + j]); int rank = 0;
                    for (int x = 0; x < 129; ++x) { const float vi = __int_as_float(SELB[q * 132 + x]); rank += (vi > vj || (vi == vj && x < j)) ? 1 : 0; }
                    sel0 = rank < 16 ? 1 : 0; }
                if (tid2 < 4) { const int i = tid2 + NTHR; const int q = i / 129, j = i % 129; const float vj = __int_as_float(SELB[q * 132 + j]); int rank = 0;
                    for (int x = 0; x < 129; ++x) { const float vi = __int_as_float(SELB[q * 132 + x]); rank += (vi > vj || (vi == vj && x < j)) ? 1 : 0; }
                    sel1 = rank < 16 ? 1 : 0; }
                __syncthreads();
                { const int i = tid2; SELB[(i / 129) * 132 + i % 129] = sel0; }
                if (tid2 < 4) { const int i = tid2 + NTHR; SELB[(i / 129) * 132 + i % 129] = sel1; }
                __syncthreads();
                if (tid2 == 0) { int n = 0; for (int j = 0; j < 129; ++j) { const int msk = SELB[j] | (SELB[132 + j] << 1) | (SELB[264 + j] << 2) | (SELB[396 + j] << 3); if (msk) { UL[n] = j; UM[n] = msk; ++n; } } NU[0] = n; }
                __syncthreads();
                nu = NU[0];
            }
        }
        if (ph >= 2) {
            if (ph == 3) { const float lt = l + __shfl_xor(l, 32); const float sc = lt > 0.f ? NGt[(size_t)mrow * 32 + 1 * 8 + h] / lt : 0.f;
                if (qvalid) { PKP(PK);
#pragma unroll
                    for (int dt = 0; dt < 4; ++dt)
#pragma unroll
                        for (int hf = 0; hf < 2; ++hf) { u32x4* yp = (u32x4*)(PK + (2 * dt + hf) * 1024); const u32x4 o = *yp; u32x4 w;
                            w.x = pk2(bflo(o.x) + ot[dt][8 * hf + 0] * sc, bfhi(o.x) + ot[dt][8 * hf + 1] * sc); w.y = pk2(bflo(o.y) + ot[dt][8 * hf + 2] * sc, bfhi(o.y) + ot[dt][8 * hf + 3] * sc);
                            w.z = pk2(bflo(o.z) + ot[dt][8 * hf + 4] * sc, bfhi(o.z) + ot[dt][8 * hf + 5] * sc); w.w = pk2(bflo(o.w) + ot[dt][8 * hf + 6] * sc, bfhi(o.w) + ot[dt][8 * hf + 7] * sc); *yp = w; } } }
#pragma unroll
            for (int dt = 0; dt < 4; ++dt)
#pragma unroll
                for (int i = 0; i < 16; ++i) ot[dt][i] = 0.f;
            m = NEG_M; l = 0.f;
        }
        const int ntiles = ph < 2 ? ncmp : (ph == 2 ? (is_s ? nu : c + 1) : (is_s ? 9 : (c >= 8 ? 9 : c + 1)));
        const int t_lo = t - ql;
        TileRegs tr;
#pragma nounroll
        for (int i = 0; i < ntiles; ++i) {
            const void* kp; const void* vp; int pitch, nvalid = 64, kp0, kstride = 1, wl = HUGE_W, mode = 2; bool lv = qvalid;
            if (ph < 2) { kp = kc_k + (size_t)(64 * i) * 512; vp = kc_v + (size_t)(64 * i) * 512; pitch = 512; mode = 1; kp0 = 2048 * i + 31; kstride = 32; }
            else if (ph == 2) {
                if (!is_s) { kp = KVN + (size_t)(b * TP + 64 * i) * 1024 + 2 * 256 + g * 128; vp = VTS + ((size_t)((b * 2 + g) * 32 + i) * 128) * 64; pitch = 1024; kp0 = 64 * i; lv = ((selm >> i) & 1u) != 0u; mode = 0; }
                else { const int j = UL[i], msk = UM[i]; kp0 = 64 * j; pitch = 1024; lv = qvalid && ((msk >> (ql & 3)) & 1);
                    if (j < 128) { const int page = pt[j >> 1]; const float* kb = ckv + ((size_t)(page * PAGE + (j & 1) * 64) * 4 + 2) * 256 + g * 128; kp = kb; vp = kb + 256; mode = 1; }
                    else { const bf16* kb = KVN + (size_t)(MP + b * 4) * 1024 + 2 * 256 + g * 128; kp = kb; vp = kb + 256; nvalid = 4; } }
            } else { wl = 512; pitch = 512;
                if (!is_s) { const int j = (c >= 8 ? c - 8 : 0) + i; kp = WINN + (size_t)(b * TP + 64 * j) * 512 + g * 128; vp = VTW + ((size_t)((b * 2 + g) * 32 + j) * 128) * 64; kp0 = 64 * j; mode = 0; }
                else { kp0 = PAST - 512 + 64 * i;
                    if (i < 8) { const float* kb = cw + ((size_t)(b * 512 + 64 * i) * 2) * 256 + g * 128; kp = kb; vp = kb + 256; mode = 1; }
                    else { const bf16* kb = WINN + (size_t)(MP + b * 4) * 512 + g * 128; kp = kb; vp = kb + 256; nvalid = 4; } }
            }
            int tid = F.tid; asm volatile("" : "+v"(tid));
            const bool loader = is_s && tid >= 256;
            const int boff = (is_s || mode == 0) ? (i & 1) * A_BUF2 : 0;
            if (is_s) {
                if (i == 0) { __syncthreads(); if (loader) loader_stage(F, kp, vp, pitch, mode == 1, nvalid, tid - 256, 0); }
                __syncthreads();
                if (loader && i + 1 < ntiles) { const void* kp1; const void* vp1; int pitch1, nv1; bool f1; SAMPLE_TILE(i + 1, kp1, vp1, pitch1, f1, nv1); loader_stage(F, kp1, vp1, pitch1, f1, nv1, tid - 256, ((i + 1) & 1) * A_BUF2); }
            } else if (mode == 0) {
                if (i == 0) { __syncthreads(); tile_load(tr, (const bf16*)kp, (const bf16*)vp, pitch, tid); tile_store(F, tr, tid, 0); if (ntiles > 1) tile_load(tr, (const bf16*)kp + (size_t)64 * pitch, (const bf16*)vp + 128 * 64, pitch, tid); }
                __syncthreads();
                if (i + 1 < ntiles) { tile_store(F, tr, tid, ((i + 1) & 1) * A_BUF2); if (i + 2 < ntiles) tile_load(tr, (const bf16*)kp + (size_t)128 * pitch, (const bf16*)vp + 2 * 128 * 64, pitch, tid); }
            } else if (!(ph == 1 && !is_s)) {
                __syncthreads();
                stage_tile(F, kp, vp, pitch, mode == 1, nvalid);
                __syncthreads();
            }
            const bool far = nvalid == 64 && kstride == 1 && (t_lo - (kp0 + 63) >= FAR_D) && (t_lo + 31 - kp0 < wl);
            const bool interior = !is_s && nvalid == 64 && kstride == 1 && (kp0 + 63 <= t_lo) && (t_lo + 31 - kp0 < wl);
            if (loader) continue;
            if (ph == 1) { LAS float* imp_row = IMP + (is_s ? (hh * 4 + (ql & 3)) * 132 : (hh * 64 + iq) * 33); tile_compute<1>(F, boff, btab, qf, t, lv, kp0, kstride, nvalid, wl, far, interior, m, l, ot, invl, imp_row, 32 * i, qvalid); }
            else tile_compute<0>(F, boff, btab, qf, t, lv, kp0, kstride, nvalid, wl, far, interior, m, l, ot, 0.f, nullptr, 0, false);
        }
    }
    { const float lt = l + __shfl_xor(l, 32); const float sc = lt > 0.f ? NGt[(size_t)mrow * 32 + 2 * 8 + h] / lt : 0.f;
      if (qvalid) { PKP(PK);
#pragma unroll
          for (int dt = 0; dt < 4; ++dt)
#pragma unroll
              for (int hf = 0; hf < 2; ++hf) { const u32x4 o4 = *(const u32x4*)(PK + (2 * dt + hf) * 1024);
#pragma unroll
                  for (int rr = 0; rr < 2; ++rr) { const int r4 = 2 * hf + rr; const int d0 = 32 * dt + 8 * r4 + 4 * half; const u32x2 o = rr ? (u32x2){o4.z, o4.w} : (u32x2){o4.x, o4.y};
                      u32x2 w; w.x = pk2(bflo(o.x) + ot[dt][4 * r4 + 0] * sc, bfhi(o.x) + ot[dt][4 * r4 + 1] * sc); w.y = pk2(bflo(o.y) + ot[dt][4 * r4 + 2] * sc, bfhi(o.y) + ot[dt][4 * r4 + 3] * sc);
                      *(u32x2*)(YN + (size_t)mrow * 1024 + h * 128 + d0) = w; } } } }
}

#undef PKP
__device__ __forceinline__ void vt_build(const P& p, Frame& F, int wg, int nwg) {
    const bf16* KVN = (const bf16*)(p.ws + WS_KVN); const bf16* WINN = (const bf16*)(p.ws + WS_WINN);
    const int gw = wg * NWAVES + F.wave, NGW = nwg * NWAVES, key = F.lane;
    for (int it = gw; it < 2 * 512 * 8; it += NGW) { const int which = it >> 12, blkid = (it >> 3) & 511, dc = it & 7;
        const int b = blkid >> 6, g = (blkid >> 5) & 1, blk = blkid & 31; const int row = b * TP + 64 * blk + key;
        const bf16* src = which == 0 ? KVN + (size_t)row * 1024 + 3 * 256 + g * 128 + dc * 16 : WINN + (size_t)row * 512 + 256 + g * 128 + dc * 16;
        const u32x4 o0 = *(const u32x4*)src, o1 = *(const u32x4*)(src + 8);
        bf16* dst = (bf16*)(p.ws + (which == 0 ? WS_VTS : WS_VTW)) + ((size_t)blkid * 128 + dc * 16) * 64 + key;
        const unsigned w[8] = {o0.x, o0.y, o0.z, o0.w, o1.x, o1.y, o1.z, o1.w};
#pragma unroll
        for (int i = 0; i < 8; ++i) { dst[(2 * i) * 64] = (bf16)(w[i] & 0xffffu); dst[(2 * i + 1) * 64] = (bf16)(w[i] >> 16); } }
}
__device__ __forceinline__ float prw_prev(const P& p, const bf16* PRW, int m, int col) {
    if (m < MP) { return (m & (TP - 1)) == 0 ? 0.f : bf2f(PRW[(size_t)(m - 1) * RWP + col]); }
    const int x = m - MP; return (x & 3) == 0 ? p.in[I_SSH][(size_t)(x >> 2) * RWP + col] : bf2f(PRW[(size_t)(m - 1) * RWP + col]);
}
__device__ __forceinline__ void lora_prep(const P& p, Frame& F) {
    const bf16* PRW = (const bf16*)(p.ws + WS_PRW); bf16* AL = (bf16*)(p.ws + WS_ALORA); const float* mu = p.in[I_MU];
    const int gt = F.bid * NTHR + F.tid, NGT = F.G * NTHR;
    for (int i = gt; i < MPAD * 256; i += NGT) { const int m = i >> 8, k = i & 255; float v = 0.f;
        if (m < MT) { const int col = 3072 + k; const float pc = bf2f(PRW[(size_t)m * RWP + col]), pp = prw_prev(p, PRW, m, col); const float xs = pc + (pp - pc) * mu[col];
            v = k < 64 ? 1.0f - 2.0f / (1.0f + __expf(2.0f * xs)) : (k < 128 ? xs : sigmoidf_(xs)); }
        AL[i] = (bf16)(pk2(v, 0.f) & 0xffffu); }
}
__device__ __forceinline__ void acmp_build(const P& p, Frame& F) {
    const bf16* KVN = (const bf16*)(p.ws + WS_KVN); bf16* AC = (bf16*)(p.ws + WS_ACMP); const float* pe = p.in[I_PE]; const float* ckv = p.in[I_CKV]; const int* pt = (const int*)p.in[I_PT];
    const int gw = F.bid * NWAVES + F.wave, NGW = F.G * NWAVES, lane = F.lane;
    const int ph = lane >> 4, d = (lane & 15) * 8;
    for (int it = gw; it < 2 * CMPROWS; it += NGW) { const int kv = it / CMPROWS, R = it % CMPROWS; bf16* dst = AC + (size_t)it * 4096;
        if (R < 1024) { const int b = R >> 7, n = (R >> 1) & 63, g = R & 1;
#pragma unroll
            for (int pp = 0; pp < 32; pp += 4) { const int pos = pp + ph; const u32x4 w = *(const u32x4*)(KVN + (size_t)(b * TP + n * 32 + pos) * 1024 + kv * 256 + g * 128 + d);
                const f32x4 e0 = *(const f32x4*)(pe + (pos * 2 + kv) * 128 + d), e1 = *(const f32x4*)(pe + (pos * 2 + kv) * 128 + d + 4);
                *(u32x4*)(dst + pos * 128 + d) = pack8((f32x4){bflo(w.x), bfhi(w.x), bflo(w.y), bfhi(w.y)} + e0, (f32x4){bflo(w.z), bfhi(w.z), bflo(w.w), bfhi(w.w)} + e1); } }
        else { const int Rs = R - 1024, b = Rs >> 9, n = (Rs >> 1) & 255, g = Rs & 1; const int page = pt[b * NPAGES + (n >> 2)];
            const float* src = ckv + ((size_t)(page * PAGE + (n & 3) * 32) * 4 + kv) * 256 + g * 128 + d;
            f32x4 x0[8], x1[8];
#pragma unroll
            for (int i = 0; i < 8; ++i) { const int pos = 4 * i + ph; x0[i] = *(const f32x4*)(src + (size_t)pos * 1024); x1[i] = *(const f32x4*)(src + (size_t)pos * 1024 + 4); }
#pragma unroll
            for (int i = 0; i < 8; ++i) { const int pos = 4 * i + ph; const f32x4 e0 = *(const f32x4*)(pe + (pos * 2 + kv) * 128 + d), e1 = *(const f32x4*)(pe + (pos * 2 + kv) * 128 + d + 4);
                *(u32x4*)(dst + pos * 128 + d) = pack8(x0[i] + e0, x1[i] + e1); } }
    }
}
__device__ __forceinline__ float red16(float x) {
    x += __builtin_bit_cast(float, __builtin_amdgcn_update_dpp(0, __builtin_bit_cast(int, x), 0xB1, 0xF, 0xF, true));
    x += __builtin_bit_cast(float, __builtin_amdgcn_update_dpp(0, __builtin_bit_cast(int, x), 0x4E, 0xF, 0xF, true));
    x += __builtin_bit_cast(float, __builtin_amdgcn_update_dpp(0, __builtin_bit_cast(int, x), 0x141, 0xF, 0xF, true));
    x += __builtin_bit_cast(float, __builtin_amdgcn_update_dpp(0, __builtin_bit_cast(int, x), 0x140, 0xF, 0xF, true));
    return x;
}
__device__ __forceinline__ f32x4 bf4(const u32x2 w) { return (f32x4){bflo(w.x), bfhi(w.x), bflo(w.y), bfhi(w.y)}; }
__device__ __forceinline__ void scan_prep(const P& p, Frame& F) {
    const bf16* PRW = (const bf16*)(p.ws + WS_PRW); const float* AA = (const float*)(p.ws + WS_AA); const float* DEC = (const float*)(p.ws + WS_DEC);
    bf16* OPSB = (bf16*)(p.ws + WS_OPS); float* WQ = (float*)(p.ws + WS_WQ); bf16* VVB = (bf16*)(p.ws + WS_VV); float* CB = (float*)(p.ws + WS_CB); const float* mu = p.in[I_MU];
    const int gw = F.bid * NWAVES + F.wave, NGW = F.G * NWAVES, q = F.lane >> 4, c = F.lane & 15;
    for (int it = MP * 4 + gw; it < MT * 4; it += NGW) { const int m = it >> 2, h = 4 * (it & 3) + q, c0 = h * 64 + 4 * c;
        const bool first = m < MP ? (m & (TP - 1)) == 0 : ((m - MP) & 3) == 0;
        f32x4 pc[3], pp[3];
#pragma unroll
        for (int x = 0; x < 3; ++x) { const int col = x * 1024 + c0; pc[x] = bf4(*(const u32x2*)(PRW + (size_t)m * RWP + col));
            if (!first) pp[x] = bf4(*(const u32x2*)(PRW + (size_t)(m - 1) * RWP + col));
            else if (m < MP) pp[x] = (f32x4){0.f, 0.f, 0.f, 0.f};
            else pp[x] = *(const f32x4*)(p.in[I_SSH] + (size_t)((m - MP) >> 2) * RWP + col); }
        const f32x4 a = *(const f32x4*)(AA + (size_t)m * 1024 + c0), w = *(const f32x4*)(DEC + (size_t)m * 1024 + c0);
        f32x4 xs[3];
#pragma unroll
        for (int x = 0; x < 3; ++x) xs[x] = pc[x] + (pp[x] - pc[x]) * *(const f32x4*)(mu + x * 1024 + c0);
        const f32x4 kmod = xs[1] * (1.0f + (a - 1.0f) * *(const f32x4*)(p.in[I_KA] + c0)); const f32x4 kkr = xs[1] * *(const f32x4*)(p.in[I_KK] + c0);
        const float nrm = sqrtf(red16((kkr.x * kkr.x + kkr.y * kkr.y) + (kkr.z * kkr.z + kkr.w * kkr.w))); const f32x4 kk = kkr * (1.0f / fmaxf(nrm, 1e-12f));
        const f32x4 rk = *(const f32x4*)(p.in[I_RK] + c0); const f32x4 t3 = xs[0] * kmod * rk; const float cb = red16((t3.x + t3.y) + (t3.z + t3.w));
        size_t sr; if (m < MP) sr = (size_t)((m >> 11) * RWH + h) * TP + (m & (TP - 1)); else { const int x = m - MP; sr = (size_t)NSEQ_P * TP + (size_t)((x >> 2) * RWH + h) * TS + (x & 3); }
        bf16* o = OPSB + sr * 256 + 4 * c;
        { const f32x4 na = -(kk * a); u32x2 u; u.x = pk2(kk.x, kk.y); u.y = pk2(kk.z, kk.w); *(u32x2*)o = u; u.x = pk2(na.x, na.y); u.y = pk2(na.z, na.w); *(u32x2*)(o + 64) = u;
          u.x = pk2(kmod.x, kmod.y); u.y = pk2(kmod.z, kmod.w); *(u32x2*)(o + 128) = u; u.x = pk2(xs[0].x, xs[0].y); u.y = pk2(xs[0].z, xs[0].w); *(u32x2*)(o + 192) = u;
          u.x = pk2(xs[2].x, xs[2].y); u.y = pk2(xs[2].z, xs[2].w); *(u32x2*)(VVB + sr * 64 + 4 * c) = u; }
        *(f32x4*)(WQ + sr * 64 + 4 * c) = w;
        if (c == 0) CB[(size_t)m * 16 + h] = cb; }
}
__device__ __forceinline__ float red8(float x) {
    x += __builtin_bit_cast(float, __builtin_amdgcn_update_dpp(0, __builtin_bit_cast(int, x), 0xB1, 0xF, 0xF, true));
    x += __builtin_bit_cast(float, __builtin_amdgcn_update_dpp(0, __builtin_bit_cast(int, x), 0x4E, 0xF, 0xF, true));
    x += __builtin_bit_cast(float, __builtin_amdgcn_update_dpp(0, __builtin_bit_cast(int, x), 0x141, 0xF, 0xF, true));
    return x;
}
constexpr int S_OPL = 0, S_VL = 81920, S_YL = 98304;
__device__ __forceinline__ void scan_half(const P& p, Frame& F, size_t sr0, int T, const float* S0, float* Sout, int m0, int h, int hf) {
    const bf16* OPSB = (const bf16*)(p.ws + WS_OPS); const float* WQ = (const float*)(p.ws + WS_WQ); const bf16* VVB = (const bf16*)(p.ws + WS_VV); bf16* YRAW = (bf16*)(p.ws + WS_YRAW);
    const int lane = F.lane, wave = F.wave, tid = F.tid, r = lane >> 4, c = lane & 15, rowl = 4 * wave + r, row = 32 * hf + rowl;
    f32x2 S2[2];
#pragma unroll
    for (int j = 0; j < 2; ++j) S2[j] = S0 ? *(const f32x2*)(S0 + row * 64 + 4 * c + 2 * j) : (f32x2){0.f, 0.f};
    const int nch = (T + 31) >> 5;
    u32x4 pb0, pb1; f32x4 pw; u32x2 pv;
    const int stt = tid >> 4, sq = (tid & 15) >> 2, scol = (tid & 3) * 16;
    const int lo_ = stt * 320 + (sq == 0 ? 0 : sq + 1) * 64 + scol, lw_ = stt * 320 + 64 + (tid & 15) * 4, lv_ = stt * 64 + (tid & 15) * 4;
#define SCAN_FETCH(srow) do { const char* so_ = (const char*)(OPSB + (srow) * 256); pb0 = *(const u32x4*)(so_ + (size_t)tid * 32); pb1 = *(const u32x4*)(so_ + (size_t)tid * 32 + 16); \
        pw = *(const f32x4*)((const char*)(WQ + (srow) * 64) + (size_t)tid * 16); pv = *(const u32x2*)((const char*)(VVB + (srow) * 64) + (size_t)tid * 8); } while (0)
#define SCAN_PUT(bufi) do { LAS float* d_ = (LAS float*)(F.lds + S_OPL + (bufi) * 40960); \
        *(LAS f32x4*)(d_ + lo_) = (f32x4){bflo(pb0.x), bfhi(pb0.x), bflo(pb0.y), bfhi(pb0.y)}; *(LAS f32x4*)(d_ + lo_ + 4) = (f32x4){bflo(pb0.z), bfhi(pb0.z), bflo(pb0.w), bfhi(pb0.w)}; \
        *(LAS f32x4*)(d_ + lo_ + 8) = (f32x4){bflo(pb1.x), bfhi(pb1.x), bflo(pb1.y), bfhi(pb1.y)}; *(LAS f32x4*)(d_ + lo_ + 12) = (f32x4){bflo(pb1.z), bfhi(pb1.z), bflo(pb1.w), bfhi(pb1.w)}; \
        *(LAS f32x4*)(d_ + lw_) = pw; *(LAS f32x4*)((LAS float*)(F.lds + S_VL + (bufi) * 8192) + lv_) = (f32x4){bflo(pv.x), bfhi(pv.x), bflo(pv.y), bfhi(pv.y)}; } while (0)
    SCAN_FETCH(sr0);
    __syncthreads();
    SCAN_PUT(0);
    __syncthreads();
    for (int k = 0; k < nch; ++k) {
        const int buf = k & 1, t0 = k * 32, ns = (T - t0) < 32 ? (T - t0) : 32;
        if (k + 1 < nch) SCAN_FETCH(sr0 + t0 + 32);
        const LAS float* opl = (const LAS float*)(F.lds + S_OPL + buf * 40960) + c * 4;
        const LAS float* vl = (const LAS float*)(F.lds + S_VL + buf * 8192) + row;
        LAS float* yl = (LAS float*)(F.lds + S_YL + buf * 4096) + rowl;
#define SCAN_LOAD(o, v, tt) do { const LAS f32x4* o4_ = (const LAS f32x4*)(opl + (tt) * 320); _Pragma("unroll") for (int q_ = 0; q_ < 5; ++q_) o[q_] = o4_[16 * q_]; v = vl[(tt) * 64]; } while (0)
#define SCAN_STEP(o, v, tt) do { \
            f32x2 acc_ = S2[0] * (f32x2){o[0].x, o[0].y}; acc_ = S2[1] * (f32x2){o[0].z, o[0].w} + acc_; \
            const float sk_ = red16(acc_.x + acc_.y); const f32x2 sk2_ = (f32x2){sk_, sk_}, v2_ = (f32x2){v, v}; \
            S2[0] = S2[0] * (f32x2){o[1].x, o[1].y} + (sk2_ * (f32x2){o[2].x, o[2].y} + v2_ * (f32x2){o[3].x, o[3].y}); \
            S2[1] = S2[1] * (f32x2){o[1].z, o[1].w} + (sk2_ * (f32x2){o[2].z, o[2].w} + v2_ * (f32x2){o[3].z, o[3].w}); \
            f32x2 ya_ = S2[0] * (f32x2){o[4].x, o[4].y}; ya_ = S2[1] * (f32x2){o[4].z, o[4].w} + ya_; \
            const float y_ = red16(ya_.x + ya_.y); if (c == 0) yl[(tt) * 32] = y_; } while (0)
        { f32x4 oa[5], ob[5]; float va, vb;
          SCAN_LOAD(oa, va, 0);
          int tt = 0;
          for (; tt + 1 < ns; tt += 2) {
              SCAN_LOAD(ob, vb, tt + 1);
              SCAN_STEP(oa, va, tt);
              if (tt + 2 < ns) SCAN_LOAD(oa, va, tt + 2);
              SCAN_STEP(ob, vb, tt + 1);
          }
          if (tt < ns) SCAN_STEP(oa, va, tt);
        }
#undef SCAN_LOAD
#undef SCAN_STEP
        __syncthreads();
        { const int tt = tid >> 4, rl = (tid & 15) * 2;
          if (tt < ns) { const LAS float* ys = (const LAS float*)(F.lds + S_YL + buf * 4096) + tt * 32 + rl;
              *(unsigned*)(YRAW + (size_t)(m0 + t0 + tt) * 1024 + h * 64 + 32 * hf + rl) = pk2(ys[0], ys[1]); } }
        if (k + 1 < nch) SCAN_PUT(buf ^ 1);
        __syncthreads();
    }
#pragma unroll
    for (int j = 0; j < 2; ++j) *(f32x2*)(Sout + row * 64 + 4 * c + 2 * j) = S2[j];
#undef SCAN_FETCH
#undef SCAN_PUT
}
__device__ __forceinline__ void scan_sample(const P& p, Frame& F, int wg, int nwg) {
    for (int task = wg; task < 2 * NSEQ_S; task += nwg) { const int s = task >> 1, hf = task & 1;
        scan_half(p, F, (size_t)NSEQ_P * TP + (size_t)s * TS, TS, p.in[I_SRW] + (size_t)s * 4096, p.out + O_RS + (size_t)s * 4096, MP + (s >> 4) * TS, s & 15, hf); }
}
__device__ __forceinline__ void rwkv_post(const P& p, Frame& F) {
    const bf16* YRAW = (const bf16*)(p.ws + WS_YRAW); const bf16* VVB = (const bf16*)(p.ws + WS_VV); const float* CB = (const float*)(p.ws + WS_CB); const bf16* GG = (const bf16*)(p.ws + WS_GG);
    bf16* YRW = (bf16*)(p.ws + WS_YRW);
    const int gw = F.bid * NWAVES + F.wave, NGW = F.G * NWAVES, q = F.lane >> 4, c = F.lane & 15;
    for (int it = gw; it < MT * 4; it += NGW) { const int m = it >> 2, h = 4 * (it & 3) + q, c0 = h * 64 + 4 * c;
        size_t sr; if (m < MP) sr = (size_t)((m >> 11) * RWH + h) * TP + (m & (TP - 1)); else { const int x = m - MP; sr = (size_t)NSEQ_P * TP + (size_t)((x >> 2) * RWH + h) * TS + (x & 3); }
        const f32x4 y = bf4(*(const u32x2*)(YRAW + (size_t)m * 1024 + c0)), vv = bf4(*(const u32x2*)(VVB + sr * 64 + 4 * c)), g = bf4(*(const u32x2*)(GG + (size_t)m * 1024 + c0));
        const float cb = CB[(size_t)m * 16 + h];
        const float mean = red16((y.x + y.y) + (y.z + y.w)) * (1.0f / 64.0f); const f32x4 dd = y - mean;
        const float var = red16((dd.x * dd.x + dd.y * dd.y) + (dd.z * dd.z + dd.w * dd.w)) * (1.0f / 64.0f);
        const f32x4 yn = dd * (1.0f / sqrtf(var + RW_LN_EPS)) * *(const f32x4*)(p.in[I_LNW] + c0) + *(const f32x4*)(p.in[I_LNB] + c0);
        const f32x4 o = (yn + vv * cb) * g;
        u32x2 w; w.x = pk2(o.x, o.y); w.y = pk2(o.z, o.w); *(u32x2*)(YRW + (size_t)m * 1024 + c0) = w; }
}
constexpr int CK_SLOT = 8192, CK_GC = 16 * CK_SLOT, CK_PAR = CK_GC + 256 + 2048;
constexpr size_t CK_TASK_BYTES = 4 * 8192;
__device__ __forceinline__ int ck_crow(int r, int half) { return (r & 3) + 8 * (r >> 2) + 4 * half; }
__device__ __forceinline__ f32x16 ck_zero() { f32x16 z;
#pragma unroll
    for (int i = 0; i < 16; ++i) z[i] = 0.f;
    return z; }
__device__ __forceinline__ f32x16 ck_mm(const LAS unsigned char* A, const LAS unsigned char* BT, int mt, int nt, int ql, int half, f32x16 acc) {
    const LAS unsigned char* ar = A + (32 * mt + ql) * 128; const LAS unsigned char* br = BT + (32 * nt + ql) * 128; const int sw = ql & 7;
    f32x16 acc2 = ck_zero();
#pragma unroll
    for (int ks = 0; ks < 4; ++ks) { const int off = ((2 * ks + half) ^ sw) << 4; const bf16x8 a = *(const LAS bf16x8*)(ar + off), b = *(const LAS bf16x8*)(br + off); if (ks & 1) acc2 = MFMA32(a, b, acc2); else acc = MFMA32(a, b, acc); }
#pragma unroll
    for (int i = 0; i < 16; ++i) acc[i] += acc2[i];
    return acc;
}
__device__ __forceinline__ void ck_store_t(LAS unsigned char* IMG, const f32x16& v, int mt, int nt, int ql, int half) {
    const int n = 32 * nt + ql; LAS unsigned char* row = IMG + n * 128;
#pragma unroll
    for (int g = 0; g < 4; ++g) { const int m0 = 32 * mt + 8 * g + 4 * half; u32x2 w; w.x = pk2(v[4 * g], v[4 * g + 1]); w.y = pk2(v[4 * g + 2], v[4 * g + 3]);
        *(LAS u32x2*)(row + (((m0 >> 3) ^ (n & 7)) << 4) + (m0 & 4) * 2) = w; }
}
__device__ __forceinline__ void ck_store_n(LAS unsigned char* IMG, const f32x16& v, int mt, int nt, int ql, int half) {
    const int n = 32 * nt + ql;
#pragma unroll
    for (int r = 0; r < 16; ++r) { const int m = 32 * mt + ck_crow(r, half);
        *(LAS unsigned short*)(IMG + m * 128 + (((n >> 3) ^ (m & 7)) << 4) + (n & 7) * 2) = (unsigned short)(pk2(v[r], 0.f) & 0xffffu); }
}
__device__ __forceinline__ void ck_tr(const LAS unsigned char* SRC, LAS unsigned char* DST, int mt, int nt, int ql, int half) {
    const LAS unsigned char* ar = SRC + (32 * mt + ql) * 128; const int sw = ql & 7;
    f32x16 acc = ck_zero();
#pragma unroll
    for (int d = 0; d < 2; ++d) { const int ks = 2 * nt + d, off = ((2 * ks + half) ^ sw) << 4; const bf16x8 a = *(const LAS bf16x8*)(ar + off);
        const int e = ql - 16 * d - 8 * half; const unsigned val = (e & 1) ? 0x3F800000u : 0x00003F80u; const int w = (e >= 0 && e < 8) ? (e >> 1) : -1;
        const u32x4 bw = (u32x4){w == 0 ? val : 0u, w == 1 ? val : 0u, w == 2 ? val : 0u, w == 3 ? val : 0u};
        acc = MFMA32(a, __builtin_bit_cast(bf16x8, bw), acc); }
    ck_store_t(DST, acc, mt, nt, ql, half);
}
#define CKIN_DECL(PFX) u32x4 PFX##cr, PFX##ck, PFX##cv, PFX##pr, PFX##pk, PFX##pv; f32x4 PFX##a0, PFX##a1, PFX##w0, PFX##w1
#define CKIN_LOAD(PFX, task_) do { const int s_ = (task_) >> 5, c_ = (task_) & 31, b_ = s_ >> 4, h_ = s_ & 15, tid_ = threadIdx.x, t_ = tid_ >> 3, jg_ = tid_ & 7, m_ = b_ * TP + 64 * c_ + t_, c0_ = h_ * 64 + 8 * jg_; \
    const bf16* PRW_ = (const bf16*)(p.ws + WS_PRW); const float* AA_ = (const float*)(p.ws + WS_AA); const float* DEC_ = (const float*)(p.ws + WS_DEC); \
    PFX##cr = *(const u32x4*)(PRW_ + (size_t)m_ * RWP + c0_); PFX##ck = *(const u32x4*)(PRW_ + (size_t)m_ * RWP + 1024 + c0_); PFX##cv = *(const u32x4*)(PRW_ + (size_t)m_ * RWP + 2048 + c0_); \
    const int mp_ = (c_ == 0 && t_ == 0) ? m_ : m_ - 1;     \
    PFX##pr = *(const u32x4*)(PRW_ + (size_t)mp_ * RWP + c0_); PFX##pk = *(const u32x4*)(PRW_ + (size_t)mp_ * RWP + 1024 + c0_); PFX##pv = *(const u32x4*)(PRW_ + (size_t)mp_ * RWP + 2048 + c0_); \
    PFX##a0 = *(const f32x4*)(AA_ + (size_t)m_ * 1024 + c0_); PFX##a1 = *(const f32x4*)(AA_ + (size_t)m_ * 1024 + c0_ + 4); PFX##w0 = *(const f32x4*)(DEC_ + (size_t)m_ * 1024 + c0_); PFX##w1 = *(const f32x4*)(DEC_ + (size_t)m_ * 1024 + c0_ + 4); } while (0)
__device__ __forceinline__ void chunk_pre(const P& p, Frame& F, int task, int next_task, u32x4& icr, u32x4& ick, u32x4& icv, u32x4& ipr, u32x4& ipk, u32x4& ipv, f32x4& ia0, f32x4& ia1, f32x4& iw0, f32x4& iw1, int& ptag0, int& ptag1) {
    const int s = task >> 5, c = task & 31, b = s >> 4, h = s & 15, mbase = b * TP + 64 * c;
    const bf16* PRW = (const bf16*)(p.ws + WS_PRW); const float* AA = (const float*)(p.ws + WS_AA); const float* DEC = (const float*)(p.ws + WS_DEC);
    bf16* VVB = (bf16*)(p.ws + WS_VV); float* CB = (float*)(p.ws + WS_CB);
    unsigned char* outp = p.ws + WS_CHK + (size_t)task * CK_TASK_BYTES;
    int tid = threadIdx.x; asm volatile("" : "+v"(tid));
    const int lane = tid & 63, wave = __builtin_amdgcn_readfirstlane(tid >> 6), ql = lane & 31, half = lane >> 5, grp = wave >> 2, mt = (wave >> 1) & 1, nt = wave & 1;
    LAS unsigned char* L = F.lds;
#define SLOT(k) (L + (k) * CK_SLOT)
    LAS float* GC = (LAS float*)(L + CK_GC);
    { const int slot_ = (h >> 3) & 1;
      if ((slot_ ? ptag1 : ptag0) != h) {
          if (tid < 384) { const int vec = tid >> 6, j = tid & 63;
              const float* src = vec < 3 ? p.in[I_MU] + vec * 1024 : vec == 3 ? p.in[I_KA] : vec == 4 ? p.in[I_KK] : p.in[I_RK];
              ((LAS float*)(L + CK_PAR))[slot_ * 384 + tid] = src[h * 64 + j]; }
          if (slot_) ptag1 = h; else ptag0 = h;
          __syncthreads(); } }
    { const int t = tid >> 3, jg = tid & 7, tl = t & 7, m = mbase + t; const bool first = (c == 0 && t == 0);
      const LAS float* PR = (const LAS float*)(L + CK_PAR) + ((h >> 3) & 1) * 384 + 8 * jg;
      float xr[8], xk[8], xv[8], av[8], wv[8];
      { const u32x4 cr = icr, ck = ick, cv = icv; u32x4 pr = ipr, pk = ipk, pv = ipv; if (first) { pr = (u32x4){0u, 0u, 0u, 0u}; pk = pr; pv = pr; }
        const unsigned cw[3][4] = {{cr.x, cr.y, cr.z, cr.w}, {ck.x, ck.y, ck.z, ck.w}, {cv.x, cv.y, cv.z, cv.w}}, pw[3][4] = {{pr.x, pr.y, pr.z, pr.w}, {pk.x, pk.y, pk.z, pk.w}, {pv.x, pv.y, pv.z, pv.w}};
        float mr[8], mk[8], mv[8];
        { const f32x4 a0 = *(const LAS f32x4*)(PR), a1 = *(const LAS f32x4*)(PR + 4), b0 = *(const LAS f32x4*)(PR + 64), b1 = *(const LAS f32x4*)(PR + 68), d0 = *(const LAS f32x4*)(PR + 128), d1 = *(const LAS f32x4*)(PR + 132);
#pragma unroll
          for (int e = 0; e < 4; ++e) { mr[e] = a0[e]; mr[4 + e] = a1[e]; mk[e] = b0[e]; mk[4 + e] = b1[e]; mv[e] = d0[e]; mv[4 + e] = d1[e]; } }
#pragma unroll
        for (int e = 0; e < 8; ++e) { const int wi = e >> 1; const bool hi = e & 1;
            const float c_r = hi ? bfhi(cw[0][wi]) : bflo(cw[0][wi]), c_k = hi ? bfhi(cw[1][wi]) : bflo(cw[1][wi]), c_v = hi ? bfhi(cw[2][wi]) : bflo(cw[2][wi]);
            const float p_r = hi ? bfhi(pw[0][wi]) : bflo(pw[0][wi]), p_k = hi ? bfhi(pw[1][wi]) : bflo(pw[1][wi]), p_v = hi ? bfhi(pw[2][wi]) : bflo(pw[2][wi]);
            xr[e] = c_r + (p_r - c_r) * mr[e]; xk[e] = c_k + (p_k - c_k) * mk[e]; xv[e] = c_v + (p_v - c_v) * mv[e]; }
        { const f32x4 a0 = ia0, a1 = ia1, w0 = iw0, w1 = iw1;
#pragma unroll
          for (int e = 0; e < 4; ++e) { av[e] = a0[e]; av[4 + e] = a1[e]; wv[e] = w0[e]; wv[4 + e] = w1[e]; } } }
      CKIN_LOAD(i, next_task);
      float kmod[8], kk[8]; float n2 = 0.f, cbp = 0.f;
      { float ka_[8], kk_[8], rk_[8];
        { const f32x4 a0 = *(const LAS f32x4*)(PR + 192), a1 = *(const LAS f32x4*)(PR + 196), b0 = *(const LAS f32x4*)(PR + 256), b1 = *(const LAS f32x4*)(PR + 260), d0 = *(const LAS f32x4*)(PR + 320), d1 = *(const LAS f32x4*)(PR + 324);
#pragma unroll
          for (int e = 0; e < 4; ++e) { ka_[e] = a0[e]; ka_[4 + e] = a1[e]; kk_[e] = b0[e]; kk_[4 + e] = b1[e]; rk_[e] = d0[e]; rk_[4 + e] = d1[e]; } }
#pragma unroll
        for (int e = 0; e < 8; ++e) { kmod[e] = xk[e] * (1.0f + (av[e] - 1.0f) * ka_[e]); kk[e] = xk[e] * kk_[e]; n2 += kk[e] * kk[e]; cbp += xr[e] * kmod[e] * rk_[e]; } }
      const float inrm = 1.0f / fmaxf(sqrtf(red8(n2)), 1e-12f); const float cb = red8(cbp);
      if (jg == 0) CB[(size_t)m * 16 + h] = cb;
      { u32x4 o; o.x = pk2(xv[0], xv[1]); o.y = pk2(xv[2], xv[3]); o.z = pk2(xv[4], xv[5]); o.w = pk2(xv[6], xv[7]); *(u32x4*)(VVB + ((size_t)s * TP + 64 * c + t) * 64 + 8 * jg) = o; }
      float lw[8], lx[8];
#pragma unroll
      for (int e = 0; e < 8; ++e) { lw[e] = __log2f(wv[e]); lx[e] = lw[e]; }
#pragma unroll
      for (int e = 0; e < 8; ++e) lx[e] += __builtin_bit_cast(float, __builtin_amdgcn_update_dpp(0, __builtin_bit_cast(int, lx[e]), 0x118, 0xF, 0xF, true));
      { const int src2 = (jg + 8 * ((tl & 4) | 1)) << 2; const bool add2 = (tl & 2) != 0;
#pragma unroll
        for (int e = 0; e < 8; ++e) { const float y = __builtin_bit_cast(float, __builtin_amdgcn_ds_bpermute(src2, __builtin_bit_cast(int, lx[e]))); lx[e] += add2 ? y : 0.f; } }
      { const int src3 = (jg + 24) << 2; const bool add3 = (tl & 4) != 0;
#pragma unroll
        for (int e = 0; e < 8; ++e) { const float y = __builtin_bit_cast(float, __builtin_amdgcn_ds_bpermute(src3, __builtin_bit_cast(int, lx[e]))); lx[e] += add3 ? y : 0.f; } }
      LAS float* SEG = (LAS float*)(L + CK_GC + 256);
      if (tl == 7) { *(LAS f32x4*)(SEG + wave * 64 + 8 * jg) = (f32x4){lx[0], lx[1], lx[2], lx[3]}; *(LAS f32x4*)(SEG + wave * 64 + 8 * jg + 4) = (f32x4){lx[4], lx[5], lx[6], lx[7]}; }
      __syncthreads();
#pragma unroll
      for (int q = 0; q < 7; ++q) if (q < wave) { const f32x4 s0 = *(const LAS f32x4*)(SEG + q * 64 + 8 * jg), s1 = *(const LAS f32x4*)(SEG + q * 64 + 8 * jg + 4);
#pragma unroll
          for (int e = 0; e < 4; ++e) { lx[e] += s0[e]; lx[4 + e] += s1[e]; } }
      float ka[8], bt[8], kt[8], rt[8];
#pragma unroll
      for (int e = 0; e < 8; ++e) { const float lt = lx[e], lp = lt - lw[e];
          const float gt = __builtin_amdgcn_exp2f(lt), gp = __builtin_amdgcn_exp2f(lp), ig = __builtin_amdgcn_exp2f(-lt); const float kap = kk[e] * inrm;
          ka[e] = kap * gp; bt[e] = kap * av[e] * ig; kt[e] = kmod[e] * ig; rt[e] = xr[e] * gt; if (t == 63) GC[8 * jg + e] = gt; }
      { const int roff = t * 128 + ((jg ^ (t & 7)) << 4);
        u32x4 o; o.x = pk2(ka[0], ka[1]); o.y = pk2(ka[2], ka[3]); o.z = pk2(ka[4], ka[5]); o.w = pk2(ka[6], ka[7]); *(LAS u32x4*)(SLOT(0) + roff) = o;
        o.x = pk2(bt[0], bt[1]); o.y = pk2(bt[2], bt[3]); o.z = pk2(bt[4], bt[5]); o.w = pk2(bt[6], bt[7]); *(LAS u32x4*)(SLOT(1) + roff) = o;
        o.x = pk2(kt[0], kt[1]); o.y = pk2(kt[2], kt[3]); o.z = pk2(kt[4], kt[5]); o.w = pk2(kt[6], kt[7]); *(LAS u32x4*)(SLOT(2) + roff) = o;
        o.x = pk2(rt[0], rt[1]); o.y = pk2(rt[2], rt[3]); o.z = pk2(rt[4], rt[5]); o.w = pk2(rt[6], rt[7]); *(LAS u32x4*)(SLOT(3) + roff) = o;
        o.x = pk2(xv[0], xv[1]); o.y = pk2(xv[2], xv[3]); o.z = pk2(xv[4], xv[5]); o.w = pk2(xv[6], xv[7]); *(LAS u32x4*)(SLOT(15) + roff) = o; } }
    __syncthreads();
    f32x16 rtile = ck_zero();
    f32x16 aY = ck_zero(), aN = ck_zero();
    if (grp == 0) {
        { f32x16 a = ck_mm(SLOT(2), SLOT(0), mt, nt, ql, half, ck_zero());
#pragma unroll
          for (int r = 0; r < 16; ++r) { const int m = 32 * mt + ck_crow(r, half), n = 32 * nt + ql; a[r] = m < n ? a[r] : 0.f; }
          ck_store_t(SLOT(11), a, mt, nt, ql, half); }
        { f32x16 a = ck_mm(SLOT(2), SLOT(3), mt, nt, ql, half, ck_zero());
#pragma unroll
          for (int r = 0; r < 16; ++r) { const int m = 32 * mt + ck_crow(r, half), n = 32 * nt + ql; a[r] = m <= n ? a[r] : 0.f; }
          ck_store_t(SLOT(13), a, mt, nt, ql, half); }
        ck_tr(SLOT(0), SLOT(4), mt, nt, ql, half); ck_tr(SLOT(1), SLOT(5), mt, nt, ql, half); }
    else {
        { f32x16 a = ck_mm(SLOT(1), SLOT(0), mt, nt, ql, half, ck_zero());
#pragma unroll
          for (int r = 0; r < 16; ++r) { const int m = 32 * mt + ck_crow(r, half), n = 32 * nt + ql; a[r] = m < n ? -a[r] : 0.f; rtile[r] = a[r] + (m == n ? 1.0f : 0.f); }
          ck_store_t(SLOT(8), a, mt, nt, ql, half); ck_store_n(SLOT(9), a, mt, nt, ql, half); ck_store_t(SLOT(10), rtile, mt, nt, ql, half); }
        { f32x16 a = ck_mm(SLOT(1), SLOT(3), mt, nt, ql, half, ck_zero());
#pragma unroll
          for (int r = 0; r < 16; ++r) { const int m = 32 * mt + ck_crow(r, half), n = 32 * nt + ql; a[r] = m <= n ? a[r] : 0.f; }
          ck_store_t(SLOT(12), a, mt, nt, ql, half); }
        ck_tr(SLOT(2), SLOT(6), mt, nt, ql, half); ck_tr(SLOT(15), SLOT(7), mt, nt, ql, half); }
    __syncthreads();
#pragma unroll
    for (int lev = 1; lev <= 6; ++lev) {
        const int px = (lev & 1) ? 8 : 0, pxt = (lev & 1) ? 9 : 1, nx = (lev & 1) ? 0 : 8, nxt = (lev & 1) ? 1 : 9;
        const int rcur = (lev & 1) ? 2 : 10, rnxt = (lev & 1) ? 10 : 2;
        if (grp == 0) {
            if (lev <= 5) { const f32x16 a = ck_mm(SLOT(px), SLOT(pxt), mt, nt, ql, half, ck_zero());
                ck_store_t(SLOT(nxt), a, mt, nt, ql, half); ck_store_n(SLOT(nx), a, mt, nt, ql, half); }
            else aN = ck_mm(SLOT(6), SLOT(7), mt, nt, ql, half, ck_zero()); }
        else { if (lev == 1) { f32x16 a = ck_mm(SLOT(11), SLOT(7), mt, nt, ql, half, ck_zero()); ck_store_t(SLOT(14), a, mt, nt, ql, half);
                               aY = ck_mm(SLOT(7), SLOT(13), mt, nt, ql, half, ck_zero()); }
          if (lev >= 2) {
            const f32x16 a = ck_mm(SLOT(pxt), SLOT(rcur), mt, nt, ql, half, ck_zero());
#pragma unroll
            for (int r = 0; r < 16; ++r) rtile[r] += a[r];
            ck_store_t(SLOT(rnxt), rtile, mt, nt, ql, half); } }
        __syncthreads();
    }
    if (grp == 0) { f32x16 a = ck_mm(SLOT(2), SLOT(4), mt, nt, ql, half, ck_zero()); ck_store_t(SLOT(11), a, mt, nt, ql, half); }
    else { f32x16 a = ck_mm(SLOT(2), SLOT(14), mt, nt, ql, half, ck_zero()); ck_store_t(SLOT(15), a, mt, nt, ql, half); }
    __syncthreads();
    if (grp == 0) {
        { f32x16 a = ck_mm(SLOT(11), SLOT(5), mt, nt, ql, half, ck_zero());
          const int n = 32 * nt + ql; const float gc = GC[n];
#pragma unroll
          for (int r = 0; r < 16; ++r) { const int m = 32 * mt + ck_crow(r, half); a[r] = ((m == n ? 1.0f : 0.f) - a[r]) * gc; }
          ck_store_t(SLOT(8), a, mt, nt, ql, half); }
        { const f32x16 a2 = ck_mm(SLOT(5), SLOT(15), mt, nt, ql, half, ck_zero());
          unsigned char* N = outp + 16384 + (mt * 2 + nt) * 2048 + lane * 16; u32x4 w0, w1; unsigned pw[8];
#pragma unroll
          for (int g = 0; g < 4; ++g) { const int m0 = 32 * mt + 8 * g + 4 * half; float v[4];
#pragma unroll
              for (int e = 0; e < 4; ++e) v[e] = (aN[4 * g + e] - a2[4 * g + e]) * GC[m0 + e];
              pw[2 * g] = pk2(v[0], v[1]); pw[2 * g + 1] = pk2(v[2], v[3]); }
          w0 = (u32x4){pw[0], pw[1], pw[2], pw[3]}; w1 = (u32x4){pw[4], pw[5], pw[6], pw[7]}; *(u32x4*)N = w0; *(u32x4*)(N + 1024) = w1; } }
    else {
        { f32x16 a = ck_mm(SLOT(11), SLOT(12), mt, nt, ql, half, ck_zero());
          const int n = 32 * nt + ql;
#pragma unroll
          for (int g = 0; g < 4; ++g) { const int m0 = 32 * mt + 8 * g + 4 * half; const u32x2 rw = *(const LAS u32x2*)(SLOT(3) + n * 128 + (((m0 >> 3) ^ (n & 7)) << 4) + (m0 & 4) * 2);
              a[4 * g] = bflo(rw.x) - a[4 * g]; a[4 * g + 1] = bfhi(rw.x) - a[4 * g + 1]; a[4 * g + 2] = bflo(rw.y) - a[4 * g + 2]; a[4 * g + 3] = bfhi(rw.y) - a[4 * g + 3]; }
          ck_store_t(SLOT(9), a, mt, nt, ql, half); }
        { const f32x16 a2 = ck_mm(SLOT(15), SLOT(12), mt, nt, ql, half, ck_zero());
          unsigned char* Yl = outp + 24576 + (mt * 2 + nt) * 2048 + lane * 16; unsigned pw[8];
#pragma unroll
          for (int g = 0; g < 4; ++g) { pw[2 * g] = pk2(aY[4 * g] - a2[4 * g], aY[4 * g + 1] - a2[4 * g + 1]); pw[2 * g + 1] = pk2(aY[4 * g + 2] - a2[4 * g + 2], aY[4 * g + 3] - a2[4 * g + 3]); }
          *(u32x4*)Yl = (u32x4){pw[0], pw[1], pw[2], pw[3]}; *(u32x4*)(Yl + 1024) = (u32x4){pw[4], pw[5], pw[6], pw[7]}; } }
    __syncthreads();
    { const int row = tid >> 3, ch = tid & 7; const int off = row * 128 + ((ch ^ (row & 7)) << 4);
      *(u32x4*)(outp + tid * 16) = *(const LAS u32x4*)(SLOT(8) + off); *(u32x4*)(outp + 8192 + tid * 16) = *(const LAS u32x4*)(SLOT(9) + off); }
#undef SLOT
}
__device__ __forceinline__ void chunk_chain(const P& p, Frame& F, int s) {
    const int b = s >> 4, h = s & 15;
    bf16* YRAW = (bf16*)(p.ws + WS_YRAW);
    int tid = threadIdx.x; asm volatile("" : "+v"(tid));
    const int lane = tid & 63, wave = __builtin_amdgcn_readfirstlane(tid >> 6), ql = lane & 31, half = lane >> 5, grp = wave >> 2, mt = (wave >> 1) & 1, nt = wave & 1;
    LAS unsigned char* L = F.lds;
    __syncthreads();
    for (int i = tid; i < 2048; i += NTHR) ((LAS unsigned*)L)[i] = 0u;
    f32x16 sacc = ck_zero();
    const int n = 32 * nt + ql;
    const int noff = (grp == 0 ? 16384 : 24576) + (mt * 2 + nt) * 2048 + lane * 16;
    const unsigned char* base = p.ws + WS_CHK + (size_t)(s * 32) * CK_TASK_BYTES;
    u32x4 pmR[4], pqR[4], n0R[4], n1R[4];
#define CH_LOAD(slot, cc) do { const unsigned char* src_ = base + (size_t)(cc) * CK_TASK_BYTES; pmR[slot] = *(const u32x4*)(src_ + tid * 16); pqR[slot] = *(const u32x4*)(src_ + 8192 + tid * 16); \
        n0R[slot] = *(const u32x4*)(src_ + noff); n1R[slot] = *(const u32x4*)(src_ + noff + 1024); } while (0)
#pragma unroll
    for (int u = 0; u < 4; ++u) CH_LOAD(u, u);
    const int ioff = (tid >> 3) * 128 + (((tid & 7) ^ ((tid >> 3) & 7)) << 4);
    *(LAS u32x4*)(L + 2 * CK_SLOT + ioff) = pmR[0]; *(LAS u32x4*)(L + 4 * CK_SLOT + ioff) = pqR[0];
    __syncthreads();
    for (int c4 = 0; c4 < 32; c4 += 4) {
#pragma unroll
      for (int u = 0; u < 4; ++u) { const int c = c4 + u, cur = u & 1;
        f32x4 ad[4];
        { const u32x4 w0 = n0R[u], w1 = n1R[u];
          ad[0] = (f32x4){bflo(w0.x), bfhi(w0.x), bflo(w0.y), bfhi(w0.y)}; ad[1] = (f32x4){bflo(w0.z), bfhi(w0.z), bflo(w0.w), bfhi(w0.w)};
          ad[2] = (f32x4){bflo(w1.x), bfhi(w1.x), bflo(w1.y), bfhi(w1.y)}; ad[3] = (f32x4){bflo(w1.z), bfhi(w1.z), bflo(w1.w), bfhi(w1.w)}; }
        if (c + 4 < 32) CH_LOAD(u, c + 4);
        if (grp == 0) {
            sacc = ck_mm(L + (2 + cur) * CK_SLOT, L + cur * CK_SLOT, mt, nt, ql, half, ck_zero());
#pragma unroll
            for (int g = 0; g < 4; ++g)
#pragma unroll
                for (int e = 0; e < 4; ++e) sacc[4 * g + e] += ad[g][e];
            ck_store_t(L + (cur ^ 1) * CK_SLOT, sacc, mt, nt, ql, half);
        } else {
            const f32x16 a = ck_mm(L + cur * CK_SLOT, L + (4 + cur) * CK_SLOT, mt, nt, ql, half, ck_zero());
            bf16* yrow = YRAW + (size_t)(b * TP + 64 * c + n) * 1024 + h * 64;
#pragma unroll
            for (int g = 0; g < 4; ++g) { u32x2 w; w.x = pk2(a[4 * g] + ad[g][0], a[4 * g + 1] + ad[g][1]); w.y = pk2(a[4 * g + 2] + ad[g][2], a[4 * g + 3] + ad[g][3]);
                *(u32x2*)(yrow + 32 * mt + 8 * g + 4 * half) = w; } }
        if (c + 1 < 32) { *(LAS u32x4*)(L + (2 + (cur ^ 1)) * CK_SLOT + ioff) = pmR[(u + 1) & 3]; *(LAS u32x4*)(L + (4 + (cur ^ 1)) * CK_SLOT + ioff) = pqR[(u + 1) & 3]; }
        __syncthreads();
      }
    }
#undef CH_LOAD
    if (grp == 0) { float* So = p.out + O_RP + (size_t)s * 4096;
#pragma unroll
        for (int g = 0; g < 4; ++g) *(f32x4*)(So + n * 64 + 32 * mt + 8 * g + 4 * half) = (f32x4){sacc[4 * g], sacc[4 * g + 1], sacc[4 * g + 2], sacc[4 * g + 3]}; }
}
constexpr int CS_A = 160 * 128, CS_BUF = CS_A + 256 * 128;
__device__ __forceinline__ void cmp1_fused(const P& p, Frame& F) {
    const bf16* KVN = (const bf16*)(p.ws + WS_KVN); bf16* HID = (bf16*)(p.ws + WS_HID); const float* pe = p.in[I_PE]; const float* ckv = p.in[I_CKV]; const int* pt = (const int*)p.in[I_PT];
    int tid = threadIdx.x; asm volatile("" : "+v"(tid));
    const int lane = tid & 63, wave = __builtin_amdgcn_readfirstlane(tid >> 6), ql = lane & 31, half = lane >> 5, l16 = tid & 15, r32 = tid >> 4, p8 = tid & 7, r64 = tid >> 3;
    const bool pth = lane < 8; const int pr = wave, pp = lane & 7;
    LAS unsigned char* L = F.lds;
    __syncthreads();
    for (int unit = F.bid; unit < 256; unit += F.G) {
        const int kv = unit >> 7, blk = unit & 127;
        unsigned aoff[4];
#pragma unroll
        for (int j = 0; j < 4; ++j) { const int Rs = blk * 128 + r32 + 32 * j, b = Rs >> 9, n = (Rs >> 1) & 255, g = Rs & 1; const int page = pt[b * NPAGES + (n >> 2)];
            aoff[j] = (unsigned)(((page * PAGE + (n & 3) * 32) * 4 + kv) * 256 + g * 128 + 4 * l16); }
        unsigned poff = 0;
        if (pth) { const int R = blk * 8 + pr, b = R >> 7, n = (R >> 1) & 63, g = R & 1; poff = (unsigned)((b * TP + n * 32) * 1024 + kv * 256 + g * 128 + 8 * pp); }
        const bf16* W = (const bf16*)(p.ws + WS_CW1) + (size_t)kv * 256 * 4096 + (size_t)r64 * 4096 + 8 * p8;
        f32x16 acc[5];
#pragma unroll
        for (int mt = 0; mt < 5; ++mt) acc[mt] = ck_zero();
        for (int i = tid; i < 24 * 32; i += NTHR) { ((LAS unsigned*)(L + 136 * 128))[i] = 0u; ((LAS unsigned*)(L + CS_BUF + 136 * 128))[i] = 0u; }
        f32x4 ga[2][4], gp[2]; u32x4 gb[2][4], gq[2]; f32x4 gq0[2], gq1[2];
#define C1_LOAD(set, s_) do { const int pos_ = (s_) >> 1, dh_ = (s_) & 1; const unsigned ko_ = (unsigned)(pos_ * 1024 + dh_ * 64); \
            _Pragma("unroll") for (int j_ = 0; j_ < 4; ++j_) ga[set][j_] = *(const f32x4*)(ckv + (aoff[j_] + ko_)); \
            gp[set] = *(const f32x4*)(pe + (pos_ * 2 + kv) * 128 + dh_ * 64 + 4 * l16); \
            _Pragma("unroll") for (int j_ = 0; j_ < 4; ++j_) gb[set][j_] = *(const u32x4*)(W + (size_t)(64 * j_) * 4096 + (s_) * 64); \
            if (pth) { gq[set] = *(const u32x4*)(KVN + (poff + ko_)); const float* pq_ = pe + (pos_ * 2 + kv) * 128 + dh_ * 64 + 8 * pp; gq0[set] = *(const f32x4*)pq_; gq1[set] = *(const f32x4*)(pq_ + 4); } } while (0)
#define C1_PUT(set, buf_) do { LAS unsigned char* A_ = L + (buf_) * CS_BUF; LAS unsigned char* B_ = A_ + CS_A; \
            _Pragma("unroll") for (int j_ = 0; j_ < 4; ++j_) { const int rr_ = r32 + 32 * j_; const f32x4 v_ = ga[set][j_] + gp[set]; u32x2 w_; w_.x = pk2(v_.x, v_.y); w_.y = pk2(v_.z, v_.w); \
                *(LAS u32x2*)(A_ + rr_ * 128 + (((l16 >> 1) ^ (rr_ & 7)) << 4) + (l16 & 1) * 8) = w_; } \
            _Pragma("unroll") for (int j_ = 0; j_ < 4; ++j_) { const int nb_ = r64 + 64 * j_; *(LAS u32x4*)(B_ + nb_ * 128 + ((p8 ^ (nb_ & 7)) << 4)) = gb[set][j_]; } \
            if (pth) { const u32x4 q_ = gq[set]; const int rr_ = 128 + pr; \
                const f32x4 a_ = (f32x4){bflo(q_.x), bfhi(q_.x), bflo(q_.y), bfhi(q_.y)} + gq0[set], b_ = (f32x4){bflo(q_.z), bfhi(q_.z), bflo(q_.w), bfhi(q_.w)} + gq1[set]; \
                u32x4 o_; o_.x = pk2(a_.x, a_.y); o_.y = pk2(a_.z, a_.w); o_.z = pk2(b_.x, b_.y); o_.w = pk2(b_.z, b_.w); *(LAS u32x4*)(A_ + rr_ * 128 + ((pp ^ (rr_ & 7)) << 4)) = o_; } } while (0)
        C1_LOAD(0, 0); C1_LOAD(1, 1);
        __syncthreads();
        C1_PUT(0, 0); C1_LOAD(0, 2);
        __syncthreads();
#pragma nounroll
        for (int s2 = 0; s2 < 64; s2 += 2) {
#pragma unroll
            for (int u = 0; u < 2; ++u) { const int s = s2 + u;
                const LAS unsigned char* A_ = L + u * CS_BUF; const LAS unsigned char* B_ = A_ + CS_A; const int sw = ql & 7;
#pragma unroll
                for (int ks = 0; ks < 4; ++ks) { const int off = ((2 * ks + half) ^ sw) << 4; const bf16x8 bfr = *(const LAS bf16x8*)(B_ + (32 * wave + ql) * 128 + off);
#pragma unroll
                    for (int mt = 0; mt < 5; ++mt) { const bf16x8 afr = *(const LAS bf16x8*)(A_ + (32 * mt + ql) * 128 + off); acc[mt] = MFMA32(bfr, afr, acc[mt]); } }
                if (s + 1 < 64) C1_PUT(u ^ 1, u ^ 1);
                if (s + 3 < 64) C1_LOAD(u ^ 1, s + 3);
                __syncthreads();
            }
        }
#undef C1_LOAD
#undef C1_PUT
#pragma unroll
        for (int mt = 0; mt < 5; ++mt) { const int rl = 32 * mt + ql; if (rl < 136) { const size_t row = (size_t)kv * CMPROWS + (rl < 128 ? 1024 + blk * 128 + rl : blk * 8 + (rl - 128));
#pragma unroll
                for (int g = 0; g < 4; ++g) { u32x2 w; w.x = pk2(gelu_tanh(acc[mt][4 * g]), gelu_tanh(acc[mt][4 * g + 1])); w.y = pk2(gelu_tanh(acc[mt][4 * g + 2]), gelu_tanh(acc[mt][4 * g + 3]));
                    *(u32x2*)(HID + row * 256 + 32 * wave + 8 * g + 4 * half) = w; } } }
    }
}
#define PG8_ALIGN true
#define PG8_SP2 true
template <int LO, int HI> __global__ void __launch_bounds__(NTHR, 2) mega(P p) {
    extern __shared__ __attribute__((aligned(16))) unsigned char lds_[];
    Frame F; F.lds = (LAS unsigned char*)lds_; F.tid = threadIdx.x; F.lane = F.tid & 63; F.wave = __builtin_amdgcn_readfirstlane(F.tid >> 6); F.G = gridDim.x; F.bid = blockIdx.x;
    volatile LAS unsigned* MISC = (volatile LAS unsigned*)(F.lds + MISC_OFF);
    if (F.tid < 32) MISC[F.tid] = 0u;
    __syncthreads();
    unsigned char* ws = p.ws;
    constexpr bool fused = (HI - LO) > 1;
    XcdBarrier bar; bar.bar = (unsigned*)(ws + WS_CTL) + CW_BAR; bar.x = 0; bar.st = MISC + 8;
    if (fused) bar = xcd_barrier_post((unsigned*)(ws + WS_CTL) + CW_BAR, MISC + 8);
#define IN(k) (LO <= (k) && (k) < HI)
#define SEAM(k) do { if (IN(k) && IN((k) + 1)) xcd_barrier(bar); { int t_ = threadIdx.x; asm volatile("" : "+v"(t_)); F.tid = t_; F.lane = t_ & 63; F.wave = __builtin_amdgcn_readfirstlane(t_ >> 6); } } while (0)
    bf16* H = (bf16*)(ws + WS_H); bf16* ACT = (bf16*)(ws + WS_ACT); bf16* FB = (bf16*)(ws + WS_F); bf16* X1 = (bf16*)(ws + WS_X1);

    if (IN(0)) { p0_prologue(p, F); }
    SEAM(0);
    if (IN(1)) {
        pg8::Gemm g{H, (const bf16*)(ws + WS_W13A), MP, 2 * DFF, D}; pg8::StaticOrder S; S.init(MP, 2 * DFF, F.G, F.bid);
        EpiSwiglu E{ACT};
        pg8::gemm_phase<EpiSwiglu, pg8::StaticOrder, PG8_ALIGN, PG8_SP2>(F.lds + RING_OFF, g, S, E);
        skinny_gemm<32, 2, 2>(F, H + (size_t)MP * D, D, (const bf16*)(ws + WS_W13A), DFF / 32, SkSwiglu{ACT});
    }
    SEAM(1);
    if (IN(2)) {
        pg8::Gemm g{ACT, (const bf16*)(ws + WS_W2A), MP, D, DFF}; pg8::StaticOrder S; S.init(MP, D, F.G, F.bid);
        EpiStore E{FB, D};
        pg8::gemm_phase<EpiStore, pg8::StaticOrder, PG8_ALIGN, PG8_SP2>(F.lds + RING_OFF, g, S, E);
        skinny_gemm2d<8>(F, ACT + (size_t)MP * DFF, DFF, (const bf16*)(ws + WS_W2A), SkStore{FB, D});
    }
    SEAM(2);
    if (IN(3)) { thin_phase<false, true>(F, FB, p.in[I_XP], p.in[I_XS], p.in[I_F1POST], 0.5f, X1, p.in[I_MIXPRE], H); }
    SEAM(3);
    if (IN(4)) {
        pg8::Gemm g{H, (const bf16*)(ws + WS_WINT), MP, NPADW, D}; pg8::StaticOrder S; S.init(MP, NPADW, F.G, F.bid);
        EpiWin E{(bf16*)(ws + WS_PRW), (bf16*)(ws + WS_Q), (bf16*)(ws + WS_KVN), (bf16*)(ws + WS_WINN), (bf16*)(ws + WS_GRW), (bf16*)(ws + WS_GNSA), (float*)(ws + WS_NG), p.out};
        pg8::gemm_phase<EpiWin, pg8::StaticOrder, PG8_ALIGN, PG8_SP2>(F.lds + RING_OFF, g, S, E);
        skinny_gemm<40, 1, 3>(F, H + (size_t)MP * D, D, (const bf16*)(ws + WS_WINT), NPADW / 40, SkWin{E.PRW, E.Q, E.KVN, E.WINN, E.GRW, E.GNSA, E.NG, E.out});
    }
    SEAM(4);
    if (IN(5)) { lora_prep(p, F); }
    SEAM(5);
    if (IN(6)) {
#pragma nounroll
        for (int half_ = 0; half_ < 2; ++half_) {
            if ((half_ ^ (F.bid & 1)) == 0) {
                { int kl = 256; asm volatile("" : "+s"(kl));
                  pg8::Gemm g{(const bf16*)(ws + WS_ALORA), (const bf16*)(ws + WS_WLORA), MP, 3072, kl}; pg8::StaticOrder S; S.init(MP, 3072, F.G, F.bid);
                  EpiLora E{(float*)(ws + WS_DEC), (float*)(ws + WS_AA), (float*)(ws + WS_GG), p.in[I_W0], p.in[I_A0]};
                  pg8::gemm_phase<EpiLora, pg8::StaticOrder, PG8_ALIGN, PG8_SP2>(F.lds + RING_OFF, g, S, E);
                  skinny_gemm<12, 1, 2>(F, (const bf16*)(ws + WS_ALORA) + (size_t)MP * 256, kl, (const bf16*)(ws + WS_WLORA), 3072 / 12, SkLora{E.DEC, E.AA, E.GG, E.w0, E.a0}); }
                vt_build(p, F, F.bid, F.G);
            } else cmp1_fused(p, F);
            __syncthreads();
        }
    }
    SEAM(6);
    if (IN(7)) {
        { pg8::Gemm g{(const bf16*)(ws + WS_HID), (const bf16*)(ws + WS_CW2), 2 * CMPROWS, 512, 256}; DiagOrder S{F.G, F.bid};
          EpiCmp2 E{(float*)(ws + WS_KC)};
          pg8::gemm_phase<EpiCmp2, DiagOrder, PG8_ALIGN, PG8_SP2>(F.lds + RING_OFF, g, S, E); }
        __syncthreads();
        scan_prep(p, F);
        if (F.bid < NSEQ_P * 32) {
            CKIN_DECL(i); CKIN_LOAD(i, F.bid); int ptag0 = -1, ptag1 = -1;
            __syncthreads();
            for (int task = F.bid; task < NSEQ_P * 32; task += F.G) chunk_pre(p, F, task, task + F.G < NSEQ_P * 32 ? task + F.G : task, icr, ick, icv, ipr, ipk, ipv, ia0, ia1, iw0, iw1, ptag0, ptag1); }
    }
    SEAM(7);
    if (IN(8)) {
        if (F.G >= 256) { if (F.bid < NSEQ_P) chunk_chain(p, F, F.bid); else scan_sample(p, F, F.bid - NSEQ_P, F.G - NSEQ_P); }
        else { for (int s = F.bid; s < NSEQ_P; s += F.G) chunk_chain(p, F, s); scan_sample(p, F, F.bid, F.G); }
        __syncthreads();
        { unsigned* qctr = (unsigned*)(ws + WS_CTL) + 8192;
#pragma nounroll
          for (;;) {
              if (F.tid == 0) MISC[0] = __hip_atomic_fetch_add(qctr, 1u, __ATOMIC_RELAXED, __HIP_MEMORY_SCOPE_AGENT);
              __syncthreads();
              const int k = (int)MISC[0];
              __syncthreads();
              constexpr int NATT = 576, NCONV = (TR_NLATE + 15) / 16;
              if (k >= NATT + NCONV) break;
              int ia = -1, ic = -1;
              if (k < 2 * NATT) { if (k & 1) ic = k >> 1; else ia = k >> 1; } else ic = k - NATT;
              if (ic >= 0) { tr_late_batch(p, F, ic); continue; }
              const bool is_s = ia < 64; const int kk = is_s ? ia : ia - 64;
              attn_item(p, F, is_s, is_s ? kk >> 1 : (kk & 15) >> 1, kk & 1, is_s ? 0 : 31 - (kk >> 4)); } }
    }
    SEAM(8);
    if (IN(9)) { rwkv_post(p, F); }
    SEAM(9);
    if (IN(10)) {
        pg8::Gemm g{(const bf16*)(ws + WS_YRW), (const bf16*)(ws + WS_WBRW), MP, D, 1024}; pg8::StaticOrder S; S.init(MP, D, F.G, F.bid);
        EpiMerge<0> E{(const bf16*)(ws + WS_GRW), (bf16*)(ws + WS_MRG), (bf16*)(ws + WS_PARK)};
        pg8::gemm_phase<EpiMerge<0>, pg8::StaticOrder, PG8_ALIGN, PG8_SP2>(F.lds + RING_OFF, g, S, E);
        skinny_gemm2d<8>(F, (const bf16*)(ws + WS_YRW) + (size_t)MP * 1024, 1024, (const bf16*)(ws + WS_WBRW), SkMerge<0>{E.GATE, E.MRG});
        __syncthreads();
    }
    if (IN(10)) {
        pg8::Gemm g{(const bf16*)(ws + WS_YNSA), (const bf16*)(ws + WS_WBNSA), MP, D, 1024}; pg8::StaticOrder S; S.init(MP, D, F.G, F.bid);
        EpiMerge<1> E{(const bf16*)(ws + WS_GNSA), (bf16*)(ws + WS_MRG), (bf16*)(ws + WS_PARK)};
        pg8::gemm_phase<EpiMerge<1>, pg8::StaticOrder, PG8_ALIGN, PG8_SP2>(F.lds + RING_OFF, g, S, E);
        skinny_gemm2d<8>(F, (const bf16*)(ws + WS_YNSA) + (size_t)MP * 1024, 1024, (const bf16*)(ws + WS_WBNSA), SkMerge<1>{E.GATE, E.MRG});
    }
    SEAM(11);
    if (IN(12)) {
        pg8::Gemm g{(const bf16*)(ws + WS_MRG), (const bf16*)(ws + WS_WOUT), MP, D, D}; pg8::StaticOrder S; S.init(MP, D, F.G, F.bid);
        EpiStore E{FB, D};
        pg8::gemm_phase<EpiStore, pg8::StaticOrder, PG8_ALIGN, PG8_SP2>(F.lds + RING_OFF, g, S, E);
        skinny_gemm2d<8>(F, (const bf16*)(ws + WS_MRG) + (size_t)MP * D, D, (const bf16*)(ws + WS_WOUT), SkStore{FB, D});
    }
    SEAM(12);
    if (IN(13)) { thin_phase<true, true>(F, FB, X1, X1 + (size_t)MP * D, p.in[I_MIXPOST], 1.0f, X1, p.in[I_F2PRE], H); }
    SEAM(13);
    if (IN(14)) {
        pg8::Gemm g{H, (const bf16*)(ws + WS_W13B), MP, 2 * DFF, D}; pg8::StaticOrder S; S.init(MP, 2 * DFF, F.G, F.bid);
        EpiSwiglu E{ACT};
        pg8::gemm_phase<EpiSwiglu, pg8::StaticOrder, PG8_ALIGN, PG8_SP2>(F.lds + RING_OFF, g, S, E);
        skinny_gemm<32, 2, 2>(F, H + (size_t)MP * D, D, (const bf16*)(ws + WS_W13B), DFF / 32, SkSwiglu{ACT});
    }
    SEAM(14);
    if (IN(15)) {
        pg8::Gemm g{ACT, (const bf16*)(ws + WS_W2B), MP, D, DFF}; pg8::StaticOrder S; S.init(MP, D, F.G, F.bid);
        EpiStore E{FB, D};
        pg8::gemm_phase<EpiStore, pg8::StaticOrder, PG8_ALIGN, PG8_SP2>(F.lds + RING_OFF, g, S, E);
        skinny_gemm2d<8>(F, ACT + (size_t)MP * DFF, DFF, (const bf16*)(ws + WS_W2B), SkStore{FB, D});
    }
    SEAM(15);
    if (IN(16)) { thin_phase<true, false>(F, FB, X1, X1 + (size_t)MP * D, p.in[I_F2POST], 0.5f, p.out + O_Y, nullptr, nullptr); }
#undef IN
#undef SEAM
}
constexpr int NPHASES = 17;

template <int K> struct PhaseLaunch {
    static bool setup() { if (hipFuncSetAttribute((const void*)mega<K, K + 1>, hipFuncAttributeMaxDynamicSharedMemorySize, LDS_BYTES) != hipSuccess) return false; return PhaseLaunch<K + 1>::setup(); }
    static void run(const P& p, int grid, hipStream_t stream) { hipLaunchKernelGGL((mega<K, K + 1>), dim3(grid), dim3(NTHR), LDS_BYTES, stream, p); PhaseLaunch<K + 1>::run(p, grid, stream); }
};
template <> struct PhaseLaunch<NPHASES> { static bool setup() { return true; } static void run(const P&, int, hipStream_t) {} };
static bool setup_all() {
#if MK_FUSED
    return hipFuncSetAttribute((const void*)mega<0, NPHASES>, hipFuncAttributeMaxDynamicSharedMemorySize, LDS_BYTES) == hipSuccess;
#else
    return PhaseLaunch<0>::setup();
#endif
}
static void launch_all(const P& p, int grid, hipStream_t stream) {
#if !MK_FUSED
    PhaseLaunch<0>::run(p, grid, stream);
#endif
}
extern "C" void kernel_launch(void* const* d_in, const int* in_sizes, int n_in, void* d_out, int out_size, void* d_ws, size_t ws_size, hipStream_t stream) {
    static int grid = 0;
    if (grid == 0) {
        if (n_in != 38 || out_size != (int)O_END || ws_size < WS_END) { fprintf(stderr, "kernel_launch: unexpected shapes: n_in %d out %d ws %zu (need %zu)\n", n_in, out_size, ws_size, (size_t)WS_END); grid = -1; return; }
        int dev = 0, cus = 0, per_cu = 0;
        if (hipGetDevice(&dev) != hipSuccess || hipDeviceGetAttribute(&cus, hipDeviceAttributeMultiprocessorCount, dev) != hipSuccess) { grid = -1; return; }
        if (!setup_all()) { fprintf(stderr, "kernel_launch: hipFuncSetAttribute failed\n"); grid = -1; return; }
        grid = cus;
    }
    if (grid < 0) return;
    (void)hipMemsetAsync((char*)d_ws + WS_CTL, 0, CTL_BYTES, stream);
    P p{};
    for (int i = 0; i < 38; ++i) p.in[i] = (const float*)d_in[i];
    p.out = (float*)d_out; p.ws = (unsigned char*)d_ws;
#if MK_FUSED
    hipLaunchKernelGGL((mega<0, NPHASES>), dim3(grid), dim3(NTHR), LDS_BYTES, stream, p);
#else
    launch_all(p, grid, stream);
#endif
}
```

```cpp
#include <hip/hip_runtime.h>
#include <cstdio>
#include <cstdint>
#include <cmath>
#define MK_FUSED 1
namespace pg8 {
#define PG8_LAS __attribute__((address_space(3)))
typedef unsigned short bf16_t;
typedef short bf16x8 __attribute__((ext_vector_type(8)));
typedef float f32x4 __attribute__((ext_vector_type(4)));
typedef unsigned u32x4 __attribute__((ext_vector_type(4)));
constexpr int BM = 256, BK = 64, HALF = 128, HTB = HALF * BK * 2  , STAGE_BYTES = 8 * HTB, NXCD = 8, WGM = 8;

__host__ __device__ __forceinline__ int lds_byte(int r, int c) { const int st = (r >> 4) * 2 + (c >> 5), rr = r & 15, cc = c & 31, ob = rr * 64 + cc * 2; return st * 1024 + (ob ^ (((ob >> 9) & 1) << 5)); }
__host__ __device__ __forceinline__ void stage_rc(int b, int& R, int& C) { const int st = b / 1024, sb = b % 1024, swz = sb ^ (((sb >> 9) & 1) << 5); R = (st >> 1) * 16 + swz / 64; C = (st & 1) * 32 + (swz % 64) / 2; }
__host__ __device__ __forceinline__ int perm32(int rho) { const int n = rho >> 4, i = rho & 15; return 8 * (i >> 2) + 4 * n + (i & 3); }

struct Unit { int pm, pn; };
struct Gemm { const bf16_t* A; const bf16_t* Bt; int M, N, K; };

struct StaticOrder {
    int nM, nN, nwg, G, c;
    __host__ __device__ void init(int M, int N, int G_, int c_) { nM = M / BM; nN = N / BM; nwg = nM * nN; G = G_; c = c_; }
    __host__ __device__ bool next(int i, Unit& u) const {
        const long L = (long)i * G + c; if (L >= nwg) return false;
        int wgid = (int)L; { const int q = nwg / NXCD, r = nwg % NXCD, xcd = wgid % NXCD, off = wgid / NXCD; wgid = (xcd < r ? xcd * (q + 1) : r * (q + 1) + (xcd - r) * q) + off; }
        const int nig = WGM * nN, gid = wgid / nig, fm = gid * WGM, gsz = (nM - fm) < WGM ? (nM - fm) : WGM;
        u.pm = fm + ((wgid % nig) % gsz); u.pn = (wgid % nig) / gsz; return true;
    }
    __device__ __forceinline__ void a_ready(const Unit&) const {}
    __device__ __forceinline__ void done(const Unit&) const {}
};

__device__ __forceinline__ unsigned cvt_pk_bf16(float lo, float hi) { unsigned r; asm volatile("v_cvt_pk_bf16_f32 %0, %1, %2" : "=v"(r) : "v"(lo), "v"(hi)); return r; }
typedef float f32x2 __attribute__((ext_vector_type(2)));
template <class Epi, class Sched, bool ALIGN_EPI = false, bool SP2 = false>
__device__ __forceinline__ void gemm_phase(PG8_LAS unsigned char* lds, const Gemm g, const Sched& S, const Epi& E) {
    int tid_ = threadIdx.x; asm volatile("" : "+v"(tid_));
    const int tid = tid_, wid = __builtin_amdgcn_readfirstlane(tid >> 6), lane = tid & 63, wr = wid >> 2, wc = wid & 3, fr = lane & 15, fq = lane >> 4;
    const int K = g.K, nt = K / BK;
    unsigned voffA[2], voffB[2];
#pragma unroll
    for (int i = 0; i < 2; ++i) { int R, C; stage_rc(tid * 16 + i * 8192, R, C); const int Rb = Epi::PERM ? ((R & ~31) + perm32(R & 31)) : R;
        voffA[i] = (unsigned)(R * K + C) * 2u; voffB[i] = (unsigned)(Rb * K + C) * 2u; }
    const size_t kstep = (size_t)(BK * 2);
    const size_t hstep = (size_t)HALF * K * 2;
    const size_t tstep = 2 * hstep;
    const unsigned ldsw = (unsigned)wid * 1024u;
    const int aoff = lds_byte(wr * 64 + fr, fq * 8), boff = lds_byte(wc * 32 + fr, fq * 8);
#define PG8_SA(b, h) (((b) * 2 + (h)) * HTB)
#define PG8_SB(b, h) ((4 + (b) * 2 + (h)) * HTB)
#define PG8_STAGE(bufoff, gbase, voff) do { _Pragma("unroll") for (int _i = 0; _i < 2; ++_i) \
        __builtin_amdgcn_global_load_lds((const unsigned*)((const char*)(gbase) + (voff)[_i]), (PG8_LAS unsigned*)(lds + (bufoff) + ldsw + _i * 8192), 16, 0, 0); } while (0)
#define PG8_LDA(dst, b, h) do { _Pragma("unroll") for (int m = 0; m < 4; ++m) _Pragma("unroll") for (int k = 0; k < 2; ++k) dst[m][k] = *(const PG8_LAS bf16x8*)(lds + PG8_SA(b, h) + aoff + m * 2048 + k * 1024); } while (0)
#define PG8_LDB(dst, b, h) do { _Pragma("unroll") for (int n = 0; n < 2; ++n) _Pragma("unroll") for (int k = 0; k < 2; ++k) dst[n][k] = *(const PG8_LAS bf16x8*)(lds + PG8_SB(b, h) + boff + n * 2048 + k * 1024); } while (0)
#define PG8_MMA(ai, bj, At, Bt) do { __builtin_amdgcn_s_setprio(1); _Pragma("unroll") for (int m = 0; m < 4; ++m) _Pragma("unroll") for (int n = 0; n < 2; ++n) _Pragma("unroll") for (int k = 0; k < 2; ++k) \
        acc[ai][bj][m][n] = __builtin_amdgcn_mfma_f32_16x16x32_bf16(Bt[n][k], At[m][k], acc[ai][bj][m][n], 0, 0, 0); __builtin_amdgcn_s_setprio(0); } while (0)
#define PG8_WAIT_V(n) asm volatile("s_waitcnt vmcnt(" #n ")" ::: "memory")
#define PG8_WAIT_L(n) asm volatile("s_waitcnt lgkmcnt(" #n ")" ::: "memory")
#define PG8_BAR __builtin_amdgcn_s_barrier()
#define PG8_SCHED __builtin_amdgcn_sched_barrier(0)
    Unit cur, nxt; int ui = 0;
    if (!S.next(0, cur)) return;
    f32x4 acc[2][2][4][2];
#pragma unroll
    for (int a = 0; a < 2; ++a)
#pragma unroll
        for (int b = 0; b < 2; ++b)
#pragma unroll
            for (int m = 0; m < 4; ++m)
#pragma unroll
                for (int n = 0; n < 2; ++n) acc[a][b][m][n] = (f32x4){0.f, 0.f, 0.f, 0.f};
    bf16x8 At[4][2], B0[2][2], B1[2][2];
    const char* cA = (const char*)g.A + (size_t)cur.pm * tstep; const char* cB = (const char*)g.Bt + (size_t)cur.pn * tstep;
    S.a_ready(cur);
    if constexpr (SP2) {
        PG8_STAGE(PG8_SB(0, 0), cB, voffB); PG8_STAGE(PG8_SB(0, 1), cB + hstep, voffB); PG8_STAGE(PG8_SA(0, 0), cA, voffA); PG8_STAGE(PG8_SA(0, 1), cA + hstep, voffA);
        if (wr == 1) PG8_BAR;
        PG8_WAIT_V(2); PG8_BAR;
        PG8_STAGE(PG8_SB(1, 0), cB + kstep, voffB); PG8_STAGE(PG8_SA(1, 0), cA + kstep, voffA); PG8_STAGE(PG8_SB(1, 1), cB + hstep + kstep, voffB);
        PG8_WAIT_V(6); PG8_BAR;
    } else {
        PG8_STAGE(PG8_SB(0, 0), cB, voffB); PG8_STAGE(PG8_SA(0, 0), cA, voffA); PG8_STAGE(PG8_SB(0, 1), cB + hstep, voffB); PG8_STAGE(PG8_SA(0, 1), cA + hstep, voffA);
        if (wr == 1) PG8_BAR;
        PG8_WAIT_V(4); PG8_BAR;
        PG8_STAGE(PG8_SB(1, 0), cB + kstep, voffB); PG8_STAGE(PG8_SA(1, 0), cA + kstep, voffA); PG8_STAGE(PG8_SB(1, 1), cB + hstep + kstep, voffB);
        PG8_WAIT_V(6); PG8_BAR;
    }
    for (;;) {
        const bool has_next = S.next(ui + 1, nxt);
        const char* nA = has_next ? (const char*)g.A + (size_t)nxt.pm * tstep : cA; const char* nB = has_next ? (const char*)g.Bt + (size_t)nxt.pn * tstep : cB;
        for (int t = 0; t < nt; t += 2) {
            const bool last = (t == nt - 2);
            const char* a1 = cA + (size_t)(t + 1) * kstep;
            const char* a2 = last ? nA : cA + (size_t)(t + 2) * kstep; const char* b2 = last ? nB : cB + (size_t)(t + 2) * kstep;
            const char* a3 = a2 + kstep; const char* b3 = b2 + kstep;
            if (last && has_next) S.a_ready(nxt);
            if constexpr (SP2) {
            PG8_LDB(B0, 0, 0); PG8_LDB(B1, 0, 1); PG8_SCHED; PG8_LDA(At, 0, 0); PG8_STAGE(PG8_SA(1, 1), a1 + hstep, voffA);
            PG8_WAIT_V(8); PG8_WAIT_L(0); PG8_BAR; PG8_MMA(0, 0, At, B0); PG8_MMA(0, 1, At, B1); PG8_BAR; PG8_SCHED;
            PG8_LDA(At, 0, 1); PG8_STAGE(PG8_SB(0, 0), b2, voffB); PG8_STAGE(PG8_SB(0, 1), b2 + hstep, voffB); PG8_STAGE(PG8_SA(0, 0), a2, voffA);
            PG8_WAIT_V(8); PG8_WAIT_L(0); PG8_BAR; PG8_MMA(1, 0, At, B0); PG8_MMA(1, 1, At, B1); PG8_BAR; PG8_SCHED;
            PG8_LDB(B0, 1, 0); PG8_LDB(B1, 1, 1); PG8_SCHED; PG8_LDA(At, 1, 0); PG8_STAGE(PG8_SA(0, 1), a2 + hstep, voffA);
            PG8_WAIT_V(8); PG8_WAIT_L(0); PG8_BAR; PG8_MMA(0, 0, At, B0); PG8_MMA(0, 1, At, B1); PG8_BAR; PG8_SCHED;
            PG8_LDA(At, 1, 1); PG8_STAGE(PG8_SB(1, 0), b3, voffB); PG8_STAGE(PG8_SB(1, 1), b3 + hstep, voffB); PG8_STAGE(PG8_SA(1, 0), a3, voffA);
            PG8_WAIT_V(8); PG8_WAIT_L(0); PG8_BAR; PG8_MMA(1, 0, At, B0); PG8_MMA(1, 1, At, B1); PG8_BAR; PG8_SCHED;
            } else {
            PG8_LDB(B0, 0, 0); PG8_SCHED; PG8_LDA(At, 0, 0); PG8_STAGE(PG8_SA(1, 1), a1 + hstep, voffA);
            PG8_WAIT_L(8); PG8_BAR; PG8_WAIT_L(0); PG8_MMA(0, 0, At, B0); PG8_BAR; PG8_SCHED;
            PG8_LDB(B1, 0, 1); PG8_STAGE(PG8_SB(0, 0), b2, voffB);
            PG8_BAR; PG8_WAIT_L(0); PG8_MMA(0, 1, At, B1); PG8_BAR;
            PG8_LDA(At, 0, 1); PG8_STAGE(PG8_SA(0, 0), a2, voffA);
            PG8_BAR; PG8_WAIT_L(0); PG8_MMA(1, 0, At, B0); PG8_BAR; PG8_SCHED;
            PG8_STAGE(PG8_SB(0, 1), b2 + hstep, voffB);
            PG8_WAIT_V(6); PG8_BAR; PG8_MMA(1, 1, At, B1); PG8_BAR;
            PG8_LDB(B0, 1, 0); PG8_SCHED; PG8_LDA(At, 1, 0); PG8_STAGE(PG8_SA(0, 1), a2 + hstep, voffA);
            PG8_WAIT_L(8); PG8_BAR; PG8_WAIT_L(0); PG8_MMA(0, 0, At, B0); PG8_BAR; PG8_SCHED;
            PG8_LDB(B1, 1, 1); PG8_STAGE(PG8_SB(1, 0), b3, voffB);
            PG8_BAR; PG8_WAIT_L(0); PG8_MMA(0, 1, At, B1); PG8_BAR;
            PG8_LDA(At, 1, 1); PG8_STAGE(PG8_SA(1, 0), a3, voffA);
            PG8_BAR; PG8_WAIT_L(0); PG8_MMA(1, 0, At, B0); PG8_BAR; PG8_SCHED;
            PG8_STAGE(PG8_SB(1, 1), b3 + hstep, voffB);
            PG8_WAIT_V(6); PG8_BAR; PG8_MMA(1, 1, At, B1); PG8_BAR;
            }
        }
        if constexpr (ALIGN_EPI) { if (wr == 0) PG8_BAR; }
        if constexpr (!Epi::AFTER_DRAIN) { E(acc, cur, wr, wc, fr, fq); S.done(cur); }
        if (!has_next) break;
#pragma unroll
        for (int a = 0; a < 2; ++a)
#pragma unroll
            for (int b = 0; b < 2; ++b)
#pragma unroll
                for (int m = 0; m < 4; ++m)
#pragma unroll
                    for (int n = 0; n < 2; ++n) acc[a][b][m][n] = (f32x4){0.f, 0.f, 0.f, 0.f};
        cur = nxt; cA = nA; cB = nB; ++ui;
        if constexpr (ALIGN_EPI) { if (wr == 1) PG8_BAR; }
    }
    PG8_WAIT_V(0);
    if constexpr (!ALIGN_EPI) { if (wr == 0) PG8_BAR; }
    PG8_BAR;
    if constexpr (Epi::AFTER_DRAIN) { E.fused(acc, cur, wr, wc, fr, fq, lds, wid, lane); S.done(cur); }
#undef PG8_SA
#undef PG8_SB
#undef PG8_STAGE
#undef PG8_LDA
#undef PG8_LDB
#undef PG8_MMA
#undef PG8_WAIT_V
#undef PG8_WAIT_L
#undef PG8_BAR
#undef PG8_SCHED
}
}
#define LAS __attribute__((address_space(3)))
#define GAS __attribute__((address_space(1)))
typedef unsigned short bf16;
typedef float f32x2 __attribute__((ext_vector_type(2)));
typedef float f32x4 __attribute__((ext_vector_type(4)));
typedef float f32x16 __attribute__((ext_vector_type(16)));
typedef unsigned u32x2 __attribute__((ext_vector_type(2)));
typedef unsigned u32x4 __attribute__((ext_vector_type(4)));
typedef short bf16x8 __attribute__((ext_vector_type(8)));
typedef short s16x4 __attribute__((ext_vector_type(4)));
typedef __bf16 bfx2 __attribute__((ext_vector_type(2)));

constexpr int D = 2048, BP = 8, TP = 2048, BS = 32, TS = 4, PAST = 8192, PAGE = 128, NPAGES = PAST / PAGE;
constexpr int MP = BP * TP, MS = BS * TS, MT = MP + MS, MPAD = 16640;
constexpr int DFF = 5632, RWD = 1024, RWP = 3328, NH = 8, NG_ = 2, HD = 128, KVD = 256;
constexpr int NCOLS = 10008, NPADW = 10240;
constexpr int RWH = 16, RWN = 64;
constexpr float RMS_EPS = 1e-6f, RW_LN_EPS = 64e-5f;
constexpr int CMPROWS = 17408;
constexpr int NSEQ_P = BP * RWH, NSEQ_S = BS * RWH;
constexpr int NSTEPROWS = NSEQ_P * TP + NSEQ_S * TS;

constexpr size_t O_Y = 0, O_KV = (size_t)MT * D, O_WP = O_KV + (size_t)MT * 1024, O_WS = O_WP + (size_t)BP * 512 * 512,
                 O_RP = O_WS + (size_t)BS * 512 * 512, O_RS = O_RP + (size_t)BP * RWH * 4096, O_SP = O_RS + (size_t)BS * RWH * 4096,
                 O_SS = O_SP + (size_t)BP * RWP, O_END = O_SS + (size_t)BS * RWP;
static_assert(O_END == 63965184, "d_out size");

constexpr size_t al256(size_t x) { return (x + 255) & ~(size_t)255; }
constexpr size_t WS_CTL = 0, CTL_BYTES = 1u << 20;
constexpr size_t WS_W13A = CTL_BYTES;
constexpr size_t WS_W2A = WS_W13A + (size_t)2 * DFF * D * 2;
constexpr size_t WS_WINT = WS_W2A + (size_t)D * DFF * 2;
constexpr size_t WS_WLORA = WS_WINT + (size_t)NPADW * D * 2;
constexpr size_t WS_WBRW = WS_WLORA + (size_t)3072 * 256 * 2;
constexpr size_t WS_WBNSA = WS_WBRW + (size_t)D * 1024 * 2;
constexpr size_t WS_WOUT = WS_WBNSA + (size_t)D * 1024 * 2;
constexpr size_t WS_W13B = WS_WOUT + (size_t)D * D * 2;
constexpr size_t WS_W2B = WS_W13B + (size_t)2 * DFF * D * 2;
constexpr size_t WS_CW1 = WS_W2B + (size_t)D * DFF * 2;
constexpr size_t WS_CW2 = WS_CW1 + (size_t)2 * 256 * 4096 * 2;
constexpr size_t WS_BTAB = WS_CW2 + (size_t)2 * 256 * 256 * 2;
constexpr size_t WS_H = WS_BTAB + (size_t)8 * 1024 * 4;
constexpr size_t WS_ACT = WS_H + (size_t)MPAD * D * 2;
constexpr size_t WS_F = WS_ACT + (size_t)MPAD * DFF * 2;
constexpr size_t WS_X1 = WS_F + (size_t)MPAD * D * 2;
constexpr size_t WS_PRW = WS_X1 + (size_t)MPAD * D * 4;
constexpr size_t WS_Q = WS_PRW + (size_t)MPAD * RWP * 2;
constexpr size_t WS_KVN = WS_Q + (size_t)MPAD * 1024 * 2;
constexpr size_t WS_WINN = WS_KVN + (size_t)MPAD * 1024 * 2;
constexpr size_t WS_GRW = WS_WINN + (size_t)MPAD * 512 * 2;
constexpr size_t WS_GNSA = WS_GRW + (size_t)MPAD * D * 2;
constexpr size_t WS_NG = WS_GNSA + (size_t)MPAD * D * 2;
constexpr size_t WS_ALORA = WS_NG + (size_t)MPAD * 32 * 4;
constexpr size_t WS_DEC = WS_ALORA + (size_t)MPAD * 256 * 2;
constexpr size_t WS_AA = WS_DEC + (size_t)MPAD * 1024 * 4;
constexpr size_t WS_GG = WS_AA + (size_t)MPAD * 1024 * 4;
constexpr size_t WS_YRW = WS_GG + (size_t)MPAD * 1024 * 4;
constexpr size_t WS_YNSA = WS_YRW + (size_t)MPAD * 1024 * 2;
constexpr size_t WS_MRG = WS_YNSA + (size_t)MPAD * 1024 * 2;
constexpr size_t WS_ACMP = WS_MRG + (size_t)MPAD * D * 2;
constexpr size_t WS_HID = WS_ACMP + (size_t)2 * CMPROWS * 4096 * 2;
constexpr size_t WS_KC = WS_HID + (size_t)2 * CMPROWS * 256 * 2;
constexpr size_t WS_OPS = WS_KC + (size_t)2 * CMPROWS * 256 * 4;
constexpr size_t WS_WQ = WS_OPS + (size_t)NSTEPROWS * 256 * 2;
constexpr size_t WS_VV = WS_OPS + (size_t)NSTEPROWS * 320 * 4;
constexpr size_t WS_CB = WS_VV + (size_t)NSTEPROWS * 64 * 4;
constexpr size_t WS_VTS = WS_CB + (size_t)MPAD * 16 * 4;
constexpr size_t WS_VTW = WS_VTS + (size_t)512 * 128 * 64 * 2;
constexpr size_t WS_YRAW = WS_VTW + (size_t)512 * 128 * 64 * 2;
constexpr size_t WS_CHK = WS_YRAW + (size_t)MPAD * 1024 * 4;
constexpr size_t WS_PARK = WS_CHK + (size_t)NSEQ_P * 32 * 32768;
constexpr size_t WS_C12 = WS_CHK + (size_t)NSEQ_P * 32 * 49152;
static_assert((size_t)576 * 65536 <= (size_t)NSEQ_P * 32 * 16384, "parking area");
constexpr size_t WS_END = WS_C12 + (size_t)(NSTEPROWS + 64) * 2 * 4 + 256;
static_assert(WS_END % 256 == 0, "ws alignment");

constexpr int NWAVES = 8, NTHR = 512;
constexpr int LDS_BYTES = 147456;
constexpr int RING_OFF = 0, MISC_OFF = 147456 - 256;
constexpr int CW_BAR = 4096;
#define XB_TMO      128
#define XB_XCNT(j)  (256  + 64 * (j))
#define XB_XSUB(j)  (1280 + 64 * (j))
#define XB_XGEN(j)  (2304 + 64 * (j))
#define XB_TOP      3328
#define XB_TOPGEN   3392
#define XCD_BAR_WORDS 3456
#define XB_SPIN_CAP (1u << 18)

__device__ __forceinline__ unsigned xb_ld(unsigned* p)              { return __hip_atomic_load(p, __ATOMIC_RELAXED, __HIP_MEMORY_SCOPE_AGENT); }
__device__ __forceinline__ unsigned xb_add(unsigned* p, unsigned v) { return __hip_atomic_fetch_add(p, v, __ATOMIC_RELAXED, __HIP_MEMORY_SCOPE_AGENT); }
__device__ __forceinline__ unsigned xb_xcc_id() { return (unsigned)__builtin_amdgcn_s_getreg((3 << 11) | 20) & 0xFu; }
#define XB_SPIN(cond, bar) do { unsigned _sp = 0; while (cond) { __builtin_amdgcn_s_sleep(1); \
    if ((++_sp & 255u) == 0u) { if (xb_ld(&(bar)[XB_TMO])) break; if (_sp > XB_SPIN_CAP) { atomicAdd(&(bar)[XB_TMO], 1u); break; } } } } while (0)

struct XcdBarrier {
    unsigned* bar; unsigned x;
    volatile LAS unsigned* st;
};

__device__ __forceinline__ XcdBarrier xcd_barrier_post(unsigned* bar, volatile LAS unsigned* st) {
    XcdBarrier b; b.bar = bar; b.x = xb_xcc_id(); b.st = st;
    if (threadIdx.x == 0) (void)xb_add(&bar[XB_XCNT(b.x)], 1u);
    return b;
}
__device__ __forceinline__ void xcd_barrier_complete(unsigned* bar, unsigned x, unsigned& nloc, unsigned& nx) {
    const unsigned G = gridDim.x * gridDim.y * gridDim.z;
    unsigned sum, cnt, mine, sp = 0u;
    for (;;) {
        sum = 0u; cnt = 0u; mine = 0u;
#pragma unroll
        for (unsigned j = 0; j < 16; ++j) { const unsigned c = xb_ld(&bar[XB_XCNT(j)]); sum += c; cnt += (c > 0u) ? 1u : 0u; mine = (j == x) ? c : mine; }
        if (sum == G) break;
        __builtin_amdgcn_s_sleep(1);
        if ((++sp & 255u) == 0u) { if (xb_ld(&bar[XB_TMO])) break; if (sp > XB_SPIN_CAP) { atomicAdd(&bar[XB_TMO], 1u); break; } }
    }
    nloc = mine > 0u ? mine : 1u; nx = cnt > 0u ? cnt : 1u;
}

__device__ __forceinline__ void xcd_barrier(const XcdBarrier& b) {
    asm volatile("s_waitcnt vmcnt(0)" ::: "memory");
    __syncthreads();
    if (threadIdx.x == 0) {
        unsigned* bar = b.bar;
        __builtin_amdgcn_s_waitcnt(0);
        unsigned nloc = b.st[0], nx = b.st[1];
        if (nloc == 0u) { xcd_barrier_complete(bar, b.x, nloc, nx); b.st[0] = nloc; b.st[1] = nx; }
        const unsigned old = xb_add(&bar[XB_XSUB(b.x)], 1u);
        const unsigned gen = old / nloc;
        if (old + 1u == (gen + 1u) * nloc) {
            __builtin_amdgcn_fence(__ATOMIC_RELEASE, "agent");
            asm volatile("s_waitcnt vmcnt(0)" ::: "memory");
            const unsigned og = xb_add(&bar[XB_TOP], 1u);
            const unsigned tg = og / nx;
            if (og + 1u == (tg + 1u) * nx) xb_add(&bar[XB_TOPGEN], 1u);
            else XB_SPIN(xb_ld(&bar[XB_TOPGEN]) == tg, bar);
            __builtin_amdgcn_fence(__ATOMIC_ACQUIRE, "agent");
            xb_add(&bar[XB_XGEN(b.x)], 1u);
            asm volatile("s_waitcnt vmcnt(0)" ::: "memory");
        } else {
            XB_SPIN(xb_ld(&bar[XB_XGEN(b.x)]) == gen, bar);
            __builtin_amdgcn_fence(__ATOMIC_ACQUIRE, "agent");
            asm volatile("s_waitcnt vmcnt(0)" ::: "memory");
        }
    }
    __syncthreads();
}
#define LDS_WAIT() asm volatile("s_waitcnt lgkmcnt(0)" ::: "memory")
#define VM_WAIT() asm volatile("s_waitcnt vmcnt(0)" ::: "memory")
__device__ __forceinline__ unsigned pk2(float lo, float hi) { const bfx2 b = __builtin_convertvector((f32x2){lo, hi}, bfx2); return __builtin_bit_cast(unsigned, b); }
__device__ __forceinline__ float bflo(unsigned w) { return __uint_as_float(w << 16); }
__device__ __forceinline__ float bfhi(unsigned w) { return __uint_as_float(w & 0xffff0000u); }
__device__ __forceinline__ float bf2f(bf16 v) { return __uint_as_float((unsigned)v << 16); }
__device__ __forceinline__ float wave_sum(float v) {
    v += __builtin_bit_cast(float, __builtin_amdgcn_update_dpp(0, __builtin_bit_cast(int, v), 0xB1, 0xF, 0xF, true));
    v += __builtin_bit_cast(float, __builtin_amdgcn_update_dpp(0, __builtin_bit_cast(int, v), 0x4E, 0xF, 0xF, true));
    v += __builtin_bit_cast(float, __builtin_amdgcn_update_dpp(0, __builtin_bit_cast(int, v), 0x141, 0xF, 0xF, true));
    v += __builtin_bit_cast(float, __builtin_amdgcn_update_dpp(0, __builtin_bit_cast(int, v), 0x140, 0xF, 0xF, true));
    const int vi = __builtin_bit_cast(int, v);
    const float r0 = __builtin_bit_cast(float, __builtin_amdgcn_readlane(vi, 0)), r1 = __builtin_bit_cast(float, __builtin_amdgcn_readlane(vi, 16)),
                r2 = __builtin_bit_cast(float, __builtin_amdgcn_readlane(vi, 32)), r3 = __builtin_bit_cast(float, __builtin_amdgcn_readlane(vi, 48));
    return (r0 + r1) + (r2 + r3);
}
__device__ __forceinline__ float sigmoidf_(float x) { return __builtin_amdgcn_rcpf(1.0f + __builtin_amdgcn_exp2f(-1.4426950408889634f * x)); }

struct P {
    const float* in[38];
    float* out; unsigned char* ws;
    int ph_lo, ph_hi;
};
struct Frame {
    LAS unsigned char* lds;
    int tid, lane, wave, G, bid;
};
enum { I_XP = 0, I_XS, I_CKV, I_CWIN, I_SRW, I_SSH, I_PT, I_F1PRE, I_F1POST, I_F1W1, I_F1W3, I_F1W2, I_MIXPRE, I_MIXPOST, I_WIN,
       I_MU, I_W0, I_W2, I_A0, I_A2, I_G2, I_KK, I_KA, I_RK, I_LNW, I_LNB, I_PE, I_CW1, I_CW2, I_BRW, I_BNSA, I_WOUT,
       I_F2PRE, I_F2POST, I_F2W1, I_F2W3, I_F2W2, I_RELB };
__device__ __forceinline__ void tr_item(const float* W, int K, int Nsrc, int sc, int nv, bf16* WT, int dr, int k0, LAS float* scr, int lane) {
    const int n4 = 4 * (lane & 15), kr = lane >> 4;
    f32x4 v[16];
    const bool vec = ((sc & 3) == 0) && ((Nsrc & 3) == 0) && nv == 64;
#pragma unroll
    for (int i = 0; i < 16; ++i) { const float* src = W + (size_t)(k0 + kr + 4 * i) * Nsrc + sc + n4;
        if (vec) v[i] = *(const f32x4*)src;
        else { v[i].x = n4 + 0 < nv ? src[0] : 0.f; v[i].y = n4 + 1 < nv ? src[1] : 0.f; v[i].z = n4 + 2 < nv ? src[2] : 0.f; v[i].w = n4 + 3 < nv ? src[3] : 0.f; } }
#pragma unroll
    for (int i = 0; i < 16; ++i) { LAS float* d = scr + (kr + 4 * i) * 65 + n4; d[0] = v[i].x; d[1] = v[i].y; d[2] = v[i].z; d[3] = v[i].w; }
    LDS_WAIT(); asm volatile("" ::: "memory");
    const int c = lane & 7;
#pragma unroll
    for (int j = 0; j < 8; ++j) { const int nn = (lane >> 3) + 8 * j; const LAS float* s = scr + (8 * c) * 65 + nn;
        u32x4 o; o.x = pk2(s[0 * 65], s[1 * 65]); o.y = pk2(s[2 * 65], s[3 * 65]); o.z = pk2(s[4 * 65], s[5 * 65]); o.w = pk2(s[6 * 65], s[7 * 65]);
        *(u32x4*)(WT + (size_t)(dr + nn) * K + k0 + 8 * c) = o; }
    LDS_WAIT(); asm volatile("" ::: "memory");
}
constexpr int TR_SCR = 64 * 65 * 4;
__device__ __forceinline__ void tr_plain(const float* W, int K, int N, bf16* WT, int item, LAS float* scr, int lane) {
    const int ncb = N / 64, kb = item / ncb, nb = item % ncb; tr_item(W, K, N, 64 * nb, 64, WT, 64 * nb, 64 * kb, scr, lane);
}
__device__ __forceinline__ void tr_up(const float* W, int which, bf16* WT, int item, LAS float* scr, int lane) {
    const int ncb = DFF / 64, kb = item / ncb, nb = item % ncb; const int dr = (nb >> 1) * 256 + which * 128 + (nb & 1) * 64;
    tr_item(W, D, DFF, 64 * nb, 64, WT, dr, 64 * kb, scr, lane);
}
__device__ __forceinline__ void tr_win(const float* W, bf16* WT, int item, LAS float* scr, int lane) {
    const int ncb = NPADW / 64, kb = item / ncb, nb = item % ncb; const int dr = 64 * nb; int sc, nv;
    if (dr < 5888) { sc = dr; nv = 64; } else if (dr < 9984) { sc = dr + 24; nv = 64; } else if (dr == 9984) { sc = 5888; nv = 24; } else { sc = 0; nv = 0; }
    tr_item(W, D, NCOLS, sc, nv, WT, dr, 64 * kb, scr, lane);
}
constexpr int TI_UP = (D / 64) * (DFF / 64), TI_DN = (DFF / 64) * (D / 64), TI_IN = (D / 64) * (NPADW / 64), TI_BR = (1024 / 64) * (D / 64), TI_OUT = (D / 64) * (D / 64), TI_C1 = (4096 / 64) * (256 / 64);
constexpr int TR_NITEMS = 4 * TI_UP + 2 * TI_DN + TI_IN + 2 * TI_BR + TI_OUT + 2 * TI_C1;
constexpr int TR_LATE0 = 2 * TI_UP + TI_DN + TI_IN, TR_NLATE = 2 * TI_BR + TI_OUT + 2 * TI_UP + TI_DN;
__device__ __forceinline__ void tr_dispatch(const P& p, int it, LAS float* scr, int lane) {
    unsigned char* ws = p.ws;
    constexpr int I_UP = TI_UP, I_DN = TI_DN, I_IN = TI_IN, I_BR = TI_BR, I_OUT = TI_OUT, I_C1 = TI_C1;
        int r = it;
        if (r < I_UP) { tr_up(p.in[I_F1W1], 0, (bf16*)(ws + WS_W13A), r, scr, lane); return; } r -= I_UP;
        if (r < I_UP) { tr_up(p.in[I_F1W3], 1, (bf16*)(ws + WS_W13A), r, scr, lane); return; } r -= I_UP;
        if (r < I_DN) { tr_plain(p.in[I_F1W2], DFF, D, (bf16*)(ws + WS_W2A), r, scr, lane); return; } r -= I_DN;
        if (r < I_IN) { tr_win(p.in[I_WIN], (bf16*)(ws + WS_WINT), r, scr, lane); return; } r -= I_IN;
        if (r < I_BR) { tr_plain(p.in[I_BRW], 1024, D, (bf16*)(ws + WS_WBRW), r, scr, lane); return; } r -= I_BR;
        if (r < I_BR) { tr_plain(p.in[I_BNSA], 1024, D, (bf16*)(ws + WS_WBNSA), r, scr, lane); return; } r -= I_BR;
        if (r < I_OUT) { tr_plain(p.in[I_WOUT], D, D, (bf16*)(ws + WS_WOUT), r, scr, lane); return; } r -= I_OUT;
        if (r < I_UP) { tr_up(p.in[I_F2W1], 0, (bf16*)(ws + WS_W13B), r, scr, lane); return; } r -= I_UP;
        if (r < I_UP) { tr_up(p.in[I_F2W3], 1, (bf16*)(ws + WS_W13B), r, scr, lane); return; } r -= I_UP;
        if (r < I_DN) { tr_plain(p.in[I_F2W2], DFF, D, (bf16*)(ws + WS_W2B), r, scr, lane); return; } r -= I_DN;
        if (r < I_C1) { tr_plain(p.in[I_CW1], 4096, 256, (bf16*)(ws + WS_CW1), r, scr, lane); return; } r -= I_C1;
        tr_plain(p.in[I_CW1] + (size_t)4096 * 256, 4096, 256, (bf16*)(ws + WS_CW1) + (size_t)256 * 4096, r, scr, lane);
}
__device__ __forceinline__ void rms_row_to_bf16(const float* xrow, const float* g, bf16* orow, int lane) {
    f32x4 v[8]; float s = 0.f;
#pragma unroll
    for (int j = 0; j < 4; ++j) { const float* p = xrow + (j * 64 + lane) * 8; v[2 * j] = *(const f32x4*)p; v[2 * j + 1] = *(const f32x4*)(p + 4);
        s += (v[2*j].x * v[2*j].x + v[2*j].y * v[2*j].y) + (v[2*j].z * v[2*j].z + v[2*j].w * v[2*j].w) + (v[2*j+1].x * v[2*j+1].x + v[2*j+1].y * v[2*j+1].y) + (v[2*j+1].z * v[2*j+1].z + v[2*j+1].w * v[2*j+1].w); }
    const float r = 1.0f / sqrtf(wave_sum(s) * (1.0f / D) + RMS_EPS);
#pragma unroll
    for (int j = 0; j < 4; ++j) { const int c = (j * 64 + lane) * 8; const f32x4 g0 = *(const f32x4*)(g + c), g1 = *(const f32x4*)(g + c + 4); const f32x4 a = v[2 * j] * r * g0, b = v[2 * j + 1] * r * g1;
        u32x4 o; o.x = pk2(a.x, a.y); o.y = pk2(a.z, a.w); o.z = pk2(b.x, b.y); o.w = pk2(b.z, b.w); *(u32x4*)(orow + c) = o; }
}
__device__ __forceinline__ void p0_prologue(const P& p, Frame& F) {
    unsigned char* ws = p.ws;
    LAS float* scr = (LAS float*)(F.lds + F.wave * TR_SCR);
    const int gw = F.bid * NWAVES + F.wave, NGW = F.G * NWAVES;
    for (int n = gw; n < TR_NITEMS - TR_NLATE; n += NGW) tr_dispatch(p, n < TR_LATE0 ? n : n + TR_NLATE, scr, F.lane);
    bf16* H = (bf16*)(ws + WS_H);
    for (int m = gw; m < MPAD; m += NGW) {
        if (m < MT) { const float* xr = m < MP ? p.in[I_XP] + (size_t)m * D : p.in[I_XS] + (size_t)(m - MP) * D; rms_row_to_bf16(xr, p.in[I_F1PRE], H + (size_t)m * D, F.lane); }
        else { for (int j = 0; j < 4; ++j) *(u32x4*)(H + (size_t)m * D + (j * 64 + F.lane) * 8) = (u32x4){0u, 0u, 0u, 0u}; }
    }
    const int gt = F.bid * NTHR + F.tid, NGT = F.G * NTHR;
    { bf16* WL = (bf16*)(ws + WS_WLORA);
      for (int i = gt; i < 3072 * 256; i += NGT) { const int n = i >> 8, k = i & 255, seg = n >> 10, nn = n & 1023; float v = 0.f;
          if (seg == 0) { if (k < 64) v = p.in[I_W2][k * 1024 + nn]; } else if (seg == 1) { if (k >= 64 && k < 128) v = p.in[I_A2][(k - 64) * 1024 + nn]; } else { if (k >= 128) v = p.in[I_G2][(k - 128) * 1024 + nn]; }
          WL[i] = (bf16)(pk2(v, 0.f) & 0xffffu); } }
    { bf16* C2 = (bf16*)(ws + WS_CW2);
      for (int i = gt; i < 2 * 256 * 256; i += NGT) { const int kv = i >> 16, n = (i >> 8) & 255, k = i & 255; const float v = n < 128 ? p.in[I_CW2][((size_t)kv * 256 + k) * 128 + n] : 0.f; C2[i] = (bf16)(pk2(v, 0.f) & 0xffffu); } }
    { float* BT = (float*)(ws + WS_BTAB);
      for (int i = gt; i < 8 * 1024; i += NGT) { const int h = i >> 10, n = i & 1023; int b;
          if (n < 16) b = n; else { b = 16 + (int)(log((double)n / 16.0) / log(64.0) * 16.0 + 1e-9);     if (b > 31) b = 31; }
          BT[i] = p.in[I_RELB][b * 8 + h]; } }
    { float* wsO = p.out + O_WS; const float* cw = p.in[I_CWIN];
      for (int i = gt; i < BS * 508 * 128; i += NGT) { const int b = i / (508 * 128), r = i % (508 * 128); *(f32x4*)(wsO + (size_t)b * 512 * 512 + (size_t)r * 4) = *(const f32x4*)(cw + (size_t)b * 512 * 512 + 4 * 512 + (size_t)r * 4); } }
}

__device__ __forceinline__ void tr_late_batch(const P& p, Frame& F, int q) {
    __syncthreads();
    int t_ = threadIdx.x; asm volatile("" : "+v"(t_));
    const int lane = t_ & 63, wave = __builtin_amdgcn_readfirstlane(t_ >> 6);
    LAS float* scr = (LAS float*)(F.lds + wave * TR_SCR);
#pragma nounroll
    for (int i = 0; i < 2; ++i) { const int it = TR_LATE0 + 16 * q + 2 * wave + i; if (it < TR_LATE0 + TR_NLATE) tr_dispatch(p, it, scr, lane); }
}
#define NT_ST4(ptr_, val_) __builtin_nontemporal_store((val_), (f32x4*)(ptr_))
__device__ __forceinline__ u32x4 pack8(const f32x4 a, const f32x4 b) { u32x4 o; o.x = pk2(a.x, a.y); o.y = pk2(a.z, a.w); o.z = pk2(b.x, b.y); o.w = pk2(b.z, b.w); return o; }
__device__ __forceinline__ f32x4 sig4(const f32x4 v) { f32x4 r; r.x = sigmoidf_(v.x); r.y = sigmoidf_(v.y); r.z = sigmoidf_(v.z); r.w = sigmoidf_(v.w); return r; }
__device__ __forceinline__ u32x4 epi_perm(const u32x4 v, const int src4) { u32x4 r;
    r.x = (unsigned)__builtin_amdgcn_ds_bpermute(src4, (int)v.x); r.y = (unsigned)__builtin_amdgcn_ds_bpermute(src4, (int)v.y); r.z = (unsigned)__builtin_amdgcn_ds_bpermute(src4, (int)v.z); r.w = (unsigned)__builtin_amdgcn_ds_bpermute(src4, (int)v.w); return r; }
__device__ __forceinline__ f32x4 epi_permf(const f32x4 v, const int src4) { return __builtin_bit_cast(f32x4, epi_perm(__builtin_bit_cast(u32x4, v), src4)); }
#define EPI_REMAP() const int fr2 = 4 * fq + (fr >> 2), fq2 = fr & 3, src4 = (fr2 + 16 * fq2) << 2
struct EpiSwiglu {
    static constexpr bool PERM = true, AFTER_DRAIN = false; bf16* O;
    __device__ __forceinline__ void operator()(const pg8::f32x4 (&acc)[2][2][4][2], const pg8::Unit& u, int wr, int wc, int fr, int fq) const {
        EPI_REMAP(); const int row0 = u.pm * 256 + wr * 64 + fr2, col0 = u.pn * 128 + wc * 32 + 8 * fq2;
#pragma unroll
        for (int ai = 0; ai < 2; ++ai)
#pragma unroll
            for (int m = 0; m < 4; ++m) { bf16* rowp = O + (size_t)(row0 + ai * 128 + m * 16) * DFF + col0;
                const f32x4 a0 = acc[ai][0][m][0], a1 = acc[ai][0][m][1], b0 = acc[ai][1][m][0], b1 = acc[ai][1][m][1];
                *(u32x4*)rowp = epi_perm(pack8(a0 * sig4(a0) * b0, a1 * sig4(a1) * b1), src4); }
    }
};
struct EpiStore {
    static constexpr bool PERM = true, AFTER_DRAIN = false; bf16* O; int ldc;
    __device__ __forceinline__ void operator()(const pg8::f32x4 (&acc)[2][2][4][2], const pg8::Unit& u, int wr, int wc, int fr, int fq) const {
        EPI_REMAP(); const int row0 = u.pm * 256 + wr * 64 + fr2, col0 = u.pn * 256 + wc * 32 + 8 * fq2;
#pragma unroll
        for (int ai = 0; ai < 2; ++ai)
#pragma unroll
            for (int m = 0; m < 4; ++m) { bf16* rowp = O + (size_t)(row0 + ai * 128 + m * 16) * ldc + col0;
#pragma unroll
                for (int bj = 0; bj < 2; ++bj) *(u32x4*)(rowp + bj * 128) = epi_perm(pack8(acc[ai][bj][m][0], acc[ai][bj][m][1]), src4); }
    }
};
__device__ __forceinline__ size_t tile_native(int pm, int pt, int wr, int wc, int fr, int fq) { return ((size_t)((pm * 8 + pt) * 8 + wr * 4 + wc)) * 8192 + (size_t)(fr + 16 * fq) * 8; }
struct EpiWin {
    static constexpr bool PERM = true, AFTER_DRAIN = false;
    bf16 *PRW, *Q, *KVN, *WINN, *GRW, *GNSA; float* NG; float* out;
    __device__ __forceinline__ void operator()(const pg8::f32x4 (&acc)[2][2][4][2], const pg8::Unit& u, int wr, int wc, int fr, int fq) const {
        EPI_REMAP(); const int pn = u.pn, row0 = u.pm * 256 + wr * 64 + fr2, cw = wc * 32 + 8 * fq2;
#pragma unroll
        for (int ai = 0; ai < 2; ++ai)
#pragma unroll
            for (int m = 0; m < 4; ++m) { const int row = row0 + ai * 128 + m * 16;
#pragma unroll
                for (int bj = 0; bj < 2; ++bj) { const int ct = bj * 128 + cw; f32x4 v0 = acc[ai][bj][m][0], v1 = acc[ai][bj][m][1];
                    if (pn < 23 || pn >= 39) { v0 = epi_permf(v0, src4); v1 = epi_permf(v1, src4); }
                    if (pn < 13) { const int col = pn * 256 + ct; *(u32x4*)(PRW + (size_t)row * RWP + col) = pack8(v0, v1);
                        float* so = nullptr;
                        if (row < MP) { if ((row & (TP - 1)) == TP - 1) so = out + O_SP + (size_t)(row >> 11) * RWP + col; }
                        else if (row < MT) { if (((row - MP) & 3) == 3) so = out + O_SS + (size_t)((row - MP) >> 2) * RWP + col; }
                        if (so) { NT_ST4(so, v0); NT_ST4(so + 4, v1); } }
                    else if (pn < 17) { const int col = (pn - 13) * 256 + ct; *(u32x4*)(Q + (size_t)row * 1024 + col) = pack8(v0, v1); }
                    else if (pn < 21) { const int col = (pn - 17) * 256 + ct; *(u32x4*)(KVN + (size_t)row * 1024 + col) = pack8(v0, v1);
                        if (row < MT) { float* so = out + O_KV + (size_t)row * 1024 + col; NT_ST4(so, v0); NT_ST4(so + 4, v1); } }
                    else if (pn < 23) { const int col = (pn - 21) * 256 + ct; *(u32x4*)(WINN + (size_t)row * 512 + col) = pack8(v0, v1);
                        float* so = nullptr;
                        if (row < MP) { const int t = row & (TP - 1); if (t >= TP - 512) so = out + O_WP + ((size_t)(row >> 11) * 512 + (t - (TP - 512))) * 512 + col; }
                        else if (row < MT) { const int b = (row - MP) >> 2, t = (row - MP) & 3; so = out + O_WS + ((size_t)b * 512 + 508 + t) * 512 + col; }
                        if (so) { NT_ST4(so, v0); NT_ST4(so + 4, v1); } }
                    else if (pn < 31) { *(u32x4*)(GRW + tile_native(u.pm, pn - 23, wr, wc, fr, fq) + (size_t)(((ai * 2 + bj) * 4 + m) * 512)) = pack8(sig4(v0), sig4(v1)); }
                    else if (pn < 39) { *(u32x4*)(GNSA + tile_native(u.pm, pn - 31, wr, wc, fr, fq) + (size_t)(((ai * 2 + bj) * 4 + m) * 512)) = pack8(sig4(v0), sig4(v1)); }
                    else { if (ct < 24) { float* so = NG + (size_t)row * 32 + ct; *(f32x4*)so = sig4(v0); *(f32x4*)(so + 4) = sig4(v1); } } } }
    }
};
struct EpiLora {
    static constexpr bool PERM = true, AFTER_DRAIN = false; float *DEC, *AA, *GG; const float *w0, *a0;
    template <int SEG> __device__ __forceinline__ void run(const pg8::f32x4 (&acc)[2][2][4][2], const pg8::Unit& u, int wr, int wc, int fr, int fq) const {
        const int row0 = u.pm * 256 + wr * 64 + fr, cb = (u.pn & 3) * 256 + wc * 32 + 8 * fq;
        float* O = SEG == 0 ? DEC : (SEG == 1 ? AA : GG); const float* bias = SEG == 0 ? w0 : a0;
#pragma unroll
        for (int bj = 0; bj < 2; ++bj)
#pragma unroll
            for (int n = 0; n < 2; ++n) { const int col = cb + bj * 128 + 4 * n; f32x4 b = (f32x4){0.f, 0.f, 0.f, 0.f}; if (SEG < 2) b = *(const f32x4*)(bias + col);
#pragma unroll
                for (int ai = 0; ai < 2; ++ai)
#pragma unroll
                    for (int m = 0; m < 4; ++m) { const int row = row0 + ai * 128 + m * 16; f32x4 v = acc[ai][bj][m][n] + b;
                        if (SEG == 0) {
                            const f32x4 sg = sig4(v);
#pragma unroll
                            for (int i = 0; i < 4; ++i) v[i] = __builtin_amdgcn_exp2f(-0.8750387749145276f * sg[i]); }
                        else if (SEG == 1) v = sig4(v);
                        if (SEG == 2) { u32x2 w; w.x = pk2(v.x, v.y); w.y = pk2(v.z, v.w); *(u32x2*)((bf16*)GG + (size_t)row * 1024 + col) = w; }
                        else *(f32x4*)(O + (size_t)row * 1024 + col) = v; }
                asm volatile("" ::: "memory"); }
    }
    __device__ __forceinline__ void operator()(const pg8::f32x4 (&acc)[2][2][4][2], const pg8::Unit& u, int wr, int wc, int fr, int fq) const {
        const int seg = u.pn >> 2;
        if (seg == 0) run<0>(acc, u, wr, wc, fr, fq); else if (seg == 1) run<1>(acc, u, wr, wc, fr, fq); else run<2>(acc, u, wr, wc, fr, fq);
    }
};
struct DiagOrder {
    int G, c;
    __device__ bool next(int i, pg8::Unit& u) const { const int L = i * G + c; if (L >= 2 * (CMPROWS / 256)) return false; u.pm = L; u.pn = L >= (CMPROWS / 256) ? 1 : 0; return true; }
    __device__ __forceinline__ void a_ready(const pg8::Unit&) const {}
    __device__ __forceinline__ void done(const pg8::Unit&) const {}
};
__device__ __forceinline__ float gelu_tanh(float x) { const float u = 0.7978845608028654f * (x + 0.044715f * x * x * x); const float th = 1.0f - 2.0f / (1.0f + __expf(2.0f * u)); return 0.5f * x * (1.0f + th); }
struct EpiCmp1 {
    static constexpr bool PERM = true, AFTER_DRAIN = false; bf16* O;
    __device__ __forceinline__ void operator()(const pg8::f32x4 (&acc)[2][2][4][2], const pg8::Unit& u, int wr, int wc, int fr, int fq) const {
        const int row0 = u.pm * 256 + wr * 64 + fr, col0 = wc * 32 + 8 * fq;
#pragma unroll
        for (int ai = 0; ai < 2; ++ai)
#pragma unroll
            for (int m = 0; m < 4; ++m) { bf16* rowp = O + (size_t)(row0 + ai * 128 + m * 16) * 256 + col0;
#pragma unroll
                for (int bj = 0; bj < 2; ++bj) { f32x4 a = acc[ai][bj][m][0], b = acc[ai][bj][m][1];
#pragma unroll
                    for (int i = 0; i < 4; ++i) { a[i] = gelu_tanh(a[i]); b[i] = gelu_tanh(b[i]); }
                    *(u32x4*)(rowp + bj * 128) = pack8(a, b); } }
    }
};
struct EpiCmp2 {
    static constexpr bool PERM = true, AFTER_DRAIN = false; float* O;
    __device__ __forceinline__ void operator()(const pg8::f32x4 (&acc)[2][2][4][2], const pg8::Unit& u, int wr, int wc, int fr, int fq) const {
        const int row0 = u.pm * 256 + wr * 64 + fr, col0 = wc * 32 + 8 * fq;
#pragma unroll
        for (int ai = 0; ai < 2; ++ai)
#pragma unroll
            for (int m = 0; m < 4; ++m) { float* rowp = O + (size_t)(row0 + ai * 128 + m * 16) * 256 + col0; *(f32x4*)rowp = acc[ai][0][m][0]; *(f32x4*)(rowp + 4) = acc[ai][0][m][1]; }
    }
};
template <int STAGE> struct EpiMerge {
    static constexpr bool PERM = true, AFTER_DRAIN = false; const bf16* GATE; bf16* MRG; bf16* PART;
    __device__ __forceinline__ void operator()(const pg8::f32x4 (&acc)[2][2][4][2], const pg8::Unit& u, int wr, int wc, int fr, int fq) const {
        EPI_REMAP(); const int row0 = u.pm * 256 + wr * 64 + fr2, col0 = u.pn * 256 + wc * 32 + 8 * fq2; const size_t nat = tile_native(u.pm, u.pn, wr, wc, fr, fq);
#pragma unroll
        for (int ai = 0; ai < 2; ++ai)
#pragma unroll
            for (int m = 0; m < 4; ++m) { const size_t off = (size_t)(row0 + ai * 128 + m * 16) * D + col0;
#pragma unroll
                for (int bj = 0; bj < 2; ++bj) { const size_t no = nat + (size_t)(((ai * 2 + bj) * 4 + m) * 512); const u32x4 gw = *(const u32x4*)(GATE + no);
                    f32x4 a = acc[ai][bj][m][0] * (f32x4){bflo(gw.x), bfhi(gw.x), bflo(gw.y), bfhi(gw.y)}, b = acc[ai][bj][m][1] * (f32x4){bflo(gw.z), bfhi(gw.z), bflo(gw.w), bfhi(gw.w)};
                    if (STAGE == 0) *(u32x4*)(PART + no) = pack8(a, b);
                    else { const u32x4 pw = *(const u32x4*)(PART + no); a += (f32x4){bflo(pw.x), bfhi(pw.x), bflo(pw.y), bfhi(pw.y)}; b += (f32x4){bflo(pw.z), bfhi(pw.z), bflo(pw.w), bfhi(pw.w)};
                        *(u32x4*)(MRG + off + bj * 128) = epi_perm(pack8(a, b), src4); } } }
    }
};
#define MFMA16(a, b, c) __builtin_amdgcn_mfma_f32_16x16x32_bf16((a), (b), (c), 0, 0, 0)
template <int CW, int NB, int NS, class Epi>
__device__ __forceinline__ void skinny_gemm(Frame& F, const bf16* A, int K, const bf16* Bt, int nchunks, const Epi& E) {
    constexpr int NT = (CW + 15) / 16, NBT = NT * NB, SROWS = 32 + 16 * NBT, SBYTES = SROWS * 144;
    int t_ = threadIdx.x; asm volatile("" : "+v"(t_));
    const int lane = t_ & 63, wave = __builtin_amdgcn_readfirstlane(t_ >> 6), lr = lane & 15, lq = lane >> 4, ks = wave & 1, rg = wave >> 1;
    const int srow = lane >> 3, sp = lane & 7;
    asm volatile("" : "+s"(K));
    const int kh = K >> 1;
    LAS pg8::f32x4* red = (LAS pg8::f32x4*)F.lds;
    LAS unsigned char* stg = F.lds + wave * SBYTES;
    const int woff = srow * 144 + sp * 16, roff = lr * 144 + lq * 32;
    __syncthreads();
    for (int chunk = F.bid; chunk < nchunks; chunk += F.G) {
        const int c0 = chunk * CW;
        const unsigned ao = (unsigned)((32 * rg + srow) * K + ks * kh + 8 * sp);
        unsigned bo[NBT][2];
#pragma unroll
        for (int j = 0; j < NT; ++j)
#pragma unroll
            for (int nb = 0; nb < NB; ++nb)
#pragma unroll
                for (int u = 0; u < 2; ++u) { const int cc = 16 * j + srow + 8 * u, col = c0 + (cc < CW ? cc : CW - 1); bo[j * NB + nb][u] = (unsigned)(E.brow(col, nb) * K + ks * kh + 8 * sp); }
        pg8::f32x4 acc[2][NT][NB];
#pragma unroll
        for (int i = 0; i < 2; ++i)
#pragma unroll
            for (int j = 0; j < NT; ++j)
#pragma unroll
                for (int nb = 0; nb < NB; ++nb) acc[i][j][nb] = (pg8::f32x4){0.f, 0.f, 0.f, 0.f};
        bf16x8 ga[NS][4], gb[NS][NBT][2];
#define SK_LOAD(set, blk_) do { const int kk_ = (blk_) * 64; _Pragma("unroll") for (int u_ = 0; u_ < 4; ++u_) ga[set][u_] = *(const bf16x8*)(A + (ao + (unsigned)(8 * u_ * K + kk_))); \
            _Pragma("unroll") for (int q_ = 0; q_ < NBT; ++q_) _Pragma("unroll") for (int u_ = 0; u_ < 2; ++u_) gb[set][q_][u_] = *(const bf16x8*)(Bt + (bo[q_][u_] + (unsigned)kk_)); } while (0)
#define SK_MMA(set) do { \
            _Pragma("unroll") for (int u_ = 0; u_ < 4; ++u_) *(LAS bf16x8*)(stg + woff + u_ * 8 * 144) = ga[set][u_]; \
            _Pragma("unroll") for (int q_ = 0; q_ < NBT; ++q_) _Pragma("unroll") for (int u_ = 0; u_ < 2; ++u_) *(LAS bf16x8*)(stg + (32 + 16 * q_ + 8 * u_) * 144 + woff) = gb[set][q_][u_]; \
            __builtin_amdgcn_fence(__ATOMIC_RELEASE, "wavefront"); __builtin_amdgcn_wave_barrier(); __builtin_amdgcn_fence(__ATOMIC_ACQUIRE, "wavefront"); \
            bf16x8 fa_[2][2], fb_[NBT][2]; \
            _Pragma("unroll") for (int i_ = 0; i_ < 2; ++i_) _Pragma("unroll") for (int s_ = 0; s_ < 2; ++s_) fa_[i_][s_] = *(const LAS bf16x8*)(stg + i_ * 16 * 144 + roff + 16 * s_); \
            _Pragma("unroll") for (int q_ = 0; q_ < NBT; ++q_) _Pragma("unroll") for (int s_ = 0; s_ < 2; ++s_) fb_[q_][s_] = *(const LAS bf16x8*)(stg + (32 + 16 * q_) * 144 + roff + 16 * s_); \
            __builtin_amdgcn_fence(__ATOMIC_RELEASE, "wavefront"); __builtin_amdgcn_wave_barrier(); __builtin_amdgcn_fence(__ATOMIC_ACQUIRE, "wavefront"); \
            _Pragma("unroll") for (int s_ = 0; s_ < 2; ++s_) _Pragma("unroll") for (int i_ = 0; i_ < 2; ++i_) _Pragma("unroll") for (int j_ = 0; j_ < NT; ++j_) \
            _Pragma("unroll") for (int nb_ = 0; nb_ < NB; ++nb_) acc[i_][j_][nb_] = MFMA16(fb_[j_ * NB + nb_][s_], fa_[i_][s_], acc[i_][j_][nb_]); } while (0)
        const int nblk = kh >> 6;
#pragma unroll
        for (int s = 0; s < NS - 1; ++s) SK_LOAD(s, s);
        for (int blk = 0; blk < nblk; blk += NS) {
#pragma unroll
            for (int s = 0; s < NS; ++s) {
                if (blk + s + NS - 1 < nblk) SK_LOAD((s + NS - 1) % NS, blk + s + NS - 1);
                if (blk + s < nblk) SK_MMA(s);
            }
        }
#undef SK_LOAD
#undef SK_MMA
        __syncthreads();
        if (ks == 1) {
#pragma unroll
            for (int i = 0; i < 2; ++i)
#pragma unroll
                for (int j = 0; j < NT; ++j)
#pragma unroll
                    for (int nb = 0; nb < NB; ++nb) red[((i * NT + j) * NB + nb) * 256 + rg * 64 + lane] = acc[i][j][nb];
        }
        __syncthreads();
        if (ks == 0) {
#pragma unroll
            for (int i = 0; i < 2; ++i)
#pragma unroll
                for (int j = 0; j < NT; ++j) {
#pragma unroll
                    for (int nb = 0; nb < NB; ++nb) acc[i][j][nb] += red[((i * NT + j) * NB + nb) * 256 + rg * 64 + lane];
                    if (16 * j + 4 * lq < CW) E(32 * rg + 16 * i + lr, c0 + 16 * j + 4 * lq, acc[i][j][0], acc[i][j][NB - 1]); }
        }
        __syncthreads();
    }
}
template <int NS, class Epi>
__device__ __forceinline__ void skinny_gemm2d(Frame& F, const bf16* A, int K, const bf16* Bt, const Epi& E) {
    int t_ = threadIdx.x; asm volatile("" : "+v"(t_));
    const int lane = t_ & 63, wave = __builtin_amdgcn_readfirstlane(t_ >> 6), lr = lane & 15, lq = lane >> 4, ks = wave & 1, mt = (wave >> 1) & 1, nt = wave >> 2;
    const int srow = lane >> 3, sp = lane & 7;
    const int kh = K >> 1;
    LAS pg8::f32x4* red = (LAS pg8::f32x4*)F.lds;
    LAS unsigned char* stg = F.lds + 4096 + wave * 9216;
    const int woff = srow * 144 + sp * 16, roff = lr * 144 + lq * 32;
    __syncthreads();
    for (int chunk = F.bid; chunk < 256; chunk += F.G) {
        const int cx = chunk & 7, cy = chunk >> 3;
        const int r0 = 32 * (cy & 3) + 16 * mt, c0 = 32 * (cx + 8 * (cy >> 2)) + 16 * nt;
        const bf16* ap0 = A + (size_t)(r0 + srow) * K + ks * kh + 8 * sp; const bf16* ap1 = ap0 + (size_t)8 * K;
        const bf16* bp0 = Bt + (size_t)E.brow(c0 + srow, 0) * K + ks * kh + 8 * sp; const bf16* bp1 = Bt + (size_t)E.brow(c0 + srow + 8, 0) * K + ks * kh + 8 * sp;
        pg8::f32x4 acc = (pg8::f32x4){0.f, 0.f, 0.f, 0.f};
        bf16x8 g[NS][4];
#define SK_LOAD(set, blk_) do { const int kk_ = (blk_) * 64; g[set][0] = *(const bf16x8*)(ap0 + kk_); g[set][1] = *(const bf16x8*)(ap1 + kk_); g[set][2] = *(const bf16x8*)(bp0 + kk_); g[set][3] = *(const bf16x8*)(bp1 + kk_); } while (0)
#define SK_MMA(set, buf_) do { LAS unsigned char* sb_ = stg + (buf_) * 4608; \
            *(LAS bf16x8*)(sb_ + woff) = g[set][0]; *(LAS bf16x8*)(sb_ + woff + 8 * 144) = g[set][1]; *(LAS bf16x8*)(sb_ + 2304 + woff) = g[set][2]; *(LAS bf16x8*)(sb_ + 2304 + woff + 8 * 144) = g[set][3]; \
            __builtin_amdgcn_fence(__ATOMIC_RELEASE, "wavefront"); __builtin_amdgcn_wave_barrier(); __builtin_amdgcn_fence(__ATOMIC_ACQUIRE, "wavefront"); \
            const bf16x8 a0_ = *(const LAS bf16x8*)(sb_ + roff), a1_ = *(const LAS bf16x8*)(sb_ + roff + 16), b0_ = *(const LAS bf16x8*)(sb_ + 2304 + roff), b1_ = *(const LAS bf16x8*)(sb_ + 2304 + roff + 16); \
            acc = MFMA16(b0_, a0_, acc); acc = MFMA16(b1_, a1_, acc); } while (0)
        const int nblk = kh >> 6;
#pragma unroll
        for (int s = 0; s < NS - 1; ++s) SK_LOAD(s, s);
        for (int blk = 0; blk < nblk; blk += NS) {
#pragma unroll
            for (int s = 0; s < NS; ++s) {
                if (blk + s + NS - 1 < nblk) SK_LOAD((s + NS - 1) % NS, blk + s + NS - 1);
                if (blk + s < nblk) SK_MMA(s, s & 1);
            }
        }
#undef SK_LOAD
#undef SK_MMA
        if (ks == 1) red[(mt * 2 + nt) * 64 + lane] = acc;
        __syncthreads();
        if (ks == 0) { acc += red[(mt * 2 + nt) * 64 + lane]; E(r0 + lr, c0 + 4 * lq, acc, acc); }
        __syncthreads();
    }
}
struct SkSwiglu {
    bf16* ACT;
    __device__ __forceinline__ int brow(int c, int which) const { return (c >> 7) * 256 + (c & 127) + which * 128; }
    __device__ __forceinline__ void operator()(int r, int c, const pg8::f32x4 a, const pg8::f32x4 b) const {
        const f32x4 v = a * sig4(a) * b; u32x2 w; w.x = pk2(v.x, v.y); w.y = pk2(v.z, v.w); *(u32x2*)(ACT + (size_t)(MP + r) * DFF + c) = w; }
};
struct SkStore {
    bf16* O; int ldc;
    __device__ __forceinline__ int brow(int c, int) const { return c; }
    __device__ __forceinline__ void operator()(int r, int c, const pg8::f32x4 a, const pg8::f32x4) const {
        u32x2 w; w.x = pk2(a.x, a.y); w.y = pk2(a.z, a.w); *(u32x2*)(O + (size_t)(MP + r) * ldc + c) = w; }
};
struct SkWin {
    bf16 *PRW, *Q, *KVN, *WINN, *GRW, *GNSA; float* NG; float* out;
    __device__ __forceinline__ int brow(int c, int) const { return c; }
    __device__ __forceinline__ void operator()(int r, int n, const pg8::f32x4 a, const pg8::f32x4) const {
        const int row = MP + r, b = r >> 2, t = r & 3;
        u32x2 w; w.x = pk2(a.x, a.y); w.y = pk2(a.z, a.w);
        if (n < 3328) { *(u32x2*)(PRW + (size_t)row * RWP + n) = w; if (t == 3) *(f32x4*)(out + O_SS + (size_t)b * RWP + n) = a; }
        else if (n < 4352) { *(u32x2*)(Q + (size_t)row * 1024 + (n - 3328)) = w; }
        else if (n < 5376) { *(u32x2*)(KVN + (size_t)row * 1024 + (n - 4352)) = w; *(f32x4*)(out + O_KV + (size_t)row * 1024 + (n - 4352)) = a; }
        else if (n < 5888) { *(u32x2*)(WINN + (size_t)row * 512 + (n - 5376)) = w; *(f32x4*)(out + O_WS + ((size_t)b * 512 + 508 + t) * 512 + (n - 5376)) = a; }
        else if (n < 7936) { const f32x4 s = sig4(a); u32x2 x; x.x = pk2(s.x, s.y); x.y = pk2(s.z, s.w); *(u32x2*)(GRW + (size_t)row * D + (n - 5888)) = x; }
        else if (n < 9984) { const f32x4 s = sig4(a); u32x2 x; x.x = pk2(s.x, s.y); x.y = pk2(s.z, s.w); *(u32x2*)(GNSA + (size_t)row * D + (n - 7936)) = x; }
        else if (n < 10008) { *(f32x4*)(NG + (size_t)row * 32 + (n - 9984)) = sig4(a); }
    }
};
struct SkLora {
    float *DEC, *AA, *GG; const float *w0, *a0;
    __device__ __forceinline__ int brow(int c, int) const { return c; }
    __device__ __forceinline__ void operator()(int r, int n, const pg8::f32x4 a, const pg8::f32x4) const {
        const int seg = n >> 10, col = n & 1023, row = MP + r; f32x4 v = a;
        if (seg == 0) { const f32x4 sg = sig4(v + *(const f32x4*)(w0 + col));
#pragma unroll
            for (int i = 0; i < 4; ++i) v[i] = __builtin_amdgcn_exp2f(-0.8750387749145276f * sg[i]);
            *(f32x4*)(DEC + (size_t)row * 1024 + col) = v; }
        else if (seg == 1) { *(f32x4*)(AA + (size_t)row * 1024 + col) = sig4(v + *(const f32x4*)(a0 + col)); }
        else { u32x2 w; w.x = pk2(v.x, v.y); w.y = pk2(v.z, v.w); *(u32x2*)((bf16*)GG + (size_t)row * 1024 + col) = w; }
    }
};
template <int STAGE> struct SkMerge {
    const bf16* GATE; bf16* MRG;
    __device__ __forceinline__ int brow(int c, int) const { return c; }
    __device__ __forceinline__ void operator()(int r, int c, const pg8::f32x4 a, const pg8::f32x4) const {
        const size_t off = (size_t)(MP + r) * D + c; const u32x2 gw = *(const u32x2*)(GATE + off);
        f32x4 v = a * (f32x4){bflo(gw.x), bfhi(gw.x), bflo(gw.y), bfhi(gw.y)};
        if (STAGE == 1) { const u32x2 pw = *(const u32x2*)(MRG + off); v += (f32x4){bflo(pw.x), bfhi(pw.x), bflo(pw.y), bfhi(pw.y)}; }
        u32x2 w; w.x = pk2(v.x, v.y); w.y = pk2(v.z, v.w); *(u32x2*)(MRG + off) = w; }
};
template <bool INB, bool OUTB>
__device__ __forceinline__ void thin_phase(Frame& F, const bf16* Fb, const void* xin_p, const void* xin_s, const float* post_g, float half, void* xout, const float* next_g, bf16* H) {
    const int gw = F.bid * NWAVES + F.wave, NGW = F.G * NWAVES, lane = F.lane;
    for (int m0 = 2 * gw; m0 < MT; m0 += 2 * NGW) {
        f32x4 f[2][8], x[2][8]; float s[2] = {0.f, 0.f};
#pragma unroll
        for (int r = 0; r < 2; ++r) { const int m = m0 + r;
#pragma unroll
            for (int j = 0; j < 4; ++j) { const int c = (j * 64 + lane) * 8; const u32x4 w = *(const u32x4*)(Fb + (size_t)m * D + c);
                f[r][2 * j] = (f32x4){bflo(w.x), bfhi(w.x), bflo(w.y), bfhi(w.y)}; f[r][2 * j + 1] = (f32x4){bflo(w.z), bfhi(w.z), bflo(w.w), bfhi(w.w)};
                if (INB) { const bf16* xr = m < MP ? (const bf16*)xin_p + (size_t)m * D : (const bf16*)xin_s + (size_t)(m - MP) * D; const u32x4 xw = *(const u32x4*)(xr + c);
                    x[r][2 * j] = (f32x4){bflo(xw.x), bfhi(xw.x), bflo(xw.y), bfhi(xw.y)}; x[r][2 * j + 1] = (f32x4){bflo(xw.z), bfhi(xw.z), bflo(xw.w), bfhi(xw.w)}; }
                else { const float* xr = m < MP ? (const float*)xin_p + (size_t)m * D : (const float*)xin_s + (size_t)(m - MP) * D; x[r][2 * j] = *(const f32x4*)(xr + c); x[r][2 * j + 1] = *(const f32x4*)(xr + c + 4); } } }
#pragma unroll
        for (int r = 0; r < 2; ++r)
#pragma unroll
            for (int q = 0; q < 8; ++q) s[r] += (f[r][q].x * f[r][q].x + f[r][q].y * f[r][q].y) + (f[r][q].z * f[r][q].z + f[r][q].w * f[r][q].w);
        const float r0 = half / sqrtf(wave_sum(s[0]) * (1.0f / D) + RMS_EPS), r1 = half / sqrtf(wave_sum(s[1]) * (1.0f / D) + RMS_EPS);
        float s2[2] = {0.f, 0.f};
#pragma unroll
        for (int j = 0; j < 4; ++j) { const int c = (j * 64 + lane) * 8; const f32x4 g0 = *(const f32x4*)(post_g + c), g1 = *(const f32x4*)(post_g + c + 4);
#pragma unroll
            for (int r = 0; r < 2; ++r) { const f32x4 o0 = x[r][2 * j] + f[r][2 * j] * (r == 0 ? r0 : r1) * g0, o1 = x[r][2 * j + 1] + f[r][2 * j + 1] * (r == 0 ? r0 : r1) * g1; f[r][2 * j] = o0; f[r][2 * j + 1] = o1;
                if (OUTB) *(u32x4*)((bf16*)xout + (size_t)(m0 + r) * D + c) = pack8(o0, o1);
                else { NT_ST4((float*)xout + (size_t)(m0 + r) * D + c, o0); NT_ST4((float*)xout + (size_t)(m0 + r) * D + c + 4, o1); }
                s2[r] += ((o0.x * o0.x + o0.y * o0.y) + (o0.z * o0.z + o0.w * o0.w)) + ((o1.x * o1.x + o1.y * o1.y) + (o1.z * o1.z + o1.w * o1.w)); } }
        if (next_g) { const float q0 = 1.0f / sqrtf(wave_sum(s2[0]) * (1.0f / D) + RMS_EPS), q1 = 1.0f / sqrtf(wave_sum(s2[1]) * (1.0f / D) + RMS_EPS);
#pragma unroll
            for (int j = 0; j < 4; ++j) { const int c = (j * 64 + lane) * 8; const f32x4 g0 = *(const f32x4*)(next_g + c), g1 = *(const f32x4*)(next_g + c + 4);
#pragma unroll
                for (int r = 0; r < 2; ++r) *(u32x4*)(H + (size_t)(m0 + r) * D + c) = pack8(f[r][2 * j] * (r == 0 ? q0 : q1) * g0, f[r][2 * j + 1] * (r == 0 ? q0 : q1) * g1); } }
    }
}
constexpr int BTX = 2112;
constexpr int A_KT = 0, A_VT = 17408, A_BT = 34816, A_IMP = 68608, A_SELM = 102400, A_UL = 102656, A_UM = 103168, A_NU = 103680, A_SELB = 103936;
constexpr int KT_PITCH = 272, VT_PITCH = 136;
constexpr float NEGB = -1e30f;
#ifndef PREFETCH_TILES
#define PREFETCH_TILES 0
#endif
#define MFMA32(a, b, c) __builtin_amdgcn_mfma_f32_32x32x16_bf16((a), (b), (c), 0, 0, 0)

__device__ __forceinline__ void stage_tile(Frame& F, const void* kp, const void* vp, int pitch, bool isf32, int nvalid) {
    LAS unsigned char* KT = F.lds + A_KT; LAS unsigned char* VT = F.lds + A_VT;
    int tid = F.tid; asm volatile("" : "+v"(tid));
    { const int key = tid >> 3, ch = tid & 7; u32x4 o0 = (u32x4){0u, 0u, 0u, 0u}, o1 = o0;
      if (key < nvalid) {
          if (isf32) { const float* s = (const float*)kp + (size_t)key * pitch + ch * 16; const f32x4 a = *(const f32x4*)s, b = *(const f32x4*)(s + 4), c = *(const f32x4*)(s + 8), d = *(const f32x4*)(s + 12); o0 = pack8(a, b); o1 = pack8(c, d); }
          else { const bf16* s = (const bf16*)kp + (size_t)key * pitch + ch * 16; o0 = *(const u32x4*)s; o1 = *(const u32x4*)(s + 8); } }
      *(LAS u32x4*)(KT + key * KT_PITCH + ch * 32) = o0; *(LAS u32x4*)(KT + key * KT_PITCH + ch * 32 + 16) = o1; }
    { const int key = tid >> 3, dc = tid & 7; u32x4 o0 = (u32x4){0u, 0u, 0u, 0u}, o1 = o0;
      if (key < nvalid) {
          if (isf32) { const float* s = (const float*)vp + (size_t)key * pitch + dc * 16; const f32x4 a = *(const f32x4*)s, b = *(const f32x4*)(s + 4), c = *(const f32x4*)(s + 8), d = *(const f32x4*)(s + 12); o0 = pack8(a, b); o1 = pack8(c, d); }
          else { const bf16* s = (const bf16*)vp + (size_t)key * pitch + dc * 16; o0 = *(const u32x4*)s; o1 = *(const u32x4*)(s + 8); } }
      LAS unsigned short* vt = (LAS unsigned short*)(VT + (dc * 16) * VT_PITCH + key * 2);
      const unsigned w[8] = {o0.x, o0.y, o0.z, o0.w, o1.x, o1.y, o1.z, o1.w};
#pragma unroll
      for (int i = 0; i < 8; ++i) { vt[(2 * i) * (VT_PITCH / 2)] = (unsigned short)(w[i] & 0xffffu); vt[(2 * i + 1) * (VT_PITCH / 2)] = (unsigned short)(w[i] >> 16); } }
}

struct TileRegs { u32x4 k0, k1, v0, v1; };
__device__ __forceinline__ void tile_load(TileRegs& r, const bf16* kp, const bf16* vp, int pitch, int tid) {
    const bf16* ks = kp + (size_t)(tid >> 3) * pitch + (tid & 7) * 16; r.k0 = *(const u32x4*)ks; r.k1 = *(const u32x4*)(ks + 8);
    const bf16* vs = vp + (tid >> 2) * 64 + (tid & 3) * 16; r.v0 = *(const u32x4*)vs; r.v1 = *(const u32x4*)(vs + 8);
}
__device__ __forceinline__ void tile_store(Frame& F, const TileRegs& r, int tid, int boff) {
    LAS unsigned char* kd = F.lds + A_KT + boff + (tid >> 3) * KT_PITCH + (tid & 7) * 32; *(LAS u32x4*)kd = r.k0; *(LAS u32x4*)(kd + 16) = r.k1;
    LAS unsigned char* vd = F.lds + A_VT + boff + (tid >> 2) * VT_PITCH + (tid & 3) * 32;
    *(LAS u32x2*)vd = (u32x2){r.v0.x, r.v0.y}; *(LAS u32x2*)(vd + 8) = (u32x2){r.v0.z, r.v0.w}; *(LAS u32x2*)(vd + 16) = (u32x2){r.v1.x, r.v1.y}; *(LAS u32x2*)(vd + 24) = (u32x2){r.v1.z, r.v1.w};
}
constexpr int A_BUF2 = 106240;
__device__ __forceinline__ void loader_stage(Frame& F, const void* kp, const void* vp, int pitch, bool isf32, int nvalid, int lt, int boff) {
    const int key = lt >> 2, ch = lt & 3;
#pragma unroll
    for (int kv = 0; kv < 2; ++kv) { const void* sp = kv ? vp : kp; u32x2 r[8];
#pragma unroll
        for (int j = 0; j < 8; ++j) r[j] = (u32x2){0u, 0u};
        if (key < nvalid) {
            if (isf32) { const float* s = (const float*)sp + (size_t)key * pitch + 4 * ch; f32x4 a[8];
#pragma unroll
                for (int j = 0; j < 8; ++j) a[j] = *(const f32x4*)(s + 16 * j);
#pragma unroll
                for (int j = 0; j < 8; ++j) { r[j].x = pk2(a[j].x, a[j].y); r[j].y = pk2(a[j].z, a[j].w); } }
            else { const bf16* s = (const bf16*)sp + (size_t)key * pitch + 4 * ch;
#pragma unroll
                for (int j = 0; j < 8; ++j) r[j] = *(const u32x2*)(s + 16 * j); } }
        if (kv == 0) { LAS unsigned char* kd = F.lds + A_KT + boff + key * KT_PITCH + 8 * ch;
#pragma unroll
            for (int j = 0; j < 8; ++j) *(LAS u32x2*)(kd + 32 * j) = r[j]; }
        else { LAS unsigned short* vt = (LAS unsigned short*)(F.lds + A_VT + boff + (4 * ch) * VT_PITCH + key * 2);
#pragma unroll
            for (int j = 0; j < 8; ++j) { const unsigned w[2] = {r[j].x, r[j].y};
#pragma unroll
                for (int e = 0; e < 2; ++e) { vt[(16 * j + 2 * e) * (VT_PITCH / 2)] = (unsigned short)(w[e] & 0xffffu); vt[(16 * j + 2 * e + 1) * (VT_PITCH / 2)] = (unsigned short)(w[e] >> 16); } } } }
}
#define SAMPLE_TILE(ii, kpX, vpX, pitchX, f32X, nvX) do { nvX = 64; \
    if (ph < 2) { kpX = kc_k + (size_t)(64 * (ii)) * 512; vpX = kc_v + (size_t)(64 * (ii)) * 512; pitchX = 512; f32X = true; } \
    else if (ph == 2) { const int j_ = UL[ii]; pitchX = 1024; \
        if (j_ < 128) { const int page_ = pt[j_ >> 1]; const float* kb_ = ckv + ((size_t)(page_ * PAGE + (j_ & 1) * 64) * 4 + 2) * 256 + g * 128; kpX = kb_; vpX = kb_ + 256; f32X = true; } \
        else { const bf16* kb_ = KVN + (size_t)(MP + b * 4) * 1024 + 2 * 256 + g * 128; kpX = kb_; vpX = kb_ + 256; f32X = false; nvX = 4; } } \
    else { pitchX = 512; \
        if ((ii) < 8) { const float* kb_ = cw + ((size_t)(b * 512 + 64 * (ii)) * 2) * 256 + g * 128; kpX = kb_; vpX = kb_ + 256; f32X = true; } \
        else { const bf16* kb_ = WINN + (size_t)(MP + b * 4) * 512 + g * 128; kpX = kb_; vpX = kb_ + 256; f32X = false; nvX = 4; } } } while (0)
constexpr float NEG_M = -1e30f, NEG_S = -3e30f;
template <int MODE>
__device__ __forceinline__ void tile_compute(Frame& F, const int boff, const LAS float* btab, const bf16x8 (&qf)[8], int t, bool lanevalid, int kp0, int kstride, int nvalid, int wlimit, bool far, bool interior,
                                             float& m, float& l, f32x16 (&ot)[4], float invl, LAS float* imp_row, int jbase, bool impwrite) {
    const LAS unsigned char* KT = F.lds + A_KT + boff; const LAS unsigned char* VT = F.lds + A_VT + boff;
    const int ql = F.lane & 31, half = F.lane >> 5;
    const float SC = 0.08838834764831845f * 1.4426950408889634f;
#pragma nounroll
    for (int nt = 0; nt < 2; ++nt) {
        f32x16 st;
#pragma unroll
        for (int i = 0; i < 16; ++i) st[i] = 0.f;
        { const LAS unsigned char* ka = KT + (32 * nt + ql) * KT_PITCH + 16 * half;
#pragma unroll
          for (int kg = 0; kg < 2; ++kg) { bf16x8 kf[4];
#pragma unroll
              for (int ks = 0; ks < 4; ++ks) kf[ks] = *(const LAS bf16x8*)(ka + 32 * (4 * kg + ks));
#pragma unroll
              for (int ks = 0; ks < 4; ++ks) st = MFMA32(kf[ks], qf[4 * kg + ks], st); } }
        float mloc = NEG_S;
        if (far) { const float bfar = btab[1023];
#pragma unroll
            for (int r = 0; r < 16; ++r) { const float s2 = st[r] * SC + bfar; st[r] = s2; mloc = fmaxf(mloc, s2); }
            if (!lanevalid) mloc = NEG_S;
        } else if (interior) {
            const LAS float* bp = btab + (t - kp0 - (32 * nt + 4 * half));
#pragma unroll
            for (int rg = 0; rg < 4; ++rg) { float bv[4];
#pragma unroll
                for (int r4 = 0; r4 < 4; ++r4) bv[r4] = *(bp - (8 * rg + r4));
#pragma unroll
                for (int r4 = 0; r4 < 4; ++r4) asm volatile("" : "+v"(bv[r4]));
#pragma unroll
                for (int r4 = 0; r4 < 4; ++r4) { const int r = 4 * rg + r4; const float s2 = st[r] * SC + bv[r4]; st[r] = s2; mloc = fmaxf(mloc, s2); } }
            if (!lanevalid) mloc = NEG_S;
        } else {
            const int key0 = 32 * nt + 4 * half, d0 = t - kp0 - kstride * key0, nvk = lanevalid ? nvalid - key0 : 0;
#pragma unroll
            for (int rg = 0; rg < 2; ++rg) { float bv[8];
#pragma unroll
                for (int r8 = 0; r8 < 8; ++r8) { const int r = 8 * rg + r8; const int cr = (r & 3) + 8 * (r >> 2); const int dist = d0 - kstride * cr; bv[r8] = btab[min(max(dist, 0), 1023)]; }
#pragma unroll
                for (int r8 = 0; r8 < 8; ++r8) asm volatile("" : "+v"(bv[r8]));
#pragma unroll
                for (int r8 = 0; r8 < 8; ++r8) { const int r = 8 * rg + r8; const int cr = (r & 3) + 8 * (r >> 2); const int dist = d0 - kstride * cr;
                    const bool ok = cr < nvk && (unsigned)dist < (unsigned)wlimit;
                    const float s2 = ok ? st[r] * SC + bv[r8] : NEG_S; st[r] = s2; mloc = fmaxf(mloc, s2); } }
        }
        if (MODE == 0) {
            mloc = fmaxf(mloc, __shfl_xor(mloc, 32));
            const float mnew = mloc > m + 8.0f ? mloc : m;
            if (__ballot(mnew != m) != 0ull) { const float alpha = __builtin_amdgcn_exp2f(m - mnew); m = mnew; l *= alpha;
#pragma unroll
                for (int dt = 0; dt < 4; ++dt)
#pragma unroll
                    for (int i = 0; i < 16; ++i) ot[dt][i] *= alpha; }
            float ls = 0.f; const float meff = lanevalid ? m : 3.0e30f;
#pragma unroll
            for (int r = 0; r < 16; ++r) { const float pv = __builtin_amdgcn_exp2f(st[r] - meff); st[r] = pv; ls += pv; }
            l += ls;
#pragma unroll
            for (int s = 0; s < 2; ++s) {
                u32x4 pb; pb.x = pk2(st[8 * s + 0], st[8 * s + 1]); pb.y = pk2(st[8 * s + 2], st[8 * s + 3]); pb.z = pk2(st[8 * s + 4], st[8 * s + 5]); pb.w = pk2(st[8 * s + 6], st[8 * s + 7]);
                const bf16x8 bfrag = __builtin_bit_cast(bf16x8, pb);
                const LAS unsigned char* va = VT + ql * VT_PITCH + (32 * nt + 16 * s + 4 * half) * 2;
                s16x4 lo[4], hi[4];
#pragma unroll
                for (int dt = 0; dt < 4; ++dt) { lo[dt] = *(const LAS s16x4*)(va + 32 * dt * VT_PITCH); hi[dt] = *(const LAS s16x4*)(va + 32 * dt * VT_PITCH + 16); }
#pragma unroll
                for (int dt = 0; dt < 4; ++dt) { const bf16x8 afrag = __builtin_shufflevector(lo[dt], hi[dt], 0, 1, 2, 3, 4, 5, 6, 7); ot[dt] = MFMA32(afrag, bfrag, ot[dt]); }
            }
        } else {
            if (impwrite) {
                const float meff = lanevalid ? m : 3.0e30f;
#pragma unroll
                for (int r = 0; r < 16; r += 2) { const float p0 = __builtin_amdgcn_exp2f(st[r] - meff) * invl, p1 = __builtin_amdgcn_exp2f(st[r + 1] - meff) * invl;
                    imp_row[jbase + 16 * nt + ((r & 3) >> 1) + 4 * (r >> 2) + 2 * half] = p0 + p1; }
            }
        }
    }
}

__device__ __forceinline__ void attn_item(const P& p, Frame& F, const bool is_s, const int b, const int g, const int c) {
    unsigned char* ws = p.ws;
    const bf16* Q = (const bf16*)(ws + WS_Q); const bf16* KVN = (const bf16*)(ws + WS_KVN); const bf16* WINN = (const bf16*)(ws + WS_WINN);
    const bf16* VTS = (const bf16*)(ws + WS_VTS); const bf16* VTW = (const bf16*)(ws + WS_VTW);
    const float* KC = (const float*)(ws + WS_KC); const float* NGt = (const float*)(ws + WS_NG); bf16* YN = (bf16*)(ws + WS_YNSA);
    { int t_ = threadIdx.x; asm volatile("" : "+v"(t_)); F.tid = t_; F.lane = t_ & 63; }
    const int hh = F.wave & 3, qh = F.wave >> 2, ql = F.lane & 31, half = F.lane >> 5, h = 4 * g + hh, iq = 32 * qh + ql;
    const bool qvalid = is_s ? (qh == 0 && ql < 4) : true;
    const int t = is_s ? PAST + ql : 64 * c + iq;
    const int mrow = is_s ? (qvalid ? MP + b * 4 + ql : MP) : b * TP + t;
    const int item8 = (is_s ? 512 + b * 2 + g : (b * 2 + g) * 32 + c) * 8;
#define PKP(var) unsigned char* var; { int l_ = threadIdx.x; asm volatile("" : "+v"(l_)); var = ws + WS_PARK + (size_t)(item8 + (l_ >> 6)) * 8192 + (l_ & 63) * 16; }
    LAS float* BT4 = (LAS float*)(F.lds + A_BT); LAS float* IMP = (LAS float*)(F.lds + A_IMP); LAS unsigned* SELM = (LAS unsigned*)(F.lds + A_SELM);
    LAS int* UL = (LAS int*)(F.lds + A_UL); LAS int* UM = (LAS int*)(F.lds + A_UM); LAS int* NU = (LAS int*)(F.lds + A_NU); LAS int* SELB = (LAS int*)(F.lds + A_SELB);
    __syncthreads();
    { const float* BTg = (const float*)(ws + WS_BTAB) + (size_t)(4 * g) * 1024;
      constexpr int NBT = (4 * BTX + NTHR - 1) / NTHR; float bt_[NBT];
#pragma unroll
      for (int k = 0; k < NBT; ++k) { const int i = F.tid + k * NTHR; const int hq = i / BTX, dd = i - hq * BTX; bt_[k] = i < 4 * BTX ? BTg[hq * 1024 + (dd < 1023 ? dd : 1023)] : 0.f; }
#pragma unroll
      for (int k = 0; k < NBT; ++k) { const int i = F.tid + k * NTHR; if (i < 4 * BTX) BT4[i] = bt_[k] * 1.4426950408889634f; }
      if (F.tid < 64) SELM[F.tid] = 0u; }
    const LAS float* btab = BT4 + hh * BTX;
    bf16x8 qf[8];
#pragma unroll
    for (int ks = 0; ks < 8; ++ks) { u32x4 w = (u32x4){0u, 0u, 0u, 0u}; if (qvalid) w = *(const u32x4*)(Q + (size_t)mrow * 1024 + h * 128 + 16 * ks + 8 * half); qf[ks] = __builtin_bit_cast(bf16x8, w); }
    f32x16 ot[4];
#pragma unroll
    for (int dt = 0; dt < 4; ++dt)
#pragma unroll
        for (int i = 0; i < 16; ++i) ot[dt][i] = 0.f;
    float m = NEG_M, l = 0.f;
    const int HUGE_W = 0x3fffffff;
    const int ncmp = is_s ? 4 : 1;
    const float* kc_k = KC + (size_t)(is_s ? 1024 + (b * 256) * 2 + g : (b * 64) * 2 + g) * 256;
    const float* kc_v = kc_k + (size_t)CMPROWS * 256;
    const int* pt = (const int*)p.in[I_PT] + b * NPAGES; const float* ckv = p.in[I_CKV]; const float* cw = p.in[I_CWIN];
    unsigned selm = 0u; int nu = 0; float invl = 0.f;
#pragma nounroll
    for (int ph = 0; ph < 4; ++ph) {
        if (ph == 1) { const float lt = l + __shfl_xor(l, 32); invl = lt > 0.f ? 1.0f / lt : 0.f; const float sc = NGt[(size_t)mrow * 32 + 0 * 8 + h] * invl;
            if (qvalid) {
                PKP(PK);
#pragma unroll
                for (int dt = 0; dt < 4; ++dt)
#pragma unroll
                    for (int hf = 0; hf < 2; ++hf) { u32x4 w; w.x = pk2(ot[dt][8 * hf + 0] * sc, ot[dt][8 * hf + 1] * sc); w.y = pk2(ot[dt][8 * hf + 2] * sc, ot[dt][8 * hf + 3] * sc);
                        w.z = pk2(ot[dt][8 * hf + 4] * sc, ot[dt][8 * hf + 5] * sc); w.w = pk2(ot[dt][8 * hf + 6] * sc, ot[dt][8 * hf + 7] * sc); *(u32x4*)(PK + (2 * dt + hf) * 1024) = w; } } }
        if (ph == 2) {
            __syncthreads();
            int tid2 = F.tid; asm volatile("" : "+v"(tid2));
            if (!is_s) {
                { const int q = tid2 >> 3, jg = tid2 & 7; const int tq = 64 * c + q;
#pragma unroll
                  for (int jj = 0; jj < 4; ++jj) { const int j = jg * 4 + jj; float v = ((IMP[(0 * 64 + q) * 33 + j] + IMP[(1 * 64 + q) * 33 + j]) + IMP[(2 * 64 + q) * 33 + j]) + IMP[(3 * 64 + q) * 33 + j];
                      if (j == 0 || j == c || j == c - 1) v += 1e4f; if (j * 64 > tq) v = NEGB; IMP[q * 33 + j] = v; } }
                __syncthreads();
                { const int q = tid2 >> 3, jg = tid2 & 7; unsigned bits = 0u;
                  for (int jj = 0; jj < 4; ++jj) { const int j = jg * 4 + jj; const float vj = IMP[q * 33 + j]; int rank = 0;
#pragma nounroll
                      for (int i = 0; i < 32; ++i) { const float vi = IMP[q * 33 + i]; rank += (vi > vj || (vi == vj && i < j)) ? 1 : 0; }
                      if (rank < 16) bits |= 1u << j; }
                  if (bits) atomicOr((unsigned*)&SELM[q], bits); }
                __syncthreads();
                selm = SELM[iq];
            } else {
                for (int i = tid2; i < 4 * 129; i += NTHR) { const int q = i / 129, j = i % 129; float v = 0.f;
                    if (j < 128) v = ((IMP[(0 * 4 + q) * 132 + j] + IMP[(1 * 4 + q) * 132 + j]) + IMP[(2 * 4 + q) * 132 + j]) + IMP[(3 * 4 + q) * 132 + j];
                    if (j == 0 || j == 128 || j == 127) v += 1e4f;
                    SELB[q * 132 + j] = __float_as_int(v); }
                __syncthreads();
                int sel0 = 0, sel1 = 0;
                { const int i = tid2; const int q = i / 129, j = i % 129; const float vj = __int_as_float(SELB[q * 132 + j]); int rank = 0;
                    for (int x = 0; x < 129; ++x) { const float vi = __int_as_float(SELB[q * 132 + x]); rank += (vi > vj || (vi == vj && x < j)) ? 1 : 0; }
                    sel0 = rank < 16 ? 1 : 0; }
                if (tid2 < 4) { const int i = tid2 + NTHR; const int q = i / 129, j = i % 129; const float vj = __int_as_float(SELB[q * 132 + j]); int rank = 0;
                    for (int x = 0; x < 129; ++x) { const float vi = __int_as_float(SELB[q * 132 + x]); rank += (vi > vj || (vi == vj && x < j)) ? 1 : 0; }
                    sel1 = rank < 16 ? 1 : 0; }
                __syncthreads();
                { const int i = tid2; SELB[(i / 129) * 132 + i % 129] = sel0; }
                if (tid2 < 4) { const int i = tid2 + NTHR; SELB[(i / 129) * 132 + i % 129] = sel1; }
                __syncthreads();
                if (tid2 == 0) { int n = 0; for (int j = 0; j < 129; ++j) { const int msk = SELB[j] | (SELB[132 + j] << 1) | (SELB[264 + j] << 2) | (SELB[396 + j] << 3); if (msk) { UL[n] = j; UM[n] = msk; ++n; } } NU[0] = n; }
                __syncthreads();
                nu = NU[0];
            }
        }
        if (ph >= 2) {
            if (ph == 3) { const float lt = l + __shfl_xor(l, 32); const float sc = lt > 0.f ? NGt[(size_t)mrow * 32 + 1 * 8 + h] / lt : 0.f;
                if (qvalid) { PKP(PK);
#pragma unroll
                    for (int dt = 0; dt < 4; ++dt)
#pragma unroll
                        for (int hf = 0; hf < 2; ++hf) { u32x4* yp = (u32x4*)(PK + (2 * dt + hf) * 1024); const u32x4 o = *yp; u32x4 w;
                            w.x = pk2(bflo(o.x) + ot[dt][8 * hf + 0] * sc, bfhi(o.x) + ot[dt][8 * hf + 1] * sc); w.y = pk2(bflo(o.y) + ot[dt][8 * hf + 2] * sc, bfhi(o.y) + ot[dt][8 * hf + 3] * sc);
                            w.z = pk2(bflo(o.z) + ot[dt][8 * hf + 4] * sc, bfhi(o.z) + ot[dt][8 * hf + 5] * sc); w.w = pk2(bflo(o.w) + ot[dt][8 * hf + 6] * sc, bfhi(o.w) + ot[dt][8 * hf + 7] * sc); *yp = w; } } }
#pragma unroll
            for (int dt = 0; dt < 4; ++dt)
#pragma unroll
                for (int i = 0; i < 16; ++i) ot[dt][i] = 0.f;
            m = NEG_M; l = 0.f;
        }
        const int ntiles = ph < 2 ? ncmp : (ph == 2 ? (is_s ? nu : c + 1) : (is_s ? 9 : (c >= 8 ? 9 : c + 1)));
        const int t_lo = t - ql;
        TileRegs tr;
#pragma nounroll
        for (int i = 0; i < ntiles; ++i) {
            const void* kp; const void* vp; int pitch, nvalid = 64, kp0, kstride = 1, wl = HUGE_W, mode = 2; bool lv = qvalid;
            if (ph < 2) { kp = kc_k + (size_t)(64 * i) * 512; vp = kc_v + (size_t)(64 * i) * 512; pitch = 512; mode = 1; kp0 = 2048 * i + 31; kstride = 32; }
            else if (ph == 2) {
                if (!is_s) { kp = KVN + (size_t)(b * TP + 64 * i) * 1024 + 2 * 256 + g * 128; vp = VTS + ((size_t)((b * 2 + g) * 32 + i) * 128) * 64; pitch = 1024; kp0 = 64 * i; lv = ((selm >> i) & 1u) != 0u; mode = 0; }
                else { const int j = UL[i], msk = UM[i]; kp0 = 64 * j; pitch = 1024; lv = qvalid && ((msk >> (ql & 3)) & 1);
                    if (j < 128) { const int page = pt[j >> 1]; const float* kb = ckv + ((size_t)(page * PAGE + (j & 1) * 64) * 4 + 2) * 256 + g * 128; kp = kb; vp = kb + 256; mode = 1; }
                    else { const bf16* kb = KVN + (size_t)(MP + b * 4) * 1024 + 2 * 256 + g * 128; kp = kb; vp = kb + 256; nvalid = 4; } }
            } else { wl = 512; pitch = 512;
                if (!is_s) { const int j = (c >= 8 ? c - 8 : 0) + i; kp = WINN + (size_t)(b * TP + 64 * j) * 512 + g * 128; vp = VTW + ((size_t)((b * 2 + g) * 32 + j) * 128) * 64; kp0 = 64 * j; mode = 0; }
                else { kp0 = PAST - 512 + 64 * i;
                    if (i < 8) { const float* kb = cw + ((size_t)(b * 512 + 64 * i) * 2) * 256 + g * 128; kp = kb; vp = kb + 256; mode = 1; }
                    else { const bf16* kb = WINN + (size_t)(MP + b * 4) * 512 + g * 128; kp = kb; vp = kb + 256; nvalid = 4; } }
            }
            int tid = F.tid; asm volatile("" : "+v"(tid));
            const bool loader = is_s && tid >= 256;
            const int boff = (is_s || mode == 0) ? (i & 1) * A_BUF2 : 0;
            if (is_s) {
                if (i == 0) { __syncthreads(); if (loader) loader_stage(F, kp, vp, pitch, mode == 1, nvalid, tid - 256, 0); }
                __syncthreads();
                if (loader && i + 1 < ntiles) { const void* kp1; const void* vp1; int pitch1, nv1; bool f1; SAMPLE_TILE(i + 1, kp1, vp1, pitch1, f1, nv1); loader_stage(F, kp1, vp1, pitch1, f1, nv1, tid - 256, ((i + 1) & 1) * A_BUF2); }
            } else if (mode == 0) {
                if (i == 0) { __syncthreads(); tile_load(tr, (const bf16*)kp, (const bf16*)vp, pitch, tid); tile_store(F, tr, tid, 0); if (ntiles > 1) tile_load(tr, (const bf16*)kp + (size_t)64 * pitch, (const bf16*)vp + 128 * 64, pitch, tid); }
                __syncthreads();
                if (i + 1 < ntiles) { tile_store(F, tr, tid, ((i + 1) & 1) * A_BUF2); if (i + 2 < ntiles) tile_load(tr, (const bf16*)kp + (size_t)128 * pitch, (const bf16*)vp + 2 * 128 * 64, pitch, tid); }
            } else if (!(ph == 1 && !is_s)) {
                __syncthreads();
                stage_tile(F, kp, vp, pitch, mode == 1, nvalid);
                __syncthreads();
            }
            const bool far = nvalid == 64 && kstride == 1 && (t_lo - (kp0 + 63) >= 1023) && (t_lo + 31 - kp0 < wl);
            const bool interior = !is_s && nvalid == 64 && kstride == 1 && (kp0 + 63 <= t_lo) && (t_lo + 31 - kp0 < wl);
            if (loader) continue;
            if (ph == 1) { LAS float* imp_row = IMP + (is_s ? (hh * 4 + (ql & 3)) * 132 : (hh * 64 + iq) * 33); tile_compute<1>(F, boff, btab, qf, t, lv, kp0, kstride, nvalid, wl, far, interior, m, l, ot, invl, imp_row, 32 * i, qvalid); }
            else tile_compute<0>(F, boff, btab, qf, t, lv, kp0, kstride, nvalid, wl, far, interior, m, l, ot, 0.f, nullptr, 0, false);
        }
    }
    { const float lt = l + __shfl_xor(l, 32); const float sc = lt > 0.f ? NGt[(size_t)mrow * 32 + 2 * 8 + h] / lt : 0.f;
      if (qvalid) { PKP(PK);
#pragma unroll
          for (int dt = 0; dt < 4; ++dt)
#pragma unroll
              for (int hf = 0; hf < 2; ++hf) { const u32x4 o4 = *(const u32x4*)(PK + (2 * dt + hf) * 1024);
#pragma unroll
                  for (int rr = 0; rr < 2; ++rr) { const int r4 = 2 * hf + rr; const int d0 = 32 * dt + 8 * r4 + 4 * half; const u32x2 o = rr ? (u32x2){o4.z, o4.w} : (u32x2){o4.x, o4.y};
                      u32x2 w; w.x = pk2(bflo(o.x) + ot[dt][4 * r4 + 0] * sc, bfhi(o.x) + ot[dt][4 * r4 + 1] * sc); w.y = pk2(bflo(o.y) + ot[dt][4 * r4 + 2] * sc, bfhi(o.y) + ot[dt][4 * r4 + 3] * sc);
                      *(u32x2*)(YN + (size_t)mrow * 1024 + h * 128 + d0) = w; } } } }
}

#undef PKP
__device__ __forceinline__ void vt_build(const P& p, Frame& F, int wg, int nwg) {
    const bf16* KVN = (const bf16*)(p.ws + WS_KVN); const bf16* WINN = (const bf16*)(p.ws + WS_WINN);
    const int gw = wg * NWAVES + F.wave, NGW = nwg * NWAVES, key = F.lane;
    for (int it = gw; it < 2 * 512 * 8; it += NGW) { const int which = it >> 12, blkid = (it >> 3) & 511, dc = it & 7;
        const int b = blkid >> 6, g = (blkid >> 5) & 1, blk = blkid & 31; const int row = b * TP + 64 * blk + key;
        const bf16* src = which == 0 ? KVN + (size_t)row * 1024 + 3 * 256 + g * 128 + dc * 16 : WINN + (size_t)row * 512 + 256 + g * 128 + dc * 16;
        const u32x4 o0 = *(const u32x4*)src, o1 = *(const u32x4*)(src + 8);
        bf16* dst = (bf16*)(p.ws + (which == 0 ? WS_VTS : WS_VTW)) + ((size_t)blkid * 128 + dc * 16) * 64 + key;
        const unsigned w[8] = {o0.x, o0.y, o0.z, o0.w, o1.x, o1.y, o1.z, o1.w};
#pragma unroll
        for (int i = 0; i < 8; ++i) { dst[(2 * i) * 64] = (bf16)(w[i] & 0xffffu); dst[(2 * i + 1) * 64] = (bf16)(w[i] >> 16); } }
}
__device__ __forceinline__ float prw_prev(const P& p, const bf16* PRW, int m, int col) {
    if (m < MP) { return (m & (TP - 1)) == 0 ? 0.f : bf2f(PRW[(size_t)(m - 1) * RWP + col]); }
    const int x = m - MP; return (x & 3) == 0 ? p.in[I_SSH][(size_t)(x >> 2) * RWP + col] : bf2f(PRW[(size_t)(m - 1) * RWP + col]);
}
__device__ __forceinline__ void lora_prep(const P& p, Frame& F) {
    const bf16* PRW = (const bf16*)(p.ws + WS_PRW); bf16* AL = (bf16*)(p.ws + WS_ALORA); const float* mu = p.in[I_MU];
    const int gt = F.bid * NTHR + F.tid, NGT = F.G * NTHR;
    for (int i = gt; i < MPAD * 256; i += NGT) { const int m = i >> 8, k = i & 255; float v = 0.f;
        if (m < MT) { const int col = 3072 + k; const float pc = bf2f(PRW[(size_t)m * RWP + col]), pp = prw_prev(p, PRW, m, col); const float xs = pc + (pp - pc) * mu[col];
            v = k < 64 ? 1.0f - 2.0f / (1.0f + __expf(2.0f * xs)) : (k < 128 ? xs : sigmoidf_(xs)); }
        AL[i] = (bf16)(pk2(v, 0.f) & 0xffffu); }
}
__device__ __forceinline__ void acmp_build(const P& p, Frame& F) {
    const bf16* KVN = (const bf16*)(p.ws + WS_KVN); bf16* AC = (bf16*)(p.ws + WS_ACMP); const float* pe = p.in[I_PE]; const float* ckv = p.in[I_CKV]; const int* pt = (const int*)p.in[I_PT];
    const int gw = F.bid * NWAVES + F.wave, NGW = F.G * NWAVES, lane = F.lane;
    const int ph = lane >> 4, d = (lane & 15) * 8;
    for (int it = gw; it < 2 * CMPROWS; it += NGW) { const int kv = it / CMPROWS, R = it % CMPROWS; bf16* dst = AC + (size_t)it * 4096;
        if (R < 1024) { const int b = R >> 7, n = (R >> 1) & 63, g = R & 1;
#pragma unroll
            for (int pp = 0; pp < 32; pp += 4) { const int pos = pp + ph; const u32x4 w = *(const u32x4*)(KVN + (size_t)(b * TP + n * 32 + pos) * 1024 + kv * 256 + g * 128 + d);
                const f32x4 e0 = *(const f32x4*)(pe + (pos * 2 + kv) * 128 + d), e1 = *(const f32x4*)(pe + (pos * 2 + kv) * 128 + d + 4);
                *(u32x4*)(dst + pos * 128 + d) = pack8((f32x4){bflo(w.x), bfhi(w.x), bflo(w.y), bfhi(w.y)} + e0, (f32x4){bflo(w.z), bfhi(w.z), bflo(w.w), bfhi(w.w)} + e1); } }
        else { const int Rs = R - 1024, b = Rs >> 9, n = (Rs >> 1) & 255, g = Rs & 1; const int page = pt[b * NPAGES + (n >> 2)];
            const float* src = ckv + ((size_t)(page * PAGE + (n & 3) * 32) * 4 + kv) * 256 + g * 128 + d;
            f32x4 x0[8], x1[8];
#pragma unroll
            for (int i = 0; i < 8; ++i) { const int pos = 4 * i + ph; x0[i] = *(const f32x4*)(src + (size_t)pos * 1024); x1[i] = *(const f32x4*)(src + (size_t)pos * 1024 + 4); }
#pragma unroll
            for (int i = 0; i < 8; ++i) { const int pos = 4 * i + ph; const f32x4 e0 = *(const f32x4*)(pe + (pos * 2 + kv) * 128 + d), e1 = *(const f32x4*)(pe + (pos * 2 + kv) * 128 + d + 4);
                *(u32x4*)(dst + pos * 128 + d) = pack8(x0[i] + e0, x1[i] + e1); } }
    }
}
__device__ __forceinline__ float red16(float x) {
    x += __builtin_bit_cast(float, __builtin_amdgcn_update_dpp(0, __builtin_bit_cast(int, x), 0xB1, 0xF, 0xF, true));
    x += __builtin_bit_cast(float, __builtin_amdgcn_update_dpp(0, __builtin_bit_cast(int, x), 0x4E, 0xF, 0xF, true));
    x += __builtin_bit_cast(float, __builtin_amdgcn_update_dpp(0, __builtin_bit_cast(int, x), 0x141, 0xF, 0xF, true));
    x += __builtin_bit_cast(float, __builtin_amdgcn_update_dpp(0, __builtin_bit_cast(int, x), 0x140, 0xF, 0xF, true));
    return x;
}
__device__ __forceinline__ f32x4 bf4(const u32x2 w) { return (f32x4){bflo(w.x), bfhi(w.x), bflo(w.y), bfhi(w.y)}; }
__device__ __forceinline__ void scan_prep(const P& p, Frame& F) {
    const bf16* PRW = (const bf16*)(p.ws + WS_PRW); const float* AA = (const float*)(p.ws + WS_AA); const float* DEC = (const float*)(p.ws + WS_DEC);
    bf16* OPSB = (bf16*)(p.ws + WS_OPS); float* WQ = (float*)(p.ws + WS_WQ); bf16* VVB = (bf16*)(p.ws + WS_VV); float* CB = (float*)(p.ws + WS_CB); const float* mu = p.in[I_MU];
    const int gw = F.bid * NWAVES + F.wave, NGW = F.G * NWAVES, q = F.lane >> 4, c = F.lane & 15;
    for (int it = MP * 4 + gw; it < MT * 4; it += NGW) { const int m = it >> 2, h = 4 * (it & 3) + q, c0 = h * 64 + 4 * c;
        const bool first = m < MP ? (m & (TP - 1)) == 0 : ((m - MP) & 3) == 0;
        f32x4 pc[3], pp[3];
#pragma unroll
        for (int x = 0; x < 3; ++x) { const int col = x * 1024 + c0; pc[x] = bf4(*(const u32x2*)(PRW + (size_t)m * RWP + col));
            if (!first) pp[x] = bf4(*(const u32x2*)(PRW + (size_t)(m - 1) * RWP + col));
            else if (m < MP) pp[x] = (f32x4){0.f, 0.f, 0.f, 0.f};
            else pp[x] = *(const f32x4*)(p.in[I_SSH] + (size_t)((m - MP) >> 2) * RWP + col); }
        const f32x4 a = *(const f32x4*)(AA + (size_t)m * 1024 + c0), w = *(const f32x4*)(DEC + (size_t)m * 1024 + c0);
        f32x4 xs[3];
#pragma unroll
        for (int x = 0; x < 3; ++x) xs[x] = pc[x] + (pp[x] - pc[x]) * *(const f32x4*)(mu + x * 1024 + c0);
        const f32x4 kmod = xs[1] * (1.0f + (a - 1.0f) * *(const f32x4*)(p.in[I_KA] + c0)); const f32x4 kkr = xs[1] * *(const f32x4*)(p.in[I_KK] + c0);
        const float nrm = sqrtf(red16((kkr.x * kkr.x + kkr.y * kkr.y) + (kkr.z * kkr.z + kkr.w * kkr.w))); const f32x4 kk = kkr * (1.0f / fmaxf(nrm, 1e-12f));
        const f32x4 rk = *(const f32x4*)(p.in[I_RK] + c0); const f32x4 t3 = xs[0] * kmod * rk; const float cb = red16((t3.x + t3.y) + (t3.z + t3.w));
        size_t sr; if (m < MP) sr = (size_t)((m >> 11) * RWH + h) * TP + (m & (TP - 1)); else { const int x = m - MP; sr = (size_t)NSEQ_P * TP + (size_t)((x >> 2) * RWH + h) * TS + (x & 3); }
        bf16* o = OPSB + sr * 256 + 4 * c;
        { const f32x4 na = -(kk * a); u32x2 u; u.x = pk2(kk.x, kk.y); u.y = pk2(kk.z, kk.w); *(u32x2*)o = u; u.x = pk2(na.x, na.y); u.y = pk2(na.z, na.w); *(u32x2*)(o + 64) = u;
          u.x = pk2(kmod.x, kmod.y); u.y = pk2(kmod.z, kmod.w); *(u32x2*)(o + 128) = u; u.x = pk2(xs[0].x, xs[0].y); u.y = pk2(xs[0].z, xs[0].w); *(u32x2*)(o + 192) = u;
          u.x = pk2(xs[2].x, xs[2].y); u.y = pk2(xs[2].z, xs[2].w); *(u32x2*)(VVB + sr * 64 + 4 * c) = u; }
        *(f32x4*)(WQ + sr * 64 + 4 * c) = w;
        if (c == 0) CB[(size_t)m * 16 + h] = cb; }
}
__device__ __forceinline__ float red8(float x) {
    x += __builtin_bit_cast(float, __builtin_amdgcn_update_dpp(0, __builtin_bit_cast(int, x), 0xB1, 0xF, 0xF, true));
    x += __builtin_bit_cast(float, __builtin_amdgcn_update_dpp(0, __builtin_bit_cast(int, x), 0x4E, 0xF, 0xF, true));
    x += __builtin_bit_cast(float, __builtin_amdgcn_update_dpp(0, __builtin_bit_cast(int, x), 0x141, 0xF, 0xF, true));
    return x;
}
constexpr int S_OPL = 0, S_VL = 81920, S_YL = 98304;
__device__ __forceinline__ void scan_half(const P& p, Frame& F, size_t sr0, int T, const float* S0, float* Sout, int m0, int h, int hf) {
    const bf16* OPSB = (const bf16*)(p.ws + WS_OPS); const float* WQ = (const float*)(p.ws + WS_WQ); const bf16* VVB = (const bf16*)(p.ws + WS_VV); bf16* YRAW = (bf16*)(p.ws + WS_YRAW);
    const int lane = F.lane, wave = F.wave, tid = F.tid, r = lane >> 4, c = lane & 15, rowl = 4 * wave + r, row = 32 * hf + rowl;
    f32x2 S2[2];
#pragma unroll
    for (int j = 0; j < 2; ++j) S2[j] = S0 ? *(const f32x2*)(S0 + row * 64 + 4 * c + 2 * j) : (f32x2){0.f, 0.f};
    const int nch = (T + 31) >> 5;
    u32x4 pb0, pb1; f32x4 pw; u32x2 pv;
    const int stt = tid >> 4, sq = (tid & 15) >> 2, scol = (tid & 3) * 16;
    const int lo_ = stt * 320 + (sq == 0 ? 0 : sq + 1) * 64 + scol, lw_ = stt * 320 + 64 + (tid & 15) * 4, lv_ = stt * 64 + (tid & 15) * 4;
#define SCAN_FETCH(srow) do { const char* so_ = (const char*)(OPSB + (srow) * 256); pb0 = *(const u32x4*)(so_ + (size_t)tid * 32); pb1 = *(const u32x4*)(so_ + (size_t)tid * 32 + 16); \
        pw = *(const f32x4*)((const char*)(WQ + (srow) * 64) + (size_t)tid * 16); pv = *(const u32x2*)((const char*)(VVB + (srow) * 64) + (size_t)tid * 8); } while (0)
#define SCAN_PUT(bufi) do { LAS float* d_ = (LAS float*)(F.lds + S_OPL + (bufi) * 40960); \
        *(LAS f32x4*)(d_ + lo_) = (f32x4){bflo(pb0.x), bfhi(pb0.x), bflo(pb0.y), bfhi(pb0.y)}; *(LAS f32x4*)(d_ + lo_ + 4) = (f32x4){bflo(pb0.z), bfhi(pb0.z), bflo(pb0.w), bfhi(pb0.w)}; \
        *(LAS f32x4*)(d_ + lo_ + 8) = (f32x4){bflo(pb1.x), bfhi(pb1.x), bflo(pb1.y), bfhi(pb1.y)}; *(LAS f32x4*)(d_ + lo_ + 12) = (f32x4){bflo(pb1.z), bfhi(pb1.z), bflo(pb1.w), bfhi(pb1.w)}; \
        *(LAS f32x4*)(d_ + lw_) = pw; *(LAS f32x4*)((LAS float*)(F.lds + S_VL + (bufi) * 8192) + lv_) = (f32x4){bflo(pv.x), bfhi(pv.x), bflo(pv.y), bfhi(pv.y)}; } while (0)
    SCAN_FETCH(sr0);
    __syncthreads();
    SCAN_PUT(0);
    __syncthreads();
    for (int k = 0; k < nch; ++k) {
        const int buf = k & 1, t0 = k * 32, ns = (T - t0) < 32 ? (T - t0) : 32;
        if (k + 1 < nch) SCAN_FETCH(sr0 + t0 + 32);
        const LAS float* opl = (const LAS float*)(F.lds + S_OPL + buf * 40960) + c * 4;
        const LAS float* vl = (const LAS float*)(F.lds + S_VL + buf * 8192) + row;
        LAS float* yl = (LAS float*)(F.lds + S_YL + buf * 4096) + rowl;
#define SCAN_LOAD(o, v, tt) do { const LAS f32x4* o4_ = (const LAS f32x4*)(opl + (tt) * 320); _Pragma("unroll") for (int q_ = 0; q_ < 5; ++q_) o[q_] = o4_[16 * q_]; v = vl[(tt) * 64]; } while (0)
#define SCAN_STEP(o, v, tt) do { \
            f32x2 acc_ = S2[0] * (f32x2){o[0].x, o[0].y}; acc_ = S2[1] * (f32x2){o[0].z, o[0].w} + acc_; \
            const float sk_ = red16(acc_.x + acc_.y); const f32x2 sk2_ = (f32x2){sk_, sk_}, v2_ = (f32x2){v, v}; \
            S2[0] = S2[0] * (f32x2){o[1].x, o[1].y} + (sk2_ * (f32x2){o[2].x, o[2].y} + v2_ * (f32x2){o[3].x, o[3].y}); \
            S2[1] = S2[1] * (f32x2){o[1].z, o[1].w} + (sk2_ * (f32x2){o[2].z, o[2].w} + v2_ * (f32x2){o[3].z, o[3].w}); \
            f32x2 ya_ = S2[0] * (f32x2){o[4].x, o[4].y}; ya_ = S2[1] * (f32x2){o[4].z, o[4].w} + ya_; \
            const float y_ = red16(ya_.x + ya_.y); if (c == 0) yl[(tt) * 32] = y_; } while (0)
        { f32x4 oa[5], ob[5]; float va, vb;
          SCAN_LOAD(oa, va, 0);
          int tt = 0;
          for (; tt + 1 < ns; tt += 2) {
              SCAN_LOAD(ob, vb, tt + 1);
              SCAN_STEP(oa, va, tt);
              if (tt + 2 < ns) SCAN_LOAD(oa, va, tt + 2);
              SCAN_STEP(ob, vb, tt + 1);
          }
          if (tt < ns) SCAN_STEP(oa, va, tt);
        }
#undef SCAN_LOAD
#undef SCAN_STEP
        __syncthreads();
        { const int tt = tid >> 4, rl = (tid & 15) * 2;
          if (tt < ns) { const LAS float* ys = (const LAS float*)(F.lds + S_YL + buf * 4096) + tt * 32 + rl;
              *(unsigned*)(YRAW + (size_t)(m0 + t0 + tt) * 1024 + h * 64 + 32 * hf + rl) = pk2(ys[0], ys[1]); } }
        if (k + 1 < nch) SCAN_PUT(buf ^ 1);
        __syncthreads();
    }
#pragma unroll
    for (int j = 0; j < 2; ++j) *(f32x2*)(Sout + row * 64 + 4 * c + 2 * j) = S2[j];
#undef SCAN_FETCH
#undef SCAN_PUT
}
__device__ __forceinline__ void scan_sample(const P& p, Frame& F, int wg, int nwg) {
    for (int task = wg; task < 2 * NSEQ_S; task += nwg) { const int s = task >> 1, hf = task & 1;
        scan_half(p, F, (size_t)NSEQ_P * TP + (size_t)s * TS, TS, p.in[I_SRW] + (size_t)s * 4096, p.out + O_RS + (size_t)s * 4096, MP + (s >> 4) * TS, s & 15, hf); }
}
__device__ __forceinline__ void rwkv_post(const P& p, Frame& F) {
    const bf16* YRAW = (const bf16*)(p.ws + WS_YRAW); const bf16* VVB = (const bf16*)(p.ws + WS_VV); const float* CB = (const float*)(p.ws + WS_CB); const bf16* GG = (const bf16*)(p.ws + WS_GG);
    bf16* YRW = (bf16*)(p.ws + WS_YRW);
    const int gw = F.bid * NWAVES + F.wave, NGW = F.G * NWAVES, q = F.lane >> 4, c = F.lane & 15;
    for (int it = gw; it < MT * 4; it += NGW) { const int m = it >> 2, h = 4 * (it & 3) + q, c0 = h * 64 + 4 * c;
        size_t sr; if (m < MP) sr = (size_t)((m >> 11) * RWH + h) * TP + (m & (TP - 1)); else { const int x = m - MP; sr = (size_t)NSEQ_P * TP + (size_t)((x >> 2) * RWH + h) * TS + (x & 3); }
        const f32x4 y = bf4(*(const u32x2*)(YRAW + (size_t)m * 1024 + c0)), vv = bf4(*(const u32x2*)(VVB + sr * 64 + 4 * c)), g = bf4(*(const u32x2*)(GG + (size_t)m * 1024 + c0));
        const float cb = CB[(size_t)m * 16 + h];
        const float mean = red16((y.x + y.y) + (y.z + y.w)) * (1.0f / 64.0f); const f32x4 dd = y - mean;
        const float var = red16((dd.x * dd.x + dd.y * dd.y) + (dd.z * dd.z + dd.w * dd.w)) * (1.0f / 64.0f);
        const f32x4 yn = dd * (1.0f / sqrtf(var + RW_LN_EPS)) * *(const f32x4*)(p.in[I_LNW] + c0) + *(const f32x4*)(p.in[I_LNB] + c0);
        const f32x4 o = (yn + vv * cb) * g;
        u32x2 w; w.x = pk2(o.x, o.y); w.y = pk2(o.z, o.w); *(u32x2*)(YRW + (size_t)m * 1024 + c0) = w; }
}
constexpr int CK_SLOT = 8192, CK_GC = 16 * CK_SLOT, CK_PAR = CK_GC + 256 + 2048;
constexpr size_t CK_TASK_BYTES = 4 * 8192;
__device__ __forceinline__ int ck_crow(int r, int half) { return (r & 3) + 8 * (r >> 2) + 4 * half; }
__device__ __forceinline__ f32x16 ck_zero() { f32x16 z;
#pragma unroll
    for (int i = 0; i < 16; ++i) z[i] = 0.f;
    return z; }
__device__ __forceinline__ f32x16 ck_mm(const LAS unsigned char* A, const LAS unsigned char* BT, int mt, int nt, int ql, int half, f32x16 acc) {
    const LAS unsigned char* ar = A + (32 * mt + ql) * 128; const LAS unsigned char* br = BT + (32 * nt + ql) * 128; const int sw = ql & 7;
    f32x16 acc2 = ck_zero();
#pragma unroll
    for (int ks = 0; ks < 4; ++ks) { const int off = ((2 * ks + half) ^ sw) << 4; const bf16x8 a = *(const LAS bf16x8*)(ar + off), b = *(const LAS bf16x8*)(br + off); if (ks & 1) acc2 = MFMA32(a, b, acc2); else acc = MFMA32(a, b, acc); }
#pragma unroll
    for (int i = 0; i < 16; ++i) acc[i] += acc2[i];
    return acc;
}
__device__ __forceinline__ void ck_store_t(LAS unsigned char* IMG, const f32x16& v, int mt, int nt, int ql, int half) {
    const int n = 32 * nt + ql; LAS unsigned char* row = IMG + n * 128;
#pragma unroll
    for (int g = 0; g < 4; ++g) { const int m0 = 32 * mt + 8 * g + 4 * half; u32x2 w; w.x = pk2(v[4 * g], v[4 * g + 1]); w.y = pk2(v[4 * g + 2], v[4 * g + 3]);
        *(LAS u32x2*)(row + (((m0 >> 3) ^ (n & 7)) << 4) + (m0 & 4) * 2) = w; }
}
__device__ __forceinline__ void ck_store_n(LAS unsigned char* IMG, const f32x16& v, int mt, int nt, int ql, int half) {
    const int n = 32 * nt + ql;
#pragma unroll
    for (int r = 0; r < 16; ++r) { const int m = 32 * mt + ck_crow(r, half);
        *(LAS unsigned short*)(IMG + m * 128 + (((n >> 3) ^ (m & 7)) << 4) + (n & 7) * 2) = (unsigned short)(pk2(v[r], 0.f) & 0xffffu); }
}
__device__ __forceinline__ void ck_tr(const LAS unsigned char* SRC, LAS unsigned char* DST, int mt, int nt, int ql, int half) {
    const LAS unsigned char* ar = SRC + (32 * mt + ql) * 128; const int sw = ql & 7;
    f32x16 acc = ck_zero();
#pragma unroll
    for (int d = 0; d < 2; ++d) { const int ks = 2 * nt + d, off = ((2 * ks + half) ^ sw) << 4; const bf16x8 a = *(const LAS bf16x8*)(ar + off);
        const int e = ql - 16 * d - 8 * half; const unsigned val = (e & 1) ? 0x3F800000u : 0x00003F80u; const int w = (e >= 0 && e < 8) ? (e >> 1) : -1;
        const u32x4 bw = (u32x4){w == 0 ? val : 0u, w == 1 ? val : 0u, w == 2 ? val : 0u, w == 3 ? val : 0u};
        acc = MFMA32(a, __builtin_bit_cast(bf16x8, bw), acc); }
    ck_store_t(DST, acc, mt, nt, ql, half);
}
#define CKIN_DECL(PFX) u32x4 PFX##cr, PFX##ck, PFX##cv, PFX##pr, PFX##pk, PFX##pv; f32x4 PFX##a0, PFX##a1, PFX##w0, PFX##w1
#define CKIN_LOAD(PFX, task_) do { const int s_ = (task_) >> 5, c_ = (task_) & 31, b_ = s_ >> 4, h_ = s_ & 15, tid_ = threadIdx.x, t_ = tid_ >> 3, jg_ = tid_ & 7, m_ = b_ * TP + 64 * c_ + t_, c0_ = h_ * 64 + 8 * jg_; \
    const bf16* PRW_ = (const bf16*)(p.ws + WS_PRW); const float* AA_ = (const float*)(p.ws + WS_AA); const float* DEC_ = (const float*)(p.ws + WS_DEC); \
    PFX##cr = *(const u32x4*)(PRW_ + (size_t)m_ * RWP + c0_); PFX##ck = *(const u32x4*)(PRW_ + (size_t)m_ * RWP + 1024 + c0_); PFX##cv = *(const u32x4*)(PRW_ + (size_t)m_ * RWP + 2048 + c0_); \
    const int mp_ = (c_ == 0 && t_ == 0) ? m_ : m_ - 1;     \
    PFX##pr = *(const u32x4*)(PRW_ + (size_t)mp_ * RWP + c0_); PFX##pk = *(const u32x4*)(PRW_ + (size_t)mp_ * RWP + 1024 + c0_); PFX##pv = *(const u32x4*)(PRW_ + (size_t)mp_ * RWP + 2048 + c0_); \
    PFX##a0 = *(const f32x4*)(AA_ + (size_t)m_ * 1024 + c0_); PFX##a1 = *(const f32x4*)(AA_ + (size_t)m_ * 1024 + c0_ + 4); PFX##w0 = *(const f32x4*)(DEC_ + (size_t)m_ * 1024 + c0_); PFX##w1 = *(const f32x4*)(DEC_ + (size_t)m_ * 1024 + c0_ + 4); } while (0)
__device__ __forceinline__ void chunk_pre(const P& p, Frame& F, int task, int next_task, u32x4& icr, u32x4& ick, u32x4& icv, u32x4& ipr, u32x4& ipk, u32x4& ipv, f32x4& ia0, f32x4& ia1, f32x4& iw0, f32x4& iw1, int& ptag0, int& ptag1) {
    const int s = task >> 5, c = task & 31, b = s >> 4, h = s & 15, mbase = b * TP + 64 * c;
    const bf16* PRW = (const bf16*)(p.ws + WS_PRW); const float* AA = (const float*)(p.ws + WS_AA); const float* DEC = (const float*)(p.ws + WS_DEC);
    bf16* VVB = (bf16*)(p.ws + WS_VV); float* CB = (float*)(p.ws + WS_CB);
    unsigned char* outp = p.ws + WS_CHK + (size_t)task * CK_TASK_BYTES;
    int tid = threadIdx.x; asm volatile("" : "+v"(tid));
    const int lane = tid & 63, wave = __builtin_amdgcn_readfirstlane(tid >> 6), ql = lane & 31, half = lane >> 5, grp = wave >> 2, mt = (wave >> 1) & 1, nt = wave & 1;
    LAS unsigned char* L = F.lds;
#define SLOT(k) (L + (k) * CK_SLOT)
    LAS float* GC = (LAS float*)(L + CK_GC);
    { const int slot_ = (h >> 3) & 1;
      if ((slot_ ? ptag1 : ptag0) != h) {
          if (tid < 384) { const int vec = tid >> 6, j = tid & 63;
              const float* src = vec < 3 ? p.in[I_MU] + vec * 1024 : vec == 3 ? p.in[I_KA] : vec == 4 ? p.in[I_KK] : p.in[I_RK];
              ((LAS float*)(L + CK_PAR))[slot_ * 384 + tid] = src[h * 64 + j]; }
          if (slot_) ptag1 = h; else ptag0 = h;
          __syncthreads(); } }
    { const int t = tid >> 3, jg = tid & 7, tl = t & 7, m = mbase + t; const bool first = (c == 0 && t == 0);
      const LAS float* PR = (const LAS float*)(L + CK_PAR) + ((h >> 3) & 1) * 384 + 8 * jg;
      float xr[8], xk[8], xv[8], av[8], wv[8];
      { const u32x4 cr = icr, ck = ick, cv = icv; u32x4 pr = ipr, pk = ipk, pv = ipv; if (first) { pr = (u32x4){0u, 0u, 0u, 0u}; pk = pr; pv = pr; }
        const unsigned cw[3][4] = {{cr.x, cr.y, cr.z, cr.w}, {ck.x, ck.y, ck.z, ck.w}, {cv.x, cv.y, cv.z, cv.w}}, pw[3][4] = {{pr.x, pr.y, pr.z, pr.w}, {pk.x, pk.y, pk.z, pk.w}, {pv.x, pv.y, pv.z, pv.w}};
        float mr[8], mk[8], mv[8];
        { const f32x4 a0 = *(const LAS f32x4*)(PR), a1 = *(const LAS f32x4*)(PR + 4), b0 = *(const LAS f32x4*)(PR + 64), b1 = *(const LAS f32x4*)(PR + 68), d0 = *(const LAS f32x4*)(PR + 128), d1 = *(const LAS f32x4*)(PR + 132);
#pragma unroll
          for (int e = 0; e < 4; ++e) { mr[e] = a0[e]; mr[4 + e] = a1[e]; mk[e] = b0[e]; mk[4 + e] = b1[e]; mv[e] = d0[e]; mv[4 + e] = d1[e]; } }
#pragma unroll
        for (int e = 0; e < 8; ++e) { const int wi = e >> 1; const bool hi = e & 1;
            const float c_r = hi ? bfhi(cw[0][wi]) : bflo(cw[0][wi]), c_k = hi ? bfhi(cw[1][wi]) : bflo(cw[1][wi]), c_v = hi ? bfhi(cw[2][wi]) : bflo(cw[2][wi]);
            const float p_r = hi ? bfhi(pw[0][wi]) : bflo(pw[0][wi]), p_k = hi ? bfhi(pw[1][wi]) : bflo(pw[1][wi]), p_v = hi ? bfhi(pw[2][wi]) : bflo(pw[2][wi]);
            xr[e] = c_r + (p_r - c_r) * mr[e]; xk[e] = c_k + (p_k - c_k) * mk[e]; xv[e] = c_v + (p_v - c_v) * mv[e]; }
        { const f32x4 a0 = ia0, a1 = ia1, w0 = iw0, w1 = iw1;
#pragma unroll
          for (int e = 0; e < 4; ++e) { av[e] = a0[e]; av[4 + e] = a1[e]; wv[e] = w0[e]; wv[4 + e] = w1[e]; } } }
      CKIN_LOAD(i, next_task);
      float kmod[8], kk[8]; float n2 = 0.f, cbp = 0.f;
      { float ka_[8], kk_[8], rk_[8];
        { const f32x4 a0 = *(const LAS f32x4*)(PR + 192), a1 = *(const LAS f32x4*)(PR + 196), b0 = *(const LAS f32x4*)(PR + 256), b1 = *(const LAS f32x4*)(PR + 260), d0 = *(const LAS f32x4*)(PR + 320), d1 = *(const LAS f32x4*)(PR + 324);
#pragma unroll
          for (int e = 0; e < 4; ++e) { ka_[e] = a0[e]; ka_[4 + e] = a1[e]; kk_[e] = b0[e]; kk_[4 + e] = b1[e]; rk_[e] = d0[e]; rk_[4 + e] = d1[e]; } }
#pragma unroll
        for (int e = 0; e < 8; ++e) { kmod[e] = xk[e] * (1.0f + (av[e] - 1.0f) * ka_[e]); kk[e] = xk[e] * kk_[e]; n2 += kk[e] * kk[e]; cbp += xr[e] * kmod[e] * rk_[e]; } }
      const float inrm = 1.0f / fmaxf(sqrtf(red8(n2)), 1e-12f); const float cb = red8(cbp);
      if (jg == 0) CB[(size_t)m * 16 + h] = cb;
      { u32x4 o; o.x = pk2(xv[0], xv[1]); o.y = pk2(xv[2], xv[3]); o.z = pk2(xv[4], xv[5]); o.w = pk2(xv[6], xv[7]); *(u32x4*)(VVB + ((size_t)s * TP + 64 * c + t) * 64 + 8 * jg) = o; }
      float lw[8], lx[8];
#pragma unroll
      for (int e = 0; e < 8; ++e) { lw[e] = __log2f(wv[e]); lx[e] = lw[e]; }
#pragma unroll
      for (int e = 0; e < 8; ++e) lx[e] += __builtin_bit_cast(float, __builtin_amdgcn_update_dpp(0, __builtin_bit_cast(int, lx[e]), 0x118, 0xF, 0xF, true));
      { const int src2 = (jg + 8 * ((tl & 4) | 1)) << 2; const bool add2 = (tl & 2) != 0;
#pragma unroll
        for (int e = 0; e < 8; ++e) { const float y = __builtin_bit_cast(float, __builtin_amdgcn_ds_bpermute(src2, __builtin_bit_cast(int, lx[e]))); lx[e] += add2 ? y : 0.f; } }
      { const int src3 = (jg + 24) << 2; const bool add3 = (tl & 4) != 0;
#pragma unroll
        for (int e = 0; e < 8; ++e) { const float y = __builtin_bit_cast(float, __builtin_amdgcn_ds_bpermute(src3, __builtin_bit_cast(int, lx[e]))); lx[e] += add3 ? y : 0.f; } }
      LAS float* SEG = (LAS float*)(L + CK_GC + 256);
      if (tl == 7) { *(LAS f32x4*)(SEG + wave * 64 + 8 * jg) = (f32x4){lx[0], lx[1], lx[2], lx[3]}; *(LAS f32x4*)(SEG + wave * 64 + 8 * jg + 4) = (f32x4){lx[4], lx[5], lx[6], lx[7]}; }
      __syncthreads();
#pragma unroll
      for (int q = 0; q < 7; ++q) if (q < wave) { const f32x4 s0 = *(const LAS f32x4*)(SEG + q * 64 + 8 * jg), s1 = *(const LAS f32x4*)(SEG + q * 64 + 8 * jg + 4);
#pragma unroll
          for (int e = 0; e < 4; ++e) { lx[e] += s0[e]; lx[4 + e] += s1[e]; } }
      float ka[8], bt[8], kt[8], rt[8];
#pragma unroll
      for (int e = 0; e < 8; ++e) { const float lt = lx[e], lp = lt - lw[e];
          const float gt = __builtin_amdgcn_exp2f(lt), gp = __builtin_amdgcn_exp2f(lp), ig = __builtin_amdgcn_exp2f(-lt); const float kap = kk[e] * inrm;
          ka[e] = kap * gp; bt[e] = kap * av[e] * ig; kt[e] = kmod[e] * ig; rt[e] = xr[e] * gt; if (t == 63) GC[8 * jg + e] = gt; }
      { const int roff = t * 128 + ((jg ^ (t & 7)) << 4);
        u32x4 o; o.x = pk2(ka[0], ka[1]); o.y = pk2(ka[2], ka[3]); o.z = pk2(ka[4], ka[5]); o.w = pk2(ka[6], ka[7]); *(LAS u32x4*)(SLOT(0) + roff) = o;
        o.x = pk2(bt[0], bt[1]); o.y = pk2(bt[2], bt[3]); o.z = pk2(bt[4], bt[5]); o.w = pk2(bt[6], bt[7]); *(LAS u32x4*)(SLOT(1) + roff) = o;
        o.x = pk2(kt[0], kt[1]); o.y = pk2(kt[2], kt[3]); o.z = pk2(kt[4], kt[5]); o.w = pk2(kt[6], kt[7]); *(LAS u32x4*)(SLOT(2) + roff) = o;
        o.x = pk2(rt[0], rt[1]); o.y = pk2(rt[2], rt[3]); o.z = pk2(rt[4], rt[5]); o.w = pk2(rt[6], rt[7]); *(LAS u32x4*)(SLOT(3) + roff) = o;
        o.x = pk2(xv[0], xv[1]); o.y = pk2(xv[2], xv[3]); o.z = pk2(xv[4], xv[5]); o.w = pk2(xv[6], xv[7]); *(LAS u32x4*)(SLOT(15) + roff) = o; } }
    __syncthreads();
    f32x16 rtile = ck_zero();
    f32x16 aY = ck_zero(), aN = ck_zero();
    if (grp == 0) {
        { f32x16 a = ck_mm(SLOT(2), SLOT(0), mt, nt, ql, half, ck_zero());
#pragma unroll
          for (int r = 0; r < 16; ++r) { const int m = 32 * mt + ck_crow(r, half), n = 32 * nt + ql; a[r] = m < n ? a[r] : 0.f; }
          ck_store_t(SLOT(11), a, mt, nt, ql, half); }
        { f32x16 a = ck_mm(SLOT(2), SLOT(3), mt, nt, ql, half, ck_zero());
#pragma unroll
          for (int r = 0; r < 16; ++r) { const int m = 32 * mt + ck_crow(r, half), n = 32 * nt + ql; a[r] = m <= n ? a[r] : 0.f; }
          ck_store_t(SLOT(13), a, mt, nt, ql, half); }
        ck_tr(SLOT(0), SLOT(4), mt, nt, ql, half); ck_tr(SLOT(1), SLOT(5), mt, nt, ql, half); }
    else {
        { f32x16 a = ck_mm(SLOT(1), SLOT(0), mt, nt, ql, half, ck_zero());
#pragma unroll
          for (int r = 0; r < 16; ++r) { const int m = 32 * mt + ck_crow(r, half), n = 32 * nt + ql; a[r] = m < n ? -a[r] : 0.f; rtile[r] = a[r] + (m == n ? 1.0f : 0.f); }
          ck_store_t(SLOT(8), a, mt, nt, ql, half); ck_store_n(SLOT(9), a, mt, nt, ql, half); ck_store_t(SLOT(10), rtile, mt, nt, ql, half); }
        { f32x16 a = ck_mm(SLOT(1), SLOT(3), mt, nt, ql, half, ck_zero());
#pragma unroll
          for (int r = 0; r < 16; ++r) { const int m = 32 * mt + ck_crow(r, half), n = 32 * nt + ql; a[r] = m <= n ? a[r] : 0.f; }
          ck_store_t(SLOT(12), a, mt, nt, ql, half); }
        ck_tr(SLOT(2), SLOT(6), mt, nt, ql, half); ck_tr(SLOT(15), SLOT(7), mt, nt, ql, half); }
    __syncthreads();
#pragma unroll
    for (int lev = 1; lev <= 6; ++lev) {
        const int px = (lev & 1) ? 8 : 0, pxt = (lev & 1) ? 9 : 1, nx = (lev & 1) ? 0 : 8, nxt = (lev & 1) ? 1 : 9;
        const int rcur = (lev & 1) ? 2 : 10, rnxt = (lev & 1) ? 10 : 2;
        if (grp == 0) {
            if (lev <= 5) { const f32x16 a = ck_mm(SLOT(px), SLOT(pxt), mt, nt, ql, half, ck_zero());
                ck_store_t(SLOT(nxt), a, mt, nt, ql, half); ck_store_n(SLOT(nx), a, mt, nt, ql, half); }
            else aN = ck_mm(SLOT(6), SLOT(7), mt, nt, ql, half, ck_zero()); }
        else { if (lev == 1) { f32x16 a = ck_mm(SLOT(11), SLOT(7), mt, nt, ql, half, ck_zero()); ck_store_t(SLOT(14), a, mt, nt, ql, half);
                               aY = ck_mm(SLOT(7), SLOT(13), mt, nt, ql, half, ck_zero()); }
          if (lev >= 2) {
            const f32x16 a = ck_mm(SLOT(pxt), SLOT(rcur), mt, nt, ql, half, ck_zero());
#pragma unroll
            for (int r = 0; r < 16; ++r) rtile[r] += a[r];
            ck_store_t(SLOT(rnxt), rtile, mt, nt, ql, half); } }
        __syncthreads();
    }
    if (grp == 0) { f32x16 a = ck_mm(SLOT(2), SLOT(4), mt, nt, ql, half, ck_zero()); ck_store_t(SLOT(11), a, mt, nt, ql, half); }
    else { f32x16 a = ck_mm(SLOT(2), SLOT(14), mt, nt, ql, half, ck_zero()); ck_store_t(SLOT(15), a, mt, nt, ql, half); }
    __syncthreads();
    if (grp == 0) {
        { f32x16 a = ck_mm(SLOT(11), SLOT(5), mt, nt, ql, half, ck_zero());
          const int n = 32 * nt + ql; const float gc = GC[n];
#pragma unroll
          for (int r = 0; r < 16; ++r) { const int m = 32 * mt + ck_crow(r, half); a[r] = ((m == n ? 1.0f : 0.f) - a[r]) * gc; }
          ck_store_t(SLOT(8), a, mt, nt, ql, half); }
        { const f32x16 a2 = ck_mm(SLOT(5), SLOT(15), mt, nt, ql, half, ck_zero());
          unsigned char* N = outp + 16384 + (mt * 2 + nt) * 2048 + lane * 16; u32x4 w0, w1; unsigned pw[8];
#pragma unroll
          for (int g = 0; g < 4; ++g) { const int m0 = 32 * mt + 8 * g + 4 * half; float v[4];
#pragma unroll
              for (int e = 0; e < 4; ++e) v[e] = (aN[4 * g + e] - a2[4 * g + e]) * GC[m0 + e];
              pw[2 * g] = pk2(v[0], v[1]); pw[2 * g + 1] = pk2(v[2], v[3]); }
          w0 = (u32x4){pw[0], pw[1], pw[2], pw[3]}; w1 = (u32x4){pw[4], pw[5], pw[6], pw[7]}; *(u32x4*)N = w0; *(u32x4*)(N + 1024) = w1; } }
    else {
        { f32x16 a = ck_mm(SLOT(11), SLOT(12), mt, nt, ql, half, ck_zero());
          const int n = 32 * nt + ql;
#pragma unroll
          for (int g = 0; g < 4; ++g) { const int m0 = 32 * mt + 8 * g + 4 * half; const u32x2 rw = *(const LAS u32x2*)(SLOT(3) + n * 128 + (((m0 >> 3) ^ (n & 7)) << 4) + (m0 & 4) * 2);
              a[4 * g] = bflo(rw.x) - a[4 * g]; a[4 * g + 1] = bfhi(rw.x) - a[4 * g + 1]; a[4 * g + 2] = bflo(rw.y) - a[4 * g + 2]; a[4 * g + 3] = bfhi(rw.y) - a[4 * g + 3]; }
          ck_store_t(SLOT(9), a, mt, nt, ql, half); }
        { const f32x16 a2 = ck_mm(SLOT(15), SLOT(12), mt, nt, ql, half, ck_zero());
          unsigned char* Yl = outp + 24576 + (mt * 2 + nt) * 2048 + lane * 16; unsigned pw[8];
#pragma unroll
          for (int g = 0; g < 4; ++g) { pw[2 * g] = pk2(aY[4 * g] - a2[4 * g], aY[4 * g + 1] - a2[4 * g + 1]); pw[2 * g + 1] = pk2(aY[4 * g + 2] - a2[4 * g + 2], aY[4 * g + 3] - a2[4 * g + 3]); }
          *(u32x4*)Yl = (u32x4){pw[0], pw[1], pw[2], pw[3]}; *(u32x4*)(Yl + 1024) = (u32x4){pw[4], pw[5], pw[6], pw[7]}; } }
    __syncthreads();
    { const int row = tid >> 3, ch = tid & 7; const int off = row * 128 + ((ch ^ (row & 7)) << 4);
      *(u32x4*)(outp + tid * 16) = *(const LAS u32x4*)(SLOT(8) + off); *(u32x4*)(outp + 8192 + tid * 16) = *(const LAS u32x4*)(SLOT(9) + off); }
#undef SLOT
}
__device__ __forceinline__ void chunk_chain(const P& p, Frame& F, int s) {
    const int b = s >> 4, h = s & 15;
    bf16* YRAW = (bf16*)(p.ws + WS_YRAW);
    int tid = threadIdx.x; asm volatile("" : "+v"(tid));
    const int lane = tid & 63, wave = __builtin_amdgcn_readfirstlane(tid >> 6), ql = lane & 31, half = lane >> 5, grp = wave >> 2, mt = (wave >> 1) & 1, nt = wave & 1;
    LAS unsigned char* L = F.lds;
    __syncthreads();
    for (int i = tid; i < 2048; i += NTHR) ((LAS unsigned*)L)[i] = 0u;
    f32x16 sacc = ck_zero();
    const int n = 32 * nt + ql;
    const int noff = (grp == 0 ? 16384 : 24576) + (mt * 2 + nt) * 2048 + lane * 16;
    const unsigned char* base = p.ws + WS_CHK + (size_t)(s * 32) * CK_TASK_BYTES;
    u32x4 pmR[4], pqR[4], n0R[4], n1R[4];
#define CH_LOAD(slot, cc) do { const unsigned char* src_ = base + (size_t)(cc) * CK_TASK_BYTES; pmR[slot] = *(const u32x4*)(src_ + tid * 16); pqR[slot] = *(const u32x4*)(src_ + 8192 + tid * 16); \
        n0R[slot] = *(const u32x4*)(src_ + noff); n1R[slot] = *(const u32x4*)(src_ + noff + 1024); } while (0)
#pragma unroll
    for (int u = 0; u < 4; ++u) CH_LOAD(u, u);
    const int ioff = (tid >> 3) * 128 + (((tid & 7) ^ ((tid >> 3) & 7)) << 4);
    *(LAS u32x4*)(L + 2 * CK_SLOT + ioff) = pmR[0]; *(LAS u32x4*)(L + 4 * CK_SLOT + ioff) = pqR[0];
    __syncthreads();
    for (int c4 = 0; c4 < 32; c4 += 4) {
#pragma unroll
      for (int u = 0; u < 4; ++u) { const int c = c4 + u, cur = u & 1;
        f32x4 ad[4];
        { const u32x4 w0 = n0R[u], w1 = n1R[u];
          ad[0] = (f32x4){bflo(w0.x), bfhi(w0.x), bflo(w0.y), bfhi(w0.y)}; ad[1] = (f32x4){bflo(w0.z), bfhi(w0.z), bflo(w0.w), bfhi(w0.w)};
          ad[2] = (f32x4){bflo(w1.x), bfhi(w1.x), bflo(w1.y), bfhi(w1.y)}; ad[3] = (f32x4){bflo(w1.z), bfhi(w1.z), bflo(w1.w), bfhi(w1.w)}; }
        if (c + 4 < 32) CH_LOAD(u, c + 4);
        if (grp == 0) {
            sacc = ck_mm(L + (2 + cur) * CK_SLOT, L + cur * CK_SLOT, mt, nt, ql, half, ck_zero());
#pragma unroll
            for (int g = 0; g < 4; ++g)
#pragma unroll
                for (int e = 0; e < 4; ++e) sacc[4 * g + e] += ad[g][e];
            ck_store_t(L + (cur ^ 1) * CK_SLOT, sacc, mt, nt, ql, half);
        } else {
            const f32x16 a = ck_mm(L + cur * CK_SLOT, L + (4 + cur) * CK_SLOT, mt, nt, ql, half, ck_zero());
            bf16* yrow = YRAW + (size_t)(b * TP + 64 * c + n) * 1024 + h * 64;
#pragma unroll
            for (int g = 0; g < 4; ++g) { u32x2 w; w.x = pk2(a[4 * g] + ad[g][0], a[4 * g + 1] + ad[g][1]); w.y = pk2(a[4 * g + 2] + ad[g][2], a[4 * g + 3] + ad[g][3]);
                *(u32x2*)(yrow + 32 * mt + 8 * g + 4 * half) = w; } }
        if (c + 1 < 32) { *(LAS u32x4*)(L + (2 + (cur ^ 1)) * CK_SLOT + ioff) = pmR[(u + 1) & 3]; *(LAS u32x4*)(L + (4 + (cur ^ 1)) * CK_SLOT + ioff) = pqR[(u + 1) & 3]; }
        __syncthreads();
      }
    }
#undef CH_LOAD
    if (grp == 0) { float* So = p.out + O_RP + (size_t)s * 4096;
#pragma unroll
        for (int g = 0; g < 4; ++g) *(f32x4*)(So + n * 64 + 32 * mt + 8 * g + 4 * half) = (f32x4){sacc[4 * g], sacc[4 * g + 1], sacc[4 * g + 2], sacc[4 * g + 3]}; }
}
constexpr int CS_A = 160 * 128, CS_BUF = CS_A + 256 * 128;
__device__ __forceinline__ void cmp1_fused(const P& p, Frame& F) {
    const bf16* KVN = (const bf16*)(p.ws + WS_KVN); bf16* HID = (bf16*)(p.ws + WS_HID); const float* pe = p.in[I_PE]; const float* ckv = p.in[I_CKV]; const int* pt = (const int*)p.in[I_PT];
    int tid = threadIdx.x; asm volatile("" : "+v"(tid));
    const int lane = tid & 63, wave = __builtin_amdgcn_readfirstlane(tid >> 6), ql = lane & 31, half = lane >> 5, l16 = tid & 15, r32 = tid >> 4, p8 = tid & 7, r64 = tid >> 3;
    const bool pth = lane < 8; const int pr = wave, pp = lane & 7;
    LAS unsigned char* L = F.lds;
    __syncthreads();
    for (int unit = F.bid; unit < 256; unit += F.G) {
        const int kv = unit >> 7, blk = unit & 127;
        unsigned aoff[4];
#pragma unroll
        for (int j = 0; j < 4; ++j) { const int Rs = blk * 128 + r32 + 32 * j, b = Rs >> 9, n = (Rs >> 1) & 255, g = Rs & 1; const int page = pt[b * NPAGES + (n >> 2)];
            aoff[j] = (unsigned)(((page * PAGE + (n & 3) * 32) * 4 + kv) * 256 + g * 128 + 4 * l16); }
        unsigned poff = 0;
        if (pth) { const int R = blk * 8 + pr, b = R >> 7, n = (R >> 1) & 63, g = R & 1; poff = (unsigned)((b * TP + n * 32) * 1024 + kv * 256 + g * 128 + 8 * pp); }
        const bf16* W = (const bf16*)(p.ws + WS_CW1) + (size_t)kv * 256 * 4096 + (size_t)r64 * 4096 + 8 * p8;
        f32x16 acc[5];
#pragma unroll
        for (int mt = 0; mt < 5; ++mt) acc[mt] = ck_zero();
        for (int i = tid; i < 24 * 32; i += NTHR) { ((LAS unsigned*)(L + 136 * 128))[i] = 0u; ((LAS unsigned*)(L + CS_BUF + 136 * 128))[i] = 0u; }
        f32x4 ga[2][4], gp[2]; u32x4 gb[2][4], gq[2]; f32x4 gq0[2], gq1[2];
#define C1_LOAD(set, s_) do { const int pos_ = (s_) >> 1, dh_ = (s_) & 1; const unsigned ko_ = (unsigned)(pos_ * 1024 + dh_ * 64); \
            _Pragma("unroll") for (int j_ = 0; j_ < 4; ++j_) ga[set][j_] = *(const f32x4*)(ckv + (aoff[j_] + ko_)); \
            gp[set] = *(const f32x4*)(pe + (pos_ * 2 + kv) * 128 + dh_ * 64 + 4 * l16); \
            _Pragma("unroll") for (int j_ = 0; j_ < 4; ++j_) gb[set][j_] = *(const u32x4*)(W + (size_t)(64 * j_) * 4096 + (s_) * 64); \
            if (pth) { gq[set] = *(const u32x4*)(KVN + (poff + ko_)); const float* pq_ = pe + (pos_ * 2 + kv) * 128 + dh_ * 64 + 8 * pp; gq0[set] = *(const f32x4*)pq_; gq1[set] = *(const f32x4*)(pq_ + 4); } } while (0)
#define C1_PUT(set, buf_) do { LAS unsigned char* A_ = L + (buf_) * CS_BUF; LAS unsigned char* B_ = A_ + CS_A; \
            _Pragma("unroll") for (int j_ = 0; j_ < 4; ++j_) { const int rr_ = r32 + 32 * j_; const f32x4 v_ = ga[set][j_] + gp[set]; u32x2 w_; w_.x = pk2(v_.x, v_.y); w_.y = pk2(v_.z, v_.w); \
                *(LAS u32x2*)(A_ + rr_ * 128 + (((l16 >> 1) ^ (rr_ & 7)) << 4) + (l16 & 1) * 8) = w_; } \
            _Pragma("unroll") for (int j_ = 0; j_ < 4; ++j_) { const int nb_ = r64 + 64 * j_; *(LAS u32x4*)(B_ + nb_ * 128 + ((p8 ^ (nb_ & 7)) << 4)) = gb[set][j_]; } \
            if (pth) { const u32x4 q_ = gq[set]; const int rr_ = 128 + pr; \
                const f32x4 a_ = (f32x4){bflo(q_.x), bfhi(q_.x), bflo(q_.y), bfhi(q_.y)} + gq0[set], b_ = (f32x4){bflo(q_.z), bfhi(q_.z), bflo(q_.w), bfhi(q_.w)} + gq1[set]; \
                u32x4 o_; o_.x = pk2(a_.x, a_.y); o_.y = pk2(a_.z, a_.w); o_.z = pk2(b_.x, b_.y); o_.w = pk2(b_.z, b_.w); *(LAS u32x4*)(A_ + rr_ * 128 + ((pp ^ (rr_ & 7)) << 4)) = o_; } } while (0)
        C1_LOAD(0, 0); C1_LOAD(1, 1);
        __syncthreads();
        C1_PUT(0, 0); C1_LOAD(0, 2);
        __syncthreads();
#pragma nounroll
        for (int s2 = 0; s2 < 64; s2 += 2) {
#pragma unroll
            for (int u = 0; u < 2; ++u) { const int s = s2 + u;
                const LAS unsigned char* A_ = L + u * CS_BUF; const LAS unsigned char* B_ = A_ + CS_A; const int sw = ql & 7;
#pragma unroll
                for (int ks = 0; ks < 4; ++ks) { const int off = ((2 * ks + half) ^ sw) << 4; const bf16x8 bfr = *(const LAS bf16x8*)(B_ + (32 * wave + ql) * 128 + off);
#pragma unroll
                    for (int mt = 0; mt < 5; ++mt) { const bf16x8 afr = *(const LAS bf16x8*)(A_ + (32 * mt + ql) * 128 + off); acc[mt] = MFMA32(bfr, afr, acc[mt]); } }
                if (s + 1 < 64) C1_PUT(u ^ 1, u ^ 1);
                if (s + 3 < 64) C1_LOAD(u ^ 1, s + 3);
                __syncthreads();
            }
        }
#undef C1_LOAD
#undef C1_PUT
#pragma unroll
        for (int mt = 0; mt < 5; ++mt) { const int rl = 32 * mt + ql; if (rl < 136) { const size_t row = (size_t)kv * CMPROWS + (rl < 128 ? 1024 + blk * 128 + rl : blk * 8 + (rl - 128));
#pragma unroll
                for (int g = 0; g < 4; ++g) { u32x2 w; w.x = pk2(gelu_tanh(acc[mt][4 * g]), gelu_tanh(acc[mt][4 * g + 1])); w.y = pk2(gelu_tanh(acc[mt][4 * g + 2]), gelu_tanh(acc[mt][4 * g + 3]));
                    *(u32x2*)(HID + row * 256 + 32 * wave + 8 * g + 4 * half) = w; } } }
    }
}
#define PG8_ALIGN true
#define PG8_SP2 true
template <int LO, int HI> __global__ void __launch_bounds__(NTHR, 2) mega(P p) {
    extern __shared__ __attribute__((aligned(16))) unsigned char lds_[];
    Frame F; F.lds = (LAS unsigned char*)lds_; F.tid = threadIdx.x; F.lane = F.tid & 63; F.wave = __builtin_amdgcn_readfirstlane(F.tid >> 6); F.G = gridDim.x; F.bid = blockIdx.x;
    volatile LAS unsigned* MISC = (volatile LAS unsigned*)(F.lds + MISC_OFF);
    if (F.tid < 32) MISC[F.tid] = 0u;
    __syncthreads();
    unsigned char* ws = p.ws;
    constexpr bool fused = (HI - LO) > 1;
    XcdBarrier bar; bar.bar = (unsigned*)(ws + WS_CTL) + CW_BAR; bar.x = 0; bar.st = MISC + 8;
    if (fused) bar = xcd_barrier_post((unsigned*)(ws + WS_CTL) + CW_BAR, MISC + 8);
#define IN(k) (LO <= (k) && (k) < HI)
#define SEAM(k) do { if (IN(k) && IN((k) + 1)) xcd_barrier(bar); { int t_ = threadIdx.x; asm volatile("" : "+v"(t_)); F.tid = t_; F.lane = t_ & 63; F.wave = __builtin_amdgcn_readfirstlane(t_ >> 6); } } while (0)
    bf16* H = (bf16*)(ws + WS_H); bf16* ACT = (bf16*)(ws + WS_ACT); bf16* FB = (bf16*)(ws + WS_F); bf16* X1 = (bf16*)(ws + WS_X1);

    if (IN(0)) { p0_prologue(p, F); }
    SEAM(0);
    if (IN(1)) {
        pg8::Gemm g{H, (const bf16*)(ws + WS_W13A), MP, 2 * DFF, D}; pg8::StaticOrder S; S.init(MP, 2 * DFF, F.G, F.bid);
        EpiSwiglu E{ACT};
        pg8::gemm_phase<EpiSwiglu, pg8::StaticOrder, PG8_ALIGN, PG8_SP2>(F.lds + RING_OFF, g, S, E);
        skinny_gemm<32, 2, 2>(F, H + (size_t)MP * D, D, (const bf16*)(ws + WS_W13A), DFF / 32, SkSwiglu{ACT});
    }
    SEAM(1);
    if (IN(2)) {
        pg8::Gemm g{ACT, (const bf16*)(ws + WS_W2A), MP, D, DFF}; pg8::StaticOrder S; S.init(MP, D, F.G, F.bid);
        EpiStore E{FB, D};
        pg8::gemm_phase<EpiStore, pg8::StaticOrder, PG8_ALIGN, PG8_SP2>(F.lds + RING_OFF, g, S, E);
        skinny_gemm2d<8>(F, ACT + (size_t)MP * DFF, DFF, (const bf16*)(ws + WS_W2A), SkStore{FB, D});
    }
    SEAM(2);
    if (IN(3)) { thin_phase<false, true>(F, FB, p.in[I_XP], p.in[I_XS], p.in[I_F1POST], 0.5f, X1, p.in[I_MIXPRE], H); }
    SEAM(3);
    if (IN(4)) {
        pg8::Gemm g{H, (const bf16*)(ws + WS_WINT), MP, NPADW, D}; pg8::StaticOrder S; S.init(MP, NPADW, F.G, F.bid);
        EpiWin E{(bf16*)(ws + WS_PRW), (bf16*)(ws + WS_Q), (bf16*)(ws + WS_KVN), (bf16*)(ws + WS_WINN), (bf16*)(ws + WS_GRW), (bf16*)(ws + WS_GNSA), (float*)(ws + WS_NG), p.out};
        pg8::gemm_phase<EpiWin, pg8::StaticOrder, PG8_ALIGN, PG8_SP2>(F.lds + RING_OFF, g, S, E);
        skinny_gemm<40, 1, 3>(F, H + (size_t)MP * D, D, (const bf16*)(ws + WS_WINT), NPADW / 40, SkWin{E.PRW, E.Q, E.KVN, E.WINN, E.GRW, E.GNSA, E.NG, E.out});
    }
    SEAM(4);
    if (IN(5)) { lora_prep(p, F); }
    SEAM(5);
    if (IN(6)) {
#pragma nounroll
        for (int half_ = 0; half_ < 2; ++half_) {
            if ((half_ ^ (F.bid & 1)) == 0) {
                { int kl = 256; asm volatile("" : "+s"(kl));
                  pg8::Gemm g{(const bf16*)(ws + WS_ALORA), (const bf16*)(ws + WS_WLORA), MP, 3072, kl}; pg8::StaticOrder S; S.init(MP, 3072, F.G, F.bid);
                  EpiLora E{(float*)(ws + WS_DEC), (float*)(ws + WS_AA), (float*)(ws + WS_GG), p.in[I_W0], p.in[I_A0]};
                  pg8::gemm_phase<EpiLora, pg8::StaticOrder, PG8_ALIGN, PG8_SP2>(F.lds + RING_OFF, g, S, E);
                  skinny_gemm<12, 1, 2>(F, (const bf16*)(ws + WS_ALORA) + (size_t)MP * 256, kl, (const bf16*)(ws + WS_WLORA), 3072 / 12, SkLora{E.DEC, E.AA, E.GG, E.w0, E.a0}); }
                vt_build(p, F, F.bid, F.G);
            } else cmp1_fused(p, F);
            __syncthreads();
        }
    }
    SEAM(6);
    if (IN(7)) {
        { pg8::Gemm g{(const bf16*)(ws + WS_HID), (const bf16*)(ws + WS_CW2), 2 * CMPROWS, 512, 256}; DiagOrder S{F.G, F.bid};
          EpiCmp2 E{(float*)(ws + WS_KC)};
          pg8::gemm_phase<EpiCmp2, DiagOrder, PG8_ALIGN, PG8_SP2>(F.lds + RING_OFF, g, S, E); }
        __syncthreads();
        scan_prep(p, F);
        if (F.bid < NSEQ_P * 32) {
            CKIN_DECL(i); CKIN_LOAD(i, F.bid); int ptag0 = -1, ptag1 = -1;
            __syncthreads();
            for (int task = F.bid; task < NSEQ_P * 32; task += F.G) chunk_pre(p, F, task, task + F.G < NSEQ_P * 32 ? task + F.G : task, icr, ick, icv, ipr, ipk, ipv, ia0, ia1, iw0, iw1, ptag0, ptag1); }
    }
    SEAM(7);
    if (IN(8)) {
        if (F.G >= 256) { if (F.bid < NSEQ_P) chunk_chain(p, F, F.bid); else scan_sample(p, F, F.bid - NSEQ_P, F.G - NSEQ_P); }
        else { for (int s = F.bid; s < NSEQ_P; s += F.G) chunk_chain(p, F, s); scan_sample(p, F, F.bid, F.G); }
        __syncthreads();
        { unsigned* qctr = (unsigned*)(ws + WS_CTL) + 8192;
#pragma nounroll
          for (;;) {
              if (F.tid == 0) MISC[0] = __hip_atomic_fetch_add(qctr, 1u, __ATOMIC_RELAXED, __HIP_MEMORY_SCOPE_AGENT);
              __syncthreads();
              const int k = (int)MISC[0];
              __syncthreads();
              constexpr int NATT = 576, NCONV = (TR_NLATE + 15) / 16;
              if (k >= NATT + NCONV) break;
              int ia = -1, ic = -1;
              if (k < 2 * NATT) { if (k & 1) ic = k >> 1; else ia = k >> 1; } else ic = k - NATT;
              if (ic >= 0) { tr_late_batch(p, F, ic); continue; }
              const bool is_s = ia < 64; const int kk = is_s ? ia : ia - 64;
              attn_item(p, F, is_s, is_s ? kk >> 1 : (kk & 15) >> 1, kk & 1, is_s ? 0 : 31 - (kk >> 4)); } }
    }
    SEAM(8);
    if (IN(9)) { rwkv_post(p, F); }
    SEAM(9);
    if (IN(10)) {
        pg8::Gemm g{(const bf16*)(ws + WS_YRW), (const bf16*)(ws + WS_WBRW), MP, D, 1024}; pg8::StaticOrder S; S.init(MP, D, F.G, F.bid);
        EpiMerge<0> E{(const bf16*)(ws + WS_GRW), (bf16*)(ws + WS_MRG), (bf16*)(ws + WS_PARK)};
        pg8::gemm_phase<EpiMerge<0>, pg8::StaticOrder, PG8_ALIGN, PG8_SP2>(F.lds + RING_OFF, g, S, E);
        skinny_gemm2d<8>(F, (const bf16*)(ws + WS_YRW) + (size_t)MP * 1024, 1024, (const bf16*)(ws + WS_WBRW), SkMerge<0>{E.GATE, E.MRG});
        __syncthreads();
    }
    if (IN(10)) {
        pg8::Gemm g{(const bf16*)(ws + WS_YNSA), (const bf16*)(ws + WS_WBNSA), MP, D, 1024}; pg8::StaticOrder S; S.init(MP, D, F.G, F.bid);
        EpiMerge<1> E{(const bf16*)(ws + WS_GNSA), (bf16*)(ws + WS_MRG), (bf16*)(ws + WS_PARK)};
        pg8::gemm_phase<EpiMerge<1>, pg8::StaticOrder, PG8_ALIGN, PG8_SP2>(F.lds + RING_OFF, g, S, E);
        skinny_gemm2d<8>(F, (const bf16*)(ws + WS_YNSA) + (size_t)MP * 1024, 1024, (const bf16*)(ws + WS_WBNSA), SkMerge<1>{E.GATE, E.MRG});
    }
    SEAM(11);
    if (IN(12)) {
        pg8::Gemm g{(const bf16*)(ws + WS_MRG), (const bf16*)(ws + WS_WOUT), MP, D, D}; pg8::StaticOrder S; S.init(MP, D, F.G, F.bid);
        EpiStore E{FB, D};
        pg8::gemm_phase<EpiStore, pg8::StaticOrder, PG8_ALIGN, PG8_SP2>(F.lds + RING_OFF, g, S, E);
        skinny_gemm2d<8>(F, (const bf16*)(ws + WS_MRG) + (size_t)MP * D, D, (const bf16*)(ws + WS_WOUT), SkStore{FB, D});
    }
    SEAM(12);
    if (IN(13)) { thin_phase<true, true>(F, FB, X1, X1 + (size_t)MP * D, p.in[I_MIXPOST], 1.0f, X1, p.in[I_F2PRE], H); }
    SEAM(13);
    if (IN(14)) {
        pg8::Gemm g{H, (const bf16*)(ws + WS_W13B), MP, 2 * DFF, D}; pg8::StaticOrder S; S.init(MP, 2 * DFF, F.G, F.bid);
        EpiSwiglu E{ACT};
        pg8::gemm_phase<EpiSwiglu, pg8::StaticOrder, PG8_ALIGN, PG8_SP2>(F.lds + RING_OFF, g, S, E);
        skinny_gemm<32, 2, 2>(F, H + (size_t)MP * D, D, (const bf16*)(ws + WS_W13B), DFF / 32, SkSwiglu{ACT});
    }
    SEAM(14);
    if (IN(15)) {
        pg8::Gemm g{ACT, (const bf16*)(ws + WS_W2B), MP, D, DFF}; pg8::StaticOrder S; S.init(MP, D, F.G, F.bid);
        EpiStore E{FB, D};
        pg8::gemm_phase<EpiStore, pg8::StaticOrder, PG8_ALIGN, PG8_SP2>(F.lds + RING_OFF, g, S, E);
        skinny_gemm2d<8>(F, ACT + (size_t)MP * DFF, DFF, (const bf16*)(ws + WS_W2B), SkStore{FB, D});
    }
    SEAM(15);
    if (IN(16)) { thin_phase<true, false>(F, FB, X1, X1 + (size_t)MP * D, p.in[I_F2POST], 0.5f, p.out + O_Y, nullptr, nullptr); }
#undef IN
#undef SEAM
}
constexpr int NPHASES = 17;

template <int K> struct PhaseLaunch {
    static bool setup() { if (hipFuncSetAttribute((const void*)mega<K, K + 1>, hipFuncAttributeMaxDynamicSharedMemorySize, LDS_BYTES) != hipSuccess) return false; return PhaseLaunch<K + 1>::setup(); }
    static void run(const P& p, int grid, hipStream_t stream) { hipLaunchKernelGGL((mega<K, K + 1>), dim3(grid), dim3(NTHR), LDS_BYTES, stream, p); PhaseLaunch<K + 1>::run(p, grid, stream); }
};
template <> struct PhaseLaunch<NPHASES> { static bool setup() { return true; } static void run(const P&, int, hipStream_t) {} };
static bool setup_all() {
#if MK_FUSED
    return hipFuncSetAttribute((const void*)mega<0, NPHASES>, hipFuncAttributeMaxDynamicSharedMemorySize, LDS_BYTES) == hipSuccess;
#else
    return PhaseLaunch<0>::setup();
#endif
}
static void launch_all(const P& p, int grid, hipStream_t stream) {
#if !MK_FUSED
    PhaseLaunch<0>::run(p, grid, stream);
#endif
}
extern "C" void kernel_launch(void* const* d_in, const int* in_sizes, int n_in, void* d_out, int out_size, void* d_ws, size_t ws_size, hipStream_t stream) {
    static int grid = 0;
    if (grid == 0) {
        if (n_in != 38 || out_size != (int)O_END || ws_size < WS_END) { fprintf(stderr, "kernel_launch: unexpected shapes: n_in %d out %d ws %zu (need %zu)\n", n_in, out_size, ws_size, (size_t)WS_END); grid = -1; return; }
        int dev = 0, cus = 0, per_cu = 0;
        if (hipGetDevice(&dev) != hipSuccess || hipDeviceGetAttribute(&cus, hipDeviceAttributeMultiprocessorCount, dev) != hipSuccess) { grid = -1; return; }
        if (!setup_all()) { fprintf(stderr, "kernel_launch: hipFuncSetAttribute failed\n"); grid = -1; return; }
        grid = cus;
    }
    if (grid < 0) return;
    (void)hipMemsetAsync((char*)d_ws + WS_CTL, 0, CTL_BYTES, stream);
    P p{};
    for (int i = 0; i < 38; ++i) p.in[i] = (const float*)d_in[i];
    p.out = (float*)d_out; p.ws = (unsigned char*)d_ws;
#if MK_FUSED
    hipLaunchKernelGGL((mega<0, NPHASES>), dim3(grid), dim3(NTHR), LDS_BYTES, stream, p);
#else
    launch_all(p, grid, stream);
#endif
}
```

```cpp
#include <hip/hip_runtime.h>
#include <cstdio>
#include <cstdint>
#include <cmath>
#define MK_FUSED 1
namespace pg8 {
#define PG8_LAS __attribute__((address_space(3)))
typedef unsigned short bf16_t;
typedef short bf16x8 __attribute__((ext_vector_type(8)));
typedef float f32x4 __attribute__((ext_vector_type(4)));
typedef unsigned u32x4 __attribute__((ext_vector_type(4)));
constexpr int BM = 256, BK = 64, HALF = 128, HTB = HALF * BK * 2  , STAGE_BYTES = 8 * HTB, NXCD = 8, WGM = 8;

__host__ __device__ __forceinline__ int lds_byte(int r, int c) { const int st = (r >> 4) * 2 + (c >> 5), rr = r & 15, cc = c & 31, ob = rr * 64 + cc * 2; return st * 1024 + (ob ^ (((ob >> 9) & 1) << 5)); }
__host__ __device__ __forceinline__ void stage_rc(int b, int& R, int& C) { const int st = b / 1024, sb = b % 1024, swz = sb ^ (((sb >> 9) & 1) << 5); R = (st >> 1) * 16 + swz / 64; C = (st & 1) * 32 + (swz % 64) / 2; }
__host__ __device__ __forceinline__ int perm32(int rho) { const int n = rho >> 4, i = rho & 15; return 8 * (i >> 2) + 4 * n + (i & 3); }

struct Unit { int pm, pn; };
struct Gemm { const bf16_t* A; const bf16_t* Bt; int M, N, K; };

struct StaticOrder {
    int nM, nN, nwg, G, c;
    __host__ __device__ void init(int M, int N, int G_, int c_) { nM = M / BM; nN = N / BM; nwg = nM * nN; G = G_; c = c_; }
    __host__ __device__ bool next(int i, Unit& u) const {
        const long L = (long)i * G + c; if (L >= nwg) return false;
        int wgid = (int)L; { const int q = nwg / NXCD, r = nwg % NXCD, xcd = wgid % NXCD, off = wgid / NXCD; wgid = (xcd < r ? xcd * (q + 1) : r * (q + 1) + (xcd - r) * q) + off; }
        const int nig = WGM * nN, gid = wgid / nig, fm = gid * WGM, gsz = (nM - fm) < WGM ? (nM - fm) : WGM;
        u.pm = fm + ((wgid % nig) % gsz); u.pn = (wgid % nig) / gsz; return true;
    }
    __device__ __forceinline__ void a_ready(const Unit&) const {}
    __device__ __forceinline__ void done(const Unit&) const {}
};

__device__ __forceinline__ unsigned cvt_pk_bf16(float lo, float hi) { unsigned r; asm volatile("v_cvt_pk_bf16_f32 %0, %1, %2" : "=v"(r) : "v"(lo), "v"(hi)); return r; }
typedef float f32x2 __attribute__((ext_vector_type(2)));
template <class Epi, class Sched, bool ALIGN_EPI = false, bool SP2 = false>
__device__ __forceinline__ void gemm_phase(PG8_LAS unsigned char* lds, const Gemm g, const Sched& S, const Epi& E) {
    int tid_ = threadIdx.x; asm volatile("" : "+v"(tid_));
    const int tid = tid_, wid = __builtin_amdgcn_readfirstlane(tid >> 6), lane = tid & 63, wr = wid >> 2, wc = wid & 3, fr = lane & 15, fq = lane >> 4;
    const int K = g.K, nt = K / BK;
    unsigned voffA[2], voffB[2];
#pragma unroll
    for (int i = 0; i < 2; ++i) { int R, C; stage_rc(tid * 16 + i * 8192, R, C); const int Rb = Epi::PERM ? ((R & ~31) + perm32(R & 31)) : R;
        voffA[i] = (unsigned)(R * K + C) * 2u; voffB[i] = (unsigned)(Rb * K + C) * 2u; }
    const size_t kstep = (size_t)(BK * 2);
    const size_t hstep = (size_t)HALF * K * 2;
    const size_t tstep = 2 * hstep;
    const unsigned ldsw = (unsigned)wid * 1024u;
    const int aoff = lds_byte(wr * 64 + fr, fq * 8), boff = lds_byte(wc * 32 + fr, fq * 8);
#define PG8_SA(b, h) (((b) * 2 + (h)) * HTB)
#define PG8_SB(b, h) ((4 + (b) * 2 + (h)) * HTB)
#define PG8_STAGE(bufoff, gbase, voff) do { _Pragma("unroll") for (int _i = 0; _i < 2; ++_i) \
        __builtin_amdgcn_global_load_lds((const unsigned*)((const char*)(gbase) + (voff)[_i]), (PG8_LAS unsigned*)(lds + (bufoff) + ldsw + _i * 8192), 16, 0, 0); } while (0)
#define PG8_LDA(dst, b, h) do { _Pragma("unroll") for (int m = 0; m < 4; ++m) _Pragma("unroll") for (int k = 0; k < 2; ++k) dst[m][k] = *(const PG8_LAS bf16x8*)(lds + PG8_SA(b, h) + aoff + m * 2048 + k * 1024); } while (0)
#define PG8_LDB(dst, b, h) do { _Pragma("unroll") for (int n = 0; n < 2; ++n) _Pragma("unroll") for (int k = 0; k < 2; ++k) dst[n][k] = *(const PG8_LAS bf16x8*)(lds + PG8_SB(b, h) + boff + n * 2048 + k * 1024); } while (0)
#define PG8_MMA(ai, bj, At, Bt) do { __builtin_amdgcn_s_setprio(1); _Pragma("unroll") for (int m = 0; m < 4; ++m) _Pragma("unroll") for (int n = 0; n < 2; ++n) _Pragma("unroll") for (int k = 0; k < 2; ++k) \
        acc[ai][bj][m][n] = __builtin_amdgcn_mfma_f32_16x16x32_bf16(Bt[n][k], At[m][k], acc[ai][bj][m][n], 0, 0, 0); __builtin_amdgcn_s_setprio(0); } while (0)
#define PG8_WAIT_V(n) asm volatile("s_waitcnt vmcnt(" #n ")" ::: "memory")
#define PG8_WAIT_L(n) asm volatile("s_waitcnt lgkmcnt(" #n ")" ::: "memory")
#define PG8_BAR __builtin_amdgcn_s_barrier()
#define PG8_SCHED __builtin_amdgcn_sched_barrier(0)
    Unit cur, nxt; int ui = 0;
    if (!S.next(0, cur)) return;
    f32x4 acc[2][2][4][2];
#pragma unroll
    for (int a = 0; a < 2; ++a)
#pragma unroll
        for (int b = 0; b < 2; ++b)
#pragma unroll
            for (int m = 0; m < 4; ++m)
#pragma unroll
                for (int n = 0; n < 2; ++n) acc[a][b][m][n] = (f32x4){0.f, 0.f, 0.f, 0.f};
    bf16x8 At[4][2], B0[2][2], B1[2][2];
    const char* cA = (const char*)g.A + (size_t)cur.pm * tstep; const char* cB = (const char*)g.Bt + (size_t)cur.pn * tstep;
    S.a_ready(cur);
    if constexpr (SP2) {
        PG8_STAGE(PG8_SB(0, 0), cB, voffB); PG8_STAGE(PG8_SB(0, 1), cB + hstep, voffB); PG8_STAGE(PG8_SA(0, 0), cA, voffA); PG8_STAGE(PG8_SA(0, 1), cA + hstep, voffA);
        if (wr == 1) PG8_BAR;
        PG8_WAIT_V(2); PG8_BAR;
        PG8_STAGE(PG8_SB(1, 0), cB + kstep, voffB); PG8_STAGE(PG8_SA(1, 0), cA + kstep, voffA); PG8_STAGE(PG8_SB(1, 1), cB + hstep + kstep, voffB);
        PG8_WAIT_V(6); PG8_BAR;
    } else {
        PG8_STAGE(PG8_SB(0, 0), cB, voffB); PG8_STAGE(PG8_SA(0, 0), cA, voffA); PG8_STAGE(PG8_SB(0, 1), cB + hstep, voffB); PG8_STAGE(PG8_SA(0, 1), cA + hstep, voffA);
        if (wr == 1) PG8_BAR;
        PG8_WAIT_V(4); PG8_BAR;
        PG8_STAGE(PG8_SB(1, 0), cB + kstep, voffB); PG8_STAGE(PG8_SA(1, 0), cA + kstep, voffA); PG8_STAGE(PG8_SB(1, 1), cB + hstep + kstep, voffB);
        PG8_WAIT_V(6); PG8_BAR;
    }
    for (;;) {
        const bool has_next = S.next(ui + 1, nxt);
        const char* nA = has_next ? (const char*)g.A + (size_t)nxt.pm * tstep : cA; const char* nB = has_next ? (const char*)g.Bt + (size_t)nxt.pn * tstep : cB;
        for (int t = 0; t < nt; t += 2) {
            const bool last = (t == nt - 2);
            const char* a1 = cA + (size_t)(t + 1) * kstep;
            const char* a2 = last ? nA : cA + (size_t)(t + 2) * kstep; const char* b2 = last ? nB : cB + (size_t)(t + 2) * kstep;
            const char* a3 = a2 + kstep; const char* b3 = b2 + kstep;
            if (last && has_next) S.a_ready(nxt);
            if constexpr (SP2) {
            PG8_LDB(B0, 0, 0); PG8_LDB(B1, 0, 1); PG8_SCHED; PG8_LDA(At, 0, 0); PG8_STAGE(PG8_SA(1, 1), a1 + hstep, voffA);
            PG8_WAIT_V(8); PG8_WAIT_L(0); PG8_BAR; PG8_MMA(0, 0, At, B0); PG8_MMA(0, 1, At, B1); PG8_BAR; PG8_SCHED;
            PG8_LDA(At, 0, 1); PG8_STAGE(PG8_SB(0, 0), b2, voffB); PG8_STAGE(PG8_SB(0, 1), b2 + hstep, voffB); PG8_STAGE(PG8_SA(0, 0), a2, voffA);
            PG8_WAIT_V(8); PG8_WAIT_L(0); PG8_BAR; PG8_MMA(1, 0, At, B0); PG8_MMA(1, 1, At, B1); PG8_BAR; PG8_SCHED;
            PG8_LDB(B0, 1, 0); PG8_LDB(B1, 1, 1); PG8_SCHED; PG8_LDA(At, 1, 0); PG8_STAGE(PG8_SA(0, 1), a2 + hstep, voffA);
            PG8_WAIT_V(8); PG8_WAIT_L(0); PG8_BAR; PG8_MMA(0, 0, At, B0); PG8_MMA(0, 1, At, B1); PG8_BAR; PG8_SCHED;
            PG8_LDA(At, 1, 1); PG8_STAGE(PG8_SB(1, 0), b3, voffB); PG8_STAGE(PG8_SB(1, 1), b3 + hstep, voffB); PG8_STAGE(PG8_SA(1, 0), a3, voffA);
            PG8_WAIT_V(8); PG8_WAIT_L(0); PG8_BAR; PG8_MMA(1, 0, At, B0); PG8_MMA(1, 1, At, B1); PG8_BAR; PG8_SCHED;
            } else {
            PG8_LDB(B0, 0, 0); PG8_SCHED; PG8_LDA(At, 0, 0); PG8_STAGE(PG8_SA(1, 1), a1 + hstep, voffA);
            PG8_WAIT_L(8); PG8_BAR; PG8_WAIT_L(0); PG8_MMA(0, 0, At, B0); PG8_BAR; PG8_SCHED;
            PG8_LDB(B1, 0, 1); PG8_STAGE(PG8_SB(0, 0), b2, voffB);
            PG8_BAR; PG8_WAIT_L(0); PG8_MMA(0, 1, At, B1); PG8_BAR;
            PG8_LDA(At, 0, 1); PG8_STAGE(PG8_SA(0, 0), a2, voffA);
            PG8_BAR; PG8_WAIT_L(0); PG8_MMA(1, 0, At, B0); PG8_BAR; PG8_SCHED;
            PG8_STAGE(PG8_SB(0, 1), b2 + hstep, voffB);
            PG8_WAIT_V(6); PG8_BAR; PG8_MMA(1, 1, At, B1); PG8_BAR;
            PG8_LDB(B0, 1, 0); PG8_SCHED; PG8_LDA(At, 1, 0); PG8_STAGE(PG8_SA(0, 1), a2 + hstep, voffA);
            PG8_WAIT_L(8); PG8_BAR; PG8_WAIT_L(0); PG8_MMA(0, 0, At, B0); PG8_BAR; PG8_SCHED;
            PG8_LDB(B1, 1, 1); PG8_STAGE(PG8_SB(1, 0), b3, voffB);
            PG8_BAR; PG8_WAIT_L(0); PG8_MMA(0, 1, At, B1); PG8_BAR;
            PG8_LDA(At, 1, 1); PG8_STAGE(PG8_SA(1, 0), a3, voffA);
            PG8_BAR; PG8_WAIT_L(0); PG8_MMA(1, 0, At, B0); PG8_BAR; PG8_SCHED;
            PG8_STAGE(PG8_SB(1, 1), b3 + hstep, voffB);
            PG8_WAIT_V(6); PG8_BAR; PG8_MMA(1, 1, At, B1); PG8_BAR;
            }
        }
        if constexpr (ALIGN_EPI) { if (wr == 0) PG8_BAR; }
        if constexpr (!Epi::AFTER_DRAIN) { E(acc, cur, wr, wc, fr, fq); S.done(cur); }
        if (!has_next) break;
#pragma unroll
        for (int a = 0; a < 2; ++a)
#pragma unroll
            for (int b = 0; b < 2; ++b)
#pragma unroll
                for (int m = 0; m < 4; ++m)
#pragma unroll
                    for (int n = 0; n < 2; ++n) acc[a][b][m][n] = (f32x4){0.f, 0.f, 0.f, 0.f};
        cur = nxt; cA = nA; cB = nB; ++ui;
        if constexpr (ALIGN_EPI) { if (wr == 1) PG8_BAR; }
    }
    PG8_WAIT_V(0);
    if constexpr (!ALIGN_EPI) { if (wr == 0) PG8_BAR; }
    PG8_BAR;
    if constexpr (Epi::AFTER_DRAIN) { E.fused(acc, cur, wr, wc, fr, fq, lds, wid, lane); S.done(cur); }
#undef PG8_SA
#undef PG8_SB
#undef PG8_STAGE
#undef PG8_LDA
#undef PG8_LDB
#undef PG8_MMA
#undef PG8_WAIT_V
#undef PG8_WAIT_L
#undef PG8_BAR
#undef PG8_SCHED
}
}
#define LAS __attribute__((address_space(3)))
#define GAS __attribute__((address_space(1)))
typedef unsigned short bf16;
typedef float f32x2 __attribute__((ext_vector_type(2)));
typedef float f32x4 __attribute__((ext_vector_type(4)));
typedef float f32x16 __attribute__((ext_vector_type(16)));
typedef unsigned u32x2 __attribute__((ext_vector_type(2)));
typedef unsigned u32x4 __attribute__((ext_vector_type(4)));
typedef short bf16x8 __attribute__((ext_vector_type(8)));
typedef short s16x4 __attribute__((ext_vector_type(4)));
typedef __bf16 bfx2 __attribute__((ext_vector_type(2)));

constexpr int D = 2048, BP = 8, TP = 2048, BS = 32, TS = 4, PAST = 8192, PAGE = 128, NPAGES = PAST / PAGE;
constexpr int MP = BP * TP, MS = BS * TS, MT = MP + MS, MPAD = 16640;
constexpr int DFF = 5632, RWD = 1024, RWP = 3328, NH = 8, NG_ = 2, HD = 128, KVD = 256;
constexpr int NCOLS = 10008, NPADW = 10240;
constexpr int RWH = 16, RWN = 64;
constexpr float RMS_EPS = 1e-6f, RW_LN_EPS = 64e-5f;
constexpr int CMPROWS = 17408;
constexpr int NSEQ_P = BP * RWH, NSEQ_S = BS * RWH;
constexpr int NSTEPROWS = NSEQ_P * TP + NSEQ_S * TS;

constexpr size_t O_Y = 0, O_KV = (size_t)MT * D, O_WP = O_KV + (size_t)MT * 1024, O_WS = O_WP + (size_t)BP * 512 * 512,
                 O_RP = O_WS + (size_t)BS * 512 * 512, O_RS = O_RP + (size_t)BP * RWH * 4096, O_SP = O_RS + (size_t)BS * RWH * 4096,
                 O_SS = O_SP + (size_t)BP * RWP, O_END = O_SS + (size_t)BS * RWP;
static_assert(O_END == 63965184, "d_out size");

constexpr size_t al256(size_t x) { return (x + 255) & ~(size_t)255; }
constexpr size_t WS_CTL = 0, CTL_BYTES = 1u << 20;
constexpr size_t WS_W13A = CTL_BYTES;
constexpr size_t WS_W2A = WS_W13A + (size_t)2 * DFF * D * 2;
constexpr size_t WS_WINT = WS_W2A + (size_t)D * DFF * 2;
constexpr size_t WS_WLORA = WS_WINT + (size_t)NPADW * D * 2;
constexpr size_t WS_WBRW = WS_WLORA + (size_t)3072 * 256 * 2;
constexpr size_t WS_WBNSA = WS_WBRW + (size_t)D * 1024 * 2;
constexpr size_t WS_WOUT = WS_WBNSA + (size_t)D * 1024 * 2;
constexpr size_t WS_W13B = WS_WOUT + (size_t)D * D * 2;
constexpr size_t WS_W2B = WS_W13B + (size_t)2 * DFF * D * 2;
constexpr size_t WS_CW1 = WS_W2B + (size_t)D * DFF * 2;
constexpr size_t WS_CW2 = WS_CW1 + (size_t)2 * 256 * 4096 * 2;
constexpr size_t WS_BTAB = WS_CW2 + (size_t)2 * 256 * 256 * 2;
constexpr size_t WS_H = WS_BTAB + (size_t)8 * 1024 * 4;
constexpr size_t WS_ACT = WS_H + (size_t)MPAD * D * 2;
constexpr size_t WS_F = WS_ACT + (size_t)MPAD * DFF * 2;
constexpr size_t WS_X1 = WS_F + (size_t)MPAD * D * 2;
constexpr size_t WS_PRW = WS_X1 + (size_t)MPAD * D * 4;
constexpr size_t WS_Q = WS_PRW + (size_t)MPAD * RWP * 2;
constexpr size_t WS_KVN = WS_Q + (size_t)MPAD * 1024 * 2;
constexpr size_t WS_WINN = WS_KVN + (size_t)MPAD * 1024 * 2;
constexpr size_t WS_GRW = WS_WINN + (size_t)MPAD * 512 * 2;
constexpr size_t WS_GNSA = WS_GRW + (size_t)MPAD * D * 2;
constexpr size_t WS_NG = WS_GNSA + (size_t)MPAD * D * 2;
constexpr size_t WS_ALORA = WS_NG + (size_t)MPAD * 32 * 4;
constexpr size_t WS_DEC = WS_ALORA + (size_t)MPAD * 256 * 2;
constexpr size_t WS_AA = WS_DEC + (size_t)MPAD * 1024 * 4;
constexpr size_t WS_GG = WS_AA + (size_t)MPAD * 1024 * 4;
constexpr size_t WS_YRW = WS_GG + (size_t)MPAD * 1024 * 4;
constexpr size_t WS_YNSA = WS_YRW + (size_t)MPAD * 1024 * 2;
constexpr size_t WS_MRG = WS_YNSA + (size_t)MPAD * 1024 * 2;
constexpr size_t WS_ACMP = WS_MRG + (size_t)MPAD * D * 2;
constexpr size_t WS_HID = WS_ACMP + (size_t)2 * CMPROWS * 4096 * 2;
constexpr size_t WS_KC = WS_HID + (size_t)2 * CMPROWS * 256 * 2;
constexpr size_t WS_OPS = WS_KC + (size_t)2 * CMPROWS * 256 * 4;
constexpr size_t WS_WQ = WS_OPS + (size_t)NSTEPROWS * 256 * 2;
constexpr size_t WS_VV = WS_OPS + (size_t)NSTEPROWS * 320 * 4;
constexpr size_t WS_CB = WS_VV + (size_t)NSTEPROWS * 64 * 4;
constexpr size_t WS_VTS = WS_CB + (size_t)MPAD * 16 * 4;
constexpr size_t WS_VTW = WS_VTS + (size_t)512 * 128 * 64 * 2;
constexpr size_t WS_YRAW = WS_VTW + (size_t)512 * 128 * 64 * 2;
constexpr size_t WS_CHK = WS_YRAW + (size_t)MPAD * 1024 * 4;
constexpr size_t WS_PARK = WS_CHK + (size_t)NSEQ_P * 32 * 32768;
constexpr size_t WS_C12 = WS_CHK + (size_t)NSEQ_P * 32 * 49152;
static_assert((size_t)576 * 65536 <= (size_t)NSEQ_P * 32 * 16384, "parking area");
constexpr size_t WS_END = WS_C12 + (size_t)(NSTEPROWS + 64) * 2 * 4 + 256;
static_assert(WS_END % 256 == 0, "ws alignment");

constexpr int NWAVES = 8, NTHR = 512;
constexpr int LDS_BYTES = 147456;
constexpr int RING_OFF = 0, MISC_OFF = 147456 - 256;
constexpr int CW_BAR = 4096;
#define XB_TMO      128
#define XB_XCNT(j)  (256  + 64 * (j))
#define XB_XSUB(j)  (1280 + 64 * (j))
#define XB_XGEN(j)  (2304 + 64 * (j))
#define XB_TOP      3328
#define XB_TOPGEN   3392
#define XCD_BAR_WORDS 3456
#define XB_SPIN_CAP (1u << 18)

__device__ __forceinline__ unsigned xb_ld(unsigned* p)              { return __hip_atomic_load(p, __ATOMIC_RELAXED, __HIP_MEMORY_SCOPE_AGENT); }
__device__ __forceinline__ unsigned xb_add(unsigned* p, unsigned v) { return __hip_atomic_fetch_add(p, v, __ATOMIC_RELAXED, __HIP_MEMORY_SCOPE_AGENT); }
__device__ __forceinline__ unsigned xb_xcc_id() { return (unsigned)__builtin_amdgcn_s_getreg((3 << 11) | 20) & 0xFu; }
#define XB_SPIN(cond, bar) do { unsigned _sp = 0; while (cond) { __builtin_amdgcn_s_sleep(1); \
    if ((++_sp & 255u) == 0u) { if (xb_ld(&(bar)[XB_TMO])) break; if (_sp > XB_SPIN_CAP) { atomicAdd(&(bar)[XB_TMO], 1u); break; } } } } while (0)

struct XcdBarrier {
    unsigned* bar; unsigned x;
    volatile LAS unsigned* st;
};

__device__ __forceinline__ XcdBarrier xcd_barrier_post(unsigned* bar, volatile LAS unsigned* st) {
    XcdBarrier b; b.bar = bar; b.x = xb_xcc_id(); b.st = st;
    if (threadIdx.x == 0) (void)xb_add(&bar[XB_XCNT(b.x)], 1u);
    return b;
}
__device__ __forceinline__ void xcd_barrier_complete(unsigned* bar, unsigned x, unsigned& nloc, unsigned& nx) {
    const unsigned G = gridDim.x * gridDim.y * gridDim.z;
    unsigned sum, cnt, mine, sp = 0u;
    for (;;) {
        sum = 0u; cnt = 0u; mine = 0u;
#pragma unroll
        for (unsigned j = 0; j < 16; ++j) { const unsigned c = xb_ld(&bar[XB_XCNT(j)]); sum += c; cnt += (c > 0u) ? 1u : 0u; mine = (j == x) ? c : mine; }
        if (sum == G) break;
        __builtin_amdgcn_s_sleep(1);
        if ((++sp & 255u) == 0u) { if (xb_ld(&bar[XB_TMO])) break; if (sp > XB_SPIN_CAP) { atomicAdd(&bar[XB_TMO], 1u); break; } }
    }
    nloc = mine > 0u ? mine : 1u; nx = cnt > 0u ? cnt : 1u;
}

__device__ __forceinline__ void xcd_barrier(const XcdBarrier& b) {
    asm volatile("s_waitcnt vmcnt(0)" ::: "memory");
    __syncthreads();
    if (threadIdx.x == 0) {
        unsigned* bar = b.bar;
        __builtin_amdgcn_s_waitcnt(0);
        unsigned nloc = b.st[0], nx = b.st[1];
        if (nloc == 0u) { xcd_barrier_complete(bar, b.x, nloc, nx); b.st[0] = nloc; b.st[1] = nx; }
        const unsigned old = xb_add(&bar[XB_XSUB(b.x)], 1u);
        const unsigned gen = old / nloc;
        if (old + 1u == (gen + 1u) * nloc) {
            __builtin_amdgcn_fence(__ATOMIC_RELEASE, "agent");
            asm volatile("s_waitcnt vmcnt(0)" ::: "memory");
            const unsigned og = xb_add(&bar[XB_TOP], 1u);
            const unsigned tg = og / nx;
            if (og + 1u == (tg + 1u) * nx) xb_add(&bar[XB_TOPGEN], 1u);
            else XB_SPIN(xb_ld(&bar[XB_TOPGEN]) == tg, bar);
            __builtin_amdgcn_fence(__ATOMIC_ACQUIRE, "agent");
            xb_add(&bar[XB_XGEN(b.x)], 1u);
            asm volatile("s_waitcnt vmcnt(0)" ::: "memory");
        } else {
            XB_SPIN(xb_ld(&bar[XB_XGEN(b.x)]) == gen, bar);
            __builtin_amdgcn_fence(__ATOMIC_ACQUIRE, "agent");
            asm volatile("s_waitcnt vmcnt(0)" ::: "memory");
        }
    }
    __syncthreads();
}
#define LDS_WAIT() asm volatile("s_waitcnt lgkmcnt(0)" ::: "memory")
#define VM_WAIT() asm volatile("s_waitcnt vmcnt(0)" ::: "memory")
__device__ __forceinline__ unsigned pk2(float lo, float hi) { const bfx2 b = __builtin_convertvector((f32x2){lo, hi}, bfx2); return __builtin_bit_cast(unsigned, b); }
__device__ __forceinline__ float bflo(unsigned w) { return __uint_as_float(w << 16); }
__device__ __forceinline__ float bfhi(unsigned w) { return __uint_as_float(w & 0xffff0000u); }
__device__ __forceinline__ float bf2f(bf16 v) { return __uint_as_float((unsigned)v << 16); }
__device__ __forceinline__ float wave_sum(float v) {
    v += __builtin_bit_cast(float, __builtin_amdgcn_update_dpp(0, __builtin_bit_cast(int, v), 0xB1, 0xF, 0xF, true));
    v += __builtin_bit_cast(float, __builtin_amdgcn_update_dpp(0, __builtin_bit_cast(int, v), 0x4E, 0xF, 0xF, true));
    v += __builtin_bit_cast(float, __builtin_amdgcn_update_dpp(0, __builtin_bit_cast(int, v), 0x141, 0xF, 0xF, true));
    v += __builtin_bit_cast(float, __builtin_amdgcn_update_dpp(0, __builtin_bit_cast(int, v), 0x140, 0xF, 0xF, true));
    const int vi = __builtin_bit_cast(int, v);
    const float r0 = __builtin_bit_cast(float, __builtin_amdgcn_readlane(vi, 0)), r1 = __builtin_bit_cast(float, __builtin_amdgcn_readlane(vi, 16)),
                r2 = __builtin_bit_cast(float, __builtin_amdgcn_readlane(vi, 32)), r3 = __builtin_bit_cast(float, __builtin_amdgcn_readlane(vi, 48));
    return (r0 + r1) + (r2 + r3);
}
__device__ __forceinline__ float sigmoidf_(float x) { return __builtin_amdgcn_rcpf(1.0f + __builtin_amdgcn_exp2f(-1.4426950408889634f * x)); }

struct P {
    const float* in[38];
    float* out; unsigned char* ws;
    int ph_lo, ph_hi;
};
struct Frame {
    LAS unsigned char* lds;
    int tid, lane, wave, G, bid;
};
enum { I_XP = 0, I_XS, I_CKV, I_CWIN, I_SRW, I_SSH, I_PT, I_F1PRE, I_F1POST, I_F1W1, I_F1W3, I_F1W2, I_MIXPRE, I_MIXPOST, I_WIN,
       I_MU, I_W0, I_W2, I_A0, I_A2, I_G2, I_KK, I_KA, I_RK, I_LNW, I_LNB, I_PE, I_CW1, I_CW2, I_BRW, I_BNSA, I_WOUT,
       I_F2PRE, I_F2POST, I_F2W1, I_F2W3, I_F2W2, I_RELB };
__device__ __forceinline__ void tr_item(const float* W, int K, int Nsrc, int sc, int nv, bf16* WT, int dr, int k0, LAS float* scr, int lane) {
    const int n4 = 4 * (lane & 15), kr = lane >> 4;
    f32x4 v[16];
    const bool vec = ((sc & 3) == 0) && ((Nsrc & 3) == 0) && nv == 64;
#pragma unroll
    for (int i = 0; i < 16; ++i) { const float* src = W + (size_t)(k0 + kr + 4 * i) * Nsrc + sc + n4;
        if (vec) v[i] = __builtin_nontemporal_load((const f32x4*)src);
        else { v[i].x = n4 + 0 < nv ? src[0] : 0.f; v[i].y = n4 + 1 < nv ? src[1] : 0.f; v[i].z = n4 + 2 < nv ? src[2] : 0.f; v[i].w = n4 + 3 < nv ? src[3] : 0.f; } }
#pragma unroll
    for (int i = 0; i < 16; ++i) { LAS float* d = scr + (kr + 4 * i) * 65 + n4; d[0] = v[i].x; d[1] = v[i].y; d[2] = v[i].z; d[3] = v[i].w; }
    LDS_WAIT(); asm volatile("" ::: "memory");
    const int c = lane & 7;
#pragma unroll
    for (int j = 0; j < 8; ++j) { const int nn = (lane >> 3) + 8 * j; const LAS float* s = scr + (8 * c) * 65 + nn;
        u32x4 o; o.x = pk2(s[0 * 65], s[1 * 65]); o.y = pk2(s[2 * 65], s[3 * 65]); o.z = pk2(s[4 * 65], s[5 * 65]); o.w = pk2(s[6 * 65], s[7 * 65]);
        *(u32x4*)(WT + (size_t)(dr + nn) * K + k0 + 8 * c) = o; }
    LDS_WAIT(); asm volatile("" ::: "memory");
}
constexpr int TR_SCR = 64 * 65 * 4;
__device__ __forceinline__ void tr_plain(const float* W, int K, int N, bf16* WT, int item, LAS float* scr, int lane) {
    const int ncb = N / 64, kb = item / ncb, nb = item % ncb; tr_item(W, K, N, 64 * nb, 64, WT, 64 * nb, 64 * kb, scr, lane);
}
__device__ __forceinline__ void tr_up(const float* W, int which, bf16* WT, int item, LAS float* scr, int lane) {
    const int ncb = DFF / 64, kb = item / ncb, nb = item % ncb; const int dr = (nb >> 1) * 256 + which * 128 + (nb & 1) * 64;
    tr_item(W, D, DFF, 64 * nb, 64, WT, dr, 64 * kb, scr, lane);
}
__device__ __forceinline__ void tr_win(const float* W, bf16* WT, int item, LAS float* scr, int lane) {
    const int ncb = NPADW / 64, kb = item / ncb, nb = item % ncb; const int dr = 64 * nb; int sc, nv;
    if (dr < 5888) { sc = dr; nv = 64; } else if (dr < 9984) { sc = dr + 24; nv = 64; } else if (dr == 9984) { sc = 5888; nv = 24; } else { sc = 0; nv = 0; }
    tr_item(W, D, NCOLS, sc, nv, WT, dr, 64 * kb, scr, lane);
}
constexpr int TI_UP = (D / 64) * (DFF / 64), TI_DN = (DFF / 64) * (D / 64), TI_IN = (D / 64) * (NPADW / 64), TI_BR = (1024 / 64) * (D / 64), TI_OUT = (D / 64) * (D / 64), TI_C1 = (4096 / 64) * (256 / 64);
constexpr int TR_NITEMS = 4 * TI_UP + 2 * TI_DN + TI_IN + 2 * TI_BR + TI_OUT + 2 * TI_C1;
constexpr int TR_LATE0 = 2 * TI_UP + TI_DN + TI_IN, TR_NLATE = 2 * TI_BR + TI_OUT + 2 * TI_UP + TI_DN;
__device__ __forceinline__ void tr_dispatch(const P& p, int it, LAS float* scr, int lane) {
    unsigned char* ws = p.ws;
    constexpr int I_UP = TI_UP, I_DN = TI_DN, I_IN = TI_IN, I_BR = TI_BR, I_OUT = TI_OUT, I_C1 = TI_C1;
        int r = it;
        if (r < I_UP) { tr_up(p.in[I_F1W1], 0, (bf16*)(ws + WS_W13A), r, scr, lane); return; } r -= I_UP;
        if (r < I_UP) { tr_up(p.in[I_F1W3], 1, (bf16*)(ws + WS_W13A), r, scr, lane); return; } r -= I_UP;
        if (r < I_DN) { tr_plain(p.in[I_F1W2], DFF, D, (bf16*)(ws + WS_W2A), r, scr, lane); return; } r -= I_DN;
        if (r < I_IN) { tr_win(p.in[I_WIN], (bf16*)(ws + WS_WINT), r, scr, lane); return; } r -= I_IN;
        if (r < I_BR) { tr_plain(p.in[I_BRW], 1024, D, (bf16*)(ws + WS_WBRW), r, scr, lane); return; } r -= I_BR;
        if (r < I_BR) { tr_plain(p.in[I_BNSA], 1024, D, (bf16*)(ws + WS_WBNSA), r, scr, lane); return; } r -= I_BR;
        if (r < I_OUT) { tr_plain(p.in[I_WOUT], D, D, (bf16*)(ws + WS_WOUT), r, scr, lane); return; } r -= I_OUT;
        if (r < I_UP) { tr_up(p.in[I_F2W1], 0, (bf16*)(ws + WS_W13B), r, scr, lane); return; } r -= I_UP;
        if (r < I_UP) { tr_up(p.in[I_F2W3], 1, (bf16*)(ws + WS_W13B), r, scr, lane); return; } r -= I_UP;
        if (r < I_DN) { tr_plain(p.in[I_F2W2], DFF, D, (bf16*)(ws + WS_W2B), r, scr, lane); return; } r -= I_DN;
        if (r < I_C1) { tr_plain(p.in[I_CW1], 4096, 256, (bf16*)(ws + WS_CW1), r, scr, lane); return; } r -= I_C1;
        tr_plain(p.in[I_CW1] + (size_t)4096 * 256, 4096, 256, (bf16*)(ws + WS_CW1) + (size_t)256 * 4096, r, scr, lane);
}
__device__ __forceinline__ void rms_row_to_bf16(const float* xrow, const float* g, bf16* orow, int lane) {
    f32x4 v[8]; float s = 0.f;
#pragma unroll
    for (int j = 0; j < 4; ++j) { const float* p = xrow + (j * 64 + lane) * 8; v[2 * j] = __builtin_nontemporal_load((const f32x4*)p); v[2 * j + 1] = __builtin_nontemporal_load((const f32x4*)(p + 4));
        s += (v[2*j].x * v[2*j].x + v[2*j].y * v[2*j].y) + (v[2*j].z * v[2*j].z + v[2*j].w * v[2*j].w) + (v[2*j+1].x * v[2*j+1].x + v[2*j+1].y * v[2*j+1].y) + (v[2*j+1].z * v[2*j+1].z + v[2*j+1].w * v[2*j+1].w); }
    const float r = 1.0f / sqrtf(wave_sum(s) * (1.0f / D) + RMS_EPS);
#pragma unroll
    for (int j = 0; j < 4; ++j) { const int c = (j * 64 + lane) * 8; const f32x4 g0 = *(const f32x4*)(g + c), g1 = *(const f32x4*)(g + c + 4); const f32x4 a = v[2 * j] * r * g0, b = v[2 * j + 1] * r * g1;
        u32x4 o; o.x = pk2(a.x, a.y); o.y = pk2(a.z, a.w); o.z = pk2(b.x, b.y); o.w = pk2(b.z, b.w); *(u32x4*)(orow + c) = o; }
}
__device__ __forceinline__ void p0_prologue(const P& p, Frame& F) {
    unsigned char* ws = p.ws;
    LAS float* scr = (LAS float*)(F.lds + F.wave * TR_SCR);
    const int gw = F.bid * NWAVES + F.wave, NGW = F.G * NWAVES;
    for (int n = gw; n < TR_NITEMS - TR_NLATE; n += NGW) tr_dispatch(p, n < TR_LATE0 ? n : n + TR_NLATE, scr, F.lane);
    bf16* H = (bf16*)(ws + WS_H);
    for (int m = gw; m < MPAD; m += NGW) {
        if (m < MT) { const float* xr = m < MP ? p.in[I_XP] + (size_t)m * D : p.in[I_XS] + (size_t)(m - MP) * D; rms_row_to_bf16(xr, p.in[I_F1PRE], H + (size_t)m * D, F.lane); }
        else { for (int j = 0; j < 4; ++j) *(u32x4*)(H + (size_t)m * D + (j * 64 + F.lane) * 8) = (u32x4){0u, 0u, 0u, 0u}; }
    }
    const int gt = F.bid * NTHR + F.tid, NGT = F.G * NTHR;
    { bf16* WL = (bf16*)(ws + WS_WLORA);
      for (int i = gt; i < 3072 * 256; i += NGT) { const int n = i >> 8, k = i & 255, seg = n >> 10, nn = n & 1023; float v = 0.f;
          if (seg == 0) { if (k < 64) v = p.in[I_W2][k * 1024 + nn]; } else if (seg == 1) { if (k >= 64 && k < 128) v = p.in[I_A2][(k - 64) * 1024 + nn]; } else { if (k >= 128) v = p.in[I_G2][(k - 128) * 1024 + nn]; }
          WL[i] = (bf16)(pk2(v, 0.f) & 0xffffu); } }
    { bf16* C2 = (bf16*)(ws + WS_CW2);
      for (int i = gt; i < 2 * 256 * 256; i += NGT) { const int kv = i >> 16, n = (i >> 8) & 255, k = i & 255; const float v = n < 128 ? p.in[I_CW2][((size_t)kv * 256 + k) * 128 + n] : 0.f; C2[i] = (bf16)(pk2(v, 0.f) & 0xffffu); } }
    { float* BT = (float*)(ws + WS_BTAB);
      for (int i = gt; i < 8 * 1024; i += NGT) { const int h = i >> 10, n = i & 1023; int b;
          if (n < 16) b = n; else { b = 16 + (int)(log((double)n / 16.0) / log(64.0) * 16.0 + 1e-9);     if (b > 31) b = 31; }
          BT[i] = p.in[I_RELB][b * 8 + h]; } }
    { float* wsO = p.out + O_WS; const float* cw = p.in[I_CWIN];
      for (int i = gt; i < BS * 508 * 128; i += NGT) { const int b = i / (508 * 128), r = i % (508 * 128); *(f32x4*)(wsO + (size_t)b * 512 * 512 + (size_t)r * 4) = *(const f32x4*)(cw + (size_t)b * 512 * 512 + 4 * 512 + (size_t)r * 4); } }
}

__device__ __forceinline__ void tr_late_batch(const P& p, Frame& F, int q) {
    __syncthreads();
    int t_ = threadIdx.x; asm volatile("" : "+v"(t_));
    const int lane = t_ & 63, wave = __builtin_amdgcn_readfirstlane(t_ >> 6);
    LAS float* scr = (LAS float*)(F.lds + wave * TR_SCR);
#pragma nounroll
    for (int i = 0; i < 2; ++i) { const int it = TR_LATE0 + 16 * q + 2 * wave + i; if (it < TR_LATE0 + TR_NLATE) tr_dispatch(p, it, scr, lane); }
}
#define NT_ST4(ptr_, val_) __builtin_nontemporal_store((val_), (f32x4*)(ptr_))
__device__ __forceinline__ u32x4 pack8(const f32x4 a, const f32x4 b) { u32x4 o; o.x = pk2(a.x, a.y); o.y = pk2(a.z, a.w); o.z = pk2(b.x, b.y); o.w = pk2(b.z, b.w); return o; }
__device__ __forceinline__ f32x4 sig4(const f32x4 v) { f32x4 r; r.x = sigmoidf_(v.x); r.y = sigmoidf_(v.y); r.z = sigmoidf_(v.z); r.w = sigmoidf_(v.w); return r; }
__device__ __forceinline__ u32x4 epi_perm(const u32x4 v, const int src4) { u32x4 r;
    r.x = (unsigned)__builtin_amdgcn_ds_bpermute(src4, (int)v.x); r.y = (unsigned)__builtin_amdgcn_ds_bpermute(src4, (int)v.y); r.z = (unsigned)__builtin_amdgcn_ds_bpermute(src4, (int)v.z); r.w = (unsigned)__builtin_amdgcn_ds_bpermute(src4, (int)v.w); return r; }
__device__ __forceinline__ f32x4 epi_permf(const f32x4 v, const int src4) { return __builtin_bit_cast(f32x4, epi_perm(__builtin_bit_cast(u32x4, v), src4)); }
#define EPI_REMAP() const int fr2 = 4 * fq + (fr >> 2), fq2 = fr & 3, src4 = (fr2 + 16 * fq2) << 2
struct EpiSwiglu {
    static constexpr bool PERM = true, AFTER_DRAIN = false; bf16* O;
    __device__ __forceinline__ void operator()(const pg8::f32x4 (&acc)[2][2][4][2], const pg8::Unit& u, int wr, int wc, int fr, int fq) const {
        EPI_REMAP(); const int row0 = u.pm * 256 + wr * 64 + fr2, col0 = u.pn * 128 + wc * 32 + 8 * fq2;
#pragma unroll
        for (int ai = 0; ai < 2; ++ai)
#pragma unroll
            for (int m = 0; m < 4; ++m) { bf16* rowp = O + (size_t)(row0 + ai * 128 + m * 16) * DFF + col0;
                const f32x4 a0 = acc[ai][0][m][0], a1 = acc[ai][0][m][1], b0 = acc[ai][1][m][0], b1 = acc[ai][1][m][1];
                *(u32x4*)rowp = epi_perm(pack8(a0 * sig4(a0) * b0, a1 * sig4(a1) * b1), src4); }
    }
};
struct EpiStore {
    static constexpr bool PERM = true, AFTER_DRAIN = false; bf16* O; int ldc;
    __device__ __forceinline__ void operator()(const pg8::f32x4 (&acc)[2][2][4][2], const pg8::Unit& u, int wr, int wc, int fr, int fq) const {
        EPI_REMAP(); const int row0 = u.pm * 256 + wr * 64 + fr2, col0 = u.pn * 256 + wc * 32 + 8 * fq2;
#pragma unroll
        for (int ai = 0; ai < 2; ++ai)
#pragma unroll
            for (int m = 0; m < 4; ++m) { bf16* rowp = O + (size_t)(row0 + ai * 128 + m * 16) * ldc + col0;
#pragma unroll
                for (int bj = 0; bj < 2; ++bj) *(u32x4*)(rowp + bj * 128) = epi_perm(pack8(acc[ai][bj][m][0], acc[ai][bj][m][1]), src4); }
    }
};
__device__ __forceinline__ size_t tile_native(int pm, int pt, int wr, int wc, int fr, int fq) { return ((size_t)((pm * 8 + pt) * 8 + wr * 4 + wc)) * 8192 + (size_t)(fr + 16 * fq) * 8; }
struct EpiWin {
    static constexpr bool PERM = true, AFTER_DRAIN = false;
    bf16 *PRW, *Q, *KVN, *WINN, *GRW, *GNSA; float* NG; float* out;
    __device__ __forceinline__ void operator()(const pg8::f32x4 (&acc)[2][2][4][2], const pg8::Unit& u, int wr, int wc, int fr, int fq) const {
        EPI_REMAP(); const int pn = u.pn, row0 = u.pm * 256 + wr * 64 + fr2, cw = wc * 32 + 8 * fq2;
#pragma unroll
        for (int ai = 0; ai < 2; ++ai)
#pragma unroll
            for (int m = 0; m < 4; ++m) { const int row = row0 + ai * 128 + m * 16;
#pragma unroll
                for (int bj = 0; bj < 2; ++bj) { const int ct = bj * 128 + cw; f32x4 v0 = acc[ai][bj][m][0], v1 = acc[ai][bj][m][1];
                    if (pn < 23 || pn >= 39) { v0 = epi_permf(v0, src4); v1 = epi_permf(v1, src4); }
                    if (pn < 13) { const int col = pn * 256 + ct; *(u32x4*)(PRW + (size_t)row * RWP + col) = pack8(v0, v1);
                        float* so = nullptr;
                        if (row < MP) { if ((row & (TP - 1)) == TP - 1) so = out + O_SP + (size_t)(row >> 11) * RWP + col; }
                        else if (row < MT) { if (((row - MP) & 3) == 3) so = out + O_SS + (size_t)((row - MP) >> 2) * RWP + col; }
                        if (so) { NT_ST4(so, v0); NT_ST4(so + 4, v1); } }
                    else if (pn < 17) { const int col = (pn - 13) * 256 + ct; *(u32x4*)(Q + (size_t)row * 1024 + col) = pack8(v0, v1); }
                    else if (pn < 21) { const int col = (pn - 17) * 256 + ct; *(u32x4*)(KVN + (size_t)row * 1024 + col) = pack8(v0, v1);
                        if (row < MT) { float* so = out + O_KV + (size_t)row * 1024 + col; NT_ST4(so, v0); NT_ST4(so + 4, v1); } }
                    else if (pn < 23) { const int col = (pn - 21) * 256 + ct; *(u32x4*)(WINN + (size_t)row * 512 + col) = pack8(v0, v1);
                        float* so = nullptr;
                        if (row < MP) { const int t = row & (TP - 1); if (t >= TP - 512) so = out + O_WP + ((size_t)(row >> 11) * 512 + (t - (TP - 512))) * 512 + col; }
                        else if (row < MT) { const int b = (row - MP) >> 2, t = (row - MP) & 3; so = out + O_WS + ((size_t)b * 512 + 508 + t) * 512 + col; }
                        if (so) { NT_ST4(so, v0); NT_ST4(so + 4, v1); } }
                    else if (pn < 31) { *(u32x4*)(GRW + tile_native(u.pm, pn - 23, wr, wc, fr, fq) + (size_t)(((ai * 2 + bj) * 4 + m) * 512)) = pack8(sig4(v0), sig4(v1)); }
                    else if (pn < 39) { *(u32x4*)(GNSA + tile_native(u.pm, pn - 31, wr, wc, fr, fq) + (size_t)(((ai * 2 + bj) * 4 + m) * 512)) = pack8(sig4(v0), sig4(v1)); }
                    else { if (ct < 24) { float* so = NG + (size_t)row * 32 + ct; *(f32x4*)so = sig4(v0); *(f32x4*)(so + 4) = sig4(v1); } } } }
    }
};
struct EpiLora {
    static constexpr bool PERM = true, AFTER_DRAIN = false; float *DEC, *AA, *GG; const float *w0, *a0;
    template <int SEG> __device__ __forceinline__ void run(const pg8::f32x4 (&acc)[2][2][4][2], const pg8::Unit& u, int wr, int wc, int fr, int fq) const {
        const int row0 = u.pm * 256 + wr * 64 + fr, cb = (u.pn & 3) * 256 + wc * 32 + 8 * fq;
        float* O = SEG == 0 ? DEC : (SEG == 1 ? AA : GG); const float* bias = SEG == 0 ? w0 : a0;
#pragma unroll
        for (int bj = 0; bj < 2; ++bj)
#pragma unroll
            for (int n = 0; n < 2; ++n) { const int col = cb + bj * 128 + 4 * n; f32x4 b = (f32x4){0.f, 0.f, 0.f, 0.f}; if (SEG < 2) b = *(const f32x4*)(bias + col);
#pragma unroll
                for (int ai = 0; ai < 2; ++ai)
#pragma unroll
                    for (int m = 0; m < 4; ++m) { const int row = row0 + ai * 128 + m * 16; f32x4 v = acc[ai][bj][m][n] + b;
                        if (SEG == 0) {
                            const f32x4 sg = sig4(v);
#pragma unroll
                            for (int i = 0; i < 4; ++i) v[i] = __builtin_amdgcn_exp2f(-0.8750387749145276f * sg[i]); }
                        else if (SEG == 1) v = sig4(v);
                        if (SEG == 2) { u32x2 w; w.x = pk2(v.x, v.y); w.y = pk2(v.z, v.w); *(u32x2*)((bf16*)GG + (size_t)row * 1024 + col) = w; }
                        else *(f32x4*)(O + (size_t)row * 1024 + col) = v; }
                asm volatile("" ::: "memory"); }
    }
    __device__ __forceinline__ void operator()(const pg8::f32x4 (&acc)[2][2][4][2], const pg8::Unit& u, int wr, int wc, int fr, int fq) const {
        const int seg = u.pn >> 2;
        if (seg == 0) run<0>(acc, u, wr, wc, fr, fq); else if (seg == 1) run<1>(acc, u, wr, wc, fr, fq); else run<2>(acc, u, wr, wc, fr, fq);
    }
};
struct DiagOrder {
    int G, c;
    __device__ bool next(int i, pg8::Unit& u) const { const int L = i * G + c; if (L >= 2 * (CMPROWS / 256)) return false; u.pm = L; u.pn = L >= (CMPROWS / 256) ? 1 : 0; return true; }
    __device__ __forceinline__ void a_ready(const pg8::Unit&) const {}
    __device__ __forceinline__ void done(const pg8::Unit&) const {}
};
__device__ __forceinline__ float gelu_tanh(float x) { const float u = 0.7978845608028654f * (x + 0.044715f * x * x * x); const float th = 1.0f - 2.0f / (1.0f + __expf(2.0f * u)); return 0.5f * x * (1.0f + th); }
struct EpiCmp1 {
    static constexpr bool PERM = true, AFTER_DRAIN = false; bf16* O;
    __device__ __forceinline__ void operator()(const pg8::f32x4 (&acc)[2][2][4][2], const pg8::Unit& u, int wr, int wc, int fr, int fq) const {
        const int row0 = u.pm * 256 + wr * 64 + fr, col0 = wc * 32 + 8 * fq;
#pragma unroll
        for (int ai = 0; ai < 2; ++ai)
#pragma unroll
            for (int m = 0; m < 4; ++m) { bf16* rowp = O + (size_t)(row0 + ai * 128 + m * 16) * 256 + col0;
#pragma unroll
                for (int bj = 0; bj < 2; ++bj) { f32x4 a = acc[ai][bj][m][0], b = acc[ai][bj][m][1];
#pragma unroll
                    for (int i = 0; i < 4; ++i) { a[i] = gelu_tanh(a[i]); b[i] = gelu_tanh(b[i]); }
                    *(u32x4*)(rowp + bj * 128) = pack8(a, b); } }
    }
};
struct EpiCmp2 {
    static constexpr bool PERM = true, AFTER_DRAIN = false; float* O;
    __device__ __forceinline__ void operator()(const pg8::f32x4 (&acc)[2][2][4][2], const pg8::Unit& u, int wr, int wc, int fr, int fq) const {
        const int row0 = u.pm * 256 + wr * 64 + fr, col0 = wc * 32 + 8 * fq;
#pragma unroll
        for (int ai = 0; ai < 2; ++ai)
#pragma unroll
            for (int m = 0; m < 4; ++m) { float* rowp = O + (size_t)(row0 + ai * 128 + m * 16) * 256 + col0; *(f32x4*)rowp = acc[ai][0][m][0]; *(f32x4*)(rowp + 4) = acc[ai][0][m][1]; }
    }
};
template <int STAGE> struct EpiMerge {
    static constexpr bool PERM = true, AFTER_DRAIN = false; const bf16* GATE; bf16* MRG; bf16* PART;
    __device__ __forceinline__ void operator()(const pg8::f32x4 (&acc)[2][2][4][2], const pg8::Unit& u, int wr, int wc, int fr, int fq) const {
        EPI_REMAP(); const int row0 = u.pm * 256 + wr * 64 + fr2, col0 = u.pn * 256 + wc * 32 + 8 * fq2; const size_t nat = tile_native(u.pm, u.pn, wr, wc, fr, fq);
#pragma unroll
        for (int ai = 0; ai < 2; ++ai)
#pragma unroll
            for (int m = 0; m < 4; ++m) { const size_t off = (size_t)(row0 + ai * 128 + m * 16) * D + col0;
#pragma unroll
                for (int bj = 0; bj < 2; ++bj) { const size_t no = nat + (size_t)(((ai * 2 + bj) * 4 + m) * 512); const u32x4 gw = *(const u32x4*)(GATE + no);
                    f32x4 a = acc[ai][bj][m][0] * (f32x4){bflo(gw.x), bfhi(gw.x), bflo(gw.y), bfhi(gw.y)}, b = acc[ai][bj][m][1] * (f32x4){bflo(gw.z), bfhi(gw.z), bflo(gw.w), bfhi(gw.w)};
                    if (STAGE == 0) *(u32x4*)(PART + no) = pack8(a, b);
                    else { const u32x4 pw = *(const u32x4*)(PART + no); a += (f32x4){bflo(pw.x), bfhi(pw.x), bflo(pw.y), bfhi(pw.y)}; b += (f32x4){bflo(pw.z), bfhi(pw.z), bflo(pw.w), bfhi(pw.w)};
                        *(u32x4*)(MRG + off + bj * 128) = epi_perm(pack8(a, b), src4); } } }
    }
};
#define MFMA16(a, b, c) __builtin_amdgcn_mfma_f32_16x16x32_bf16((a), (b), (c), 0, 0, 0)
template <int CW, int NB, int NS, class Epi>
__device__ __forceinline__ void skinny_gemm(Frame& F, const bf16* A, int K, const bf16* Bt, int nchunks, const Epi& E) {
    constexpr int NT = (CW + 15) / 16, NBT = NT * NB, SROWS = 32 + 16 * NBT, SBYTES = SROWS * 144;
    int t_ = threadIdx.x; asm volatile("" : "+v"(t_));
    const int lane = t_ & 63, wave = __builtin_amdgcn_readfirstlane(t_ >> 6), lr = lane & 15, lq = lane >> 4, ks = wave & 1, rg = wave >> 1;
    const int srow = lane >> 3, sp = lane & 7;
    asm volatile("" : "+s"(K));
    const int kh = K >> 1;
    LAS pg8::f32x4* red = (LAS pg8::f32x4*)F.lds;
    LAS unsigned char* stg = F.lds + wave * SBYTES;
    const int woff = srow * 144 + sp * 16, roff = lr * 144 + lq * 32;
    __syncthreads();
    for (int chunk = F.bid; chunk < nchunks; chunk += F.G) {
        const int c0 = chunk * CW;
        const unsigned ao = (unsigned)((32 * rg + srow) * K + ks * kh + 8 * sp);
        unsigned bo[NBT][2];
#pragma unroll
        for (int j = 0; j < NT; ++j)
#pragma unroll
            for (int nb = 0; nb < NB; ++nb)
#pragma unroll
                for (int u = 0; u < 2; ++u) { const int cc = 16 * j + srow + 8 * u, col = c0 + (cc < CW ? cc : CW - 1); bo[j * NB + nb][u] = (unsigned)(E.brow(col, nb) * K + ks * kh + 8 * sp); }
        pg8::f32x4 acc[2][NT][NB];
#pragma unroll
        for (int i = 0; i < 2; ++i)
#pragma unroll
            for (int j = 0; j < NT; ++j)
#pragma unroll
                for (int nb = 0; nb < NB; ++nb) acc[i][j][nb] = (pg8::f32x4){0.f, 0.f, 0.f, 0.f};
        bf16x8 ga[NS][4], gb[NS][NBT][2];
#define SK_LOAD(set, blk_) do { const int kk_ = (blk_) * 64; _Pragma("unroll") for (int u_ = 0; u_ < 4; ++u_) ga[set][u_] = *(const bf16x8*)(A + (ao + (unsigned)(8 * u_ * K + kk_))); \
            _Pragma("unroll") for (int q_ = 0; q_ < NBT; ++q_) _Pragma("unroll") for (int u_ = 0; u_ < 2; ++u_) gb[set][q_][u_] = *(const bf16x8*)(Bt + (bo[q_][u_] + (unsigned)kk_)); } while (0)
#define SK_MMA(set) do { \
            _Pragma("unroll") for (int u_ = 0; u_ < 4; ++u_) *(LAS bf16x8*)(stg + woff + u_ * 8 * 144) = ga[set][u_]; \
            _Pragma("unroll") for (int q_ = 0; q_ < NBT; ++q_) _Pragma("unroll") for (int u_ = 0; u_ < 2; ++u_) *(LAS bf16x8*)(stg + (32 + 16 * q_ + 8 * u_) * 144 + woff) = gb[set][q_][u_]; \
            __builtin_amdgcn_fence(__ATOMIC_RELEASE, "wavefront"); __builtin_amdgcn_wave_barrier(); __builtin_amdgcn_fence(__ATOMIC_ACQUIRE, "wavefront"); \
            bf16x8 fa_[2][2], fb_[NBT][2]; \
            _Pragma("unroll") for (int i_ = 0; i_ < 2; ++i_) _Pragma("unroll") for (int s_ = 0; s_ < 2; ++s_) fa_[i_][s_] = *(const LAS bf16x8*)(stg + i_ * 16 * 144 + roff + 16 * s_); \
            _Pragma("unroll") for (int q_ = 0; q_ < NBT; ++q_) _Pragma("unroll") for (int s_ = 0; s_ < 2; ++s_) fb_[q_][s_] = *(const LAS bf16x8*)(stg + (32 + 16 * q_) * 144 + roff + 16 * s_); \
            __builtin_amdgcn_fence(__ATOMIC_RELEASE, "wavefront"); __builtin_amdgcn_wave_barrier(); __builtin_amdgcn_fence(__ATOMIC_ACQUIRE, "wavefront"); \
            _Pragma("unroll") for (int s_ = 0; s_ < 2; ++s_) _Pragma("unroll") for (int i_ = 0; i_ < 2; ++i_) _Pragma("unroll") for (int j_ = 0; j_ < NT; ++j_) \
            _Pragma("unroll") for (int nb_ = 0; nb_ < NB; ++nb_) acc[i_][j_][nb_] = MFMA16(fb_[j_ * NB + nb_][s_], fa_[i_][s_], acc[i_][j_][nb_]); } while (0)
        const int nblk = kh >> 6;
#pragma unroll
        for (int s = 0; s < NS - 1; ++s) SK_LOAD(s, s);
        for (int blk = 0; blk < nblk; blk += NS) {
#pragma unroll
            for (int s = 0; s < NS; ++s) {
                if (blk + s + NS - 1 < nblk) SK_LOAD((s + NS - 1) % NS, blk + s + NS - 1);
                if (blk + s < nblk) SK_MMA(s);
            }
        }
#undef SK_LOAD
#undef SK_MMA
        __syncthreads();
        if (ks == 1) {
#pragma unroll
            for (int i = 0; i < 2; ++i)
#pragma unroll
                for (int j = 0; j < NT; ++j)
#pragma unroll
                    for (int nb = 0; nb < NB; ++nb) red[((i * NT + j) * NB + nb) * 256 + rg * 64 + lane] = acc[i][j][nb];
        }
        __syncthreads();
        if (ks == 0) {
#pragma unroll
            for (int i = 0; i < 2; ++i)
#pragma unroll
                for (int j = 0; j < NT; ++j) {
#pragma unroll
                    for (int nb = 0; nb < NB; ++nb) acc[i][j][nb] += red[((i * NT + j) * NB + nb) * 256 + rg * 64 + lane];
                    if (16 * j + 4 * lq < CW) E(32 * rg + 16 * i + lr, c0 + 16 * j + 4 * lq, acc[i][j][0], acc[i][j][NB - 1]); }
        }
        __syncthreads();
    }
}
template <int NS, class Epi>
__device__ __forceinline__ void skinny_gemm2d(Frame& F, const bf16* A, int K, const bf16* Bt, const Epi& E) {
    int t_ = threadIdx.x; asm volatile("" : "+v"(t_));
    const int lane = t_ & 63, wave = __builtin_amdgcn_readfirstlane(t_ >> 6), lr = lane & 15, lq = lane >> 4, ks = wave & 1, mt = (wave >> 1) & 1, nt = wave >> 2;
    const int srow = lane >> 3, sp = lane & 7;
    const int kh = K >> 1;
    LAS pg8::f32x4* red = (LAS pg8::f32x4*)F.lds;
    LAS unsigned char* stg = F.lds + 4096 + wave * 9216;
    const int woff = srow * 144 + sp * 16, roff = lr * 144 + lq * 32;
    __syncthreads();
    for (int chunk = F.bid; chunk < 256; chunk += F.G) {
        const int cx = chunk & 7, cy = chunk >> 3;
        const int r0 = 32 * (cy & 3) + 16 * mt, c0 = 32 * (cx + 8 * (cy >> 2)) + 16 * nt;
        const bf16* ap0 = A + (size_t)(r0 + srow) * K + ks * kh + 8 * sp; const bf16* ap1 = ap0 + (size_t)8 * K;
        const bf16* bp0 = Bt + (size_t)E.brow(c0 + srow, 0) * K + ks * kh + 8 * sp; const bf16* bp1 = Bt + (size_t)E.brow(c0 + srow + 8, 0) * K + ks * kh + 8 * sp;
        pg8::f32x4 acc = (pg8::f32x4){0.f, 0.f, 0.f, 0.f};
        bf16x8 g[NS][4];
#define SK_LOAD(set, blk_) do { const int kk_ = (blk_) * 64; g[set][0] = *(const bf16x8*)(ap0 + kk_); g[set][1] = *(const bf16x8*)(ap1 + kk_); g[set][2] = *(const bf16x8*)(bp0 + kk_); g[set][3] = *(const bf16x8*)(bp1 + kk_); } while (0)
#define SK_MMA(set, buf_) do { LAS unsigned char* sb_ = stg + (buf_) * 4608; \
            *(LAS bf16x8*)(sb_ + woff) = g[set][0]; *(LAS bf16x8*)(sb_ + woff + 8 * 144) = g[set][1]; *(LAS bf16x8*)(sb_ + 2304 + woff) = g[set][2]; *(LAS bf16x8*)(sb_ + 2304 + woff + 8 * 144) = g[set][3]; \
            __builtin_amdgcn_fence(__ATOMIC_RELEASE, "wavefront"); __builtin_amdgcn_wave_barrier(); __builtin_amdgcn_fence(__ATOMIC_ACQUIRE, "wavefront"); \
            const bf16x8 a0_ = *(const LAS bf16x8*)(sb_ + roff), a1_ = *(const LAS bf16x8*)(sb_ + roff + 16), b0_ = *(const LAS bf16x8*)(sb_ + 2304 + roff), b1_ = *(const LAS bf16x8*)(sb_ + 2304 + roff + 16); \
            acc = MFMA16(b0_, a0_, acc); acc = MFMA16(b1_, a1_, acc); } while (0)
        const int nblk = kh >> 6;
#pragma unroll
        for (int s = 0; s < NS - 1; ++s) SK_LOAD(s, s);
        for (int blk = 0; blk < nblk; blk += NS) {
#pragma unroll
            for (int s = 0; s < NS; ++s) {
                if (blk + s + NS - 1 < nblk) SK_LOAD((s + NS - 1) % NS, blk + s + NS - 1);
                if (blk + s < nblk) SK_MMA(s, s & 1);
            }
        }
#undef SK_LOAD
#undef SK_MMA
        if (ks == 1) red[(mt * 2 + nt) * 64 + lane] = acc;
        __syncthreads();
        if (ks == 0) { acc += red[(mt * 2 + nt) * 64 + lane]; E(r0 + lr, c0 + 4 * lq, acc, acc); }
        __syncthreads();
    }
}
struct SkSwiglu {
    bf16* ACT;
    __device__ __forceinline__ int brow(int c, int which) const { return (c >> 7) * 256 + (c & 127) + which * 128; }
    __device__ __forceinline__ void operator()(int r, int c, const pg8::f32x4 a, const pg8::f32x4 b) const {
        const f32x4 v = a * sig4(a) * b; u32x2 w; w.x = pk2(v.x, v.y); w.y = pk2(v.z, v.w); *(u32x2*)(ACT + (size_t)(MP + r) * DFF + c) = w; }
};
struct SkStore {
    bf16* O; int ldc;
    __device__ __forceinline__ int brow(int c, int) const { return c; }
    __device__ __forceinline__ void operator()(int r, int c, const pg8::f32x4 a, const pg8::f32x4) const {
        u32x2 w; w.x = pk2(a.x, a.y); w.y = pk2(a.z, a.w); *(u32x2*)(O + (size_t)(MP + r) * ldc + c) = w; }
};
struct SkWin {
    bf16 *PRW, *Q, *KVN, *WINN, *GRW, *GNSA; float* NG; float* out;
    __device__ __forceinline__ int brow(int c, int) const { return c; }
    __device__ __forceinline__ void operator()(int r, int n, const pg8::f32x4 a, const pg8::f32x4) const {
        const int row = MP + r, b = r >> 2, t = r & 3;
        u32x2 w; w.x = pk2(a.x, a.y); w.y = pk2(a.z, a.w);
        if (n < 3328) { *(u32x2*)(PRW + (size_t)row * RWP + n) = w; if (t == 3) *(f32x4*)(out + O_SS + (size_t)b * RWP + n) = a; }
        else if (n < 4352) { *(u32x2*)(Q + (size_t)row * 1024 + (n - 3328)) = w; }
        else if (n < 5376) { *(u32x2*)(KVN + (size_t)row * 1024 + (n - 4352)) = w; *(f32x4*)(out + O_KV + (size_t)row * 1024 + (n - 4352)) = a; }
        else if (n < 5888) { *(u32x2*)(WINN + (size_t)row * 512 + (n - 5376)) = w; *(f32x4*)(out + O_WS + ((size_t)b * 512 + 508 + t) * 512 + (n - 5376)) = a; }
        else if (n < 7936) { const f32x4 s = sig4(a); u32x2 x; x.x = pk2(s.x, s.y); x.y = pk2(s.z, s.w); *(u32x2*)(GRW + (size_t)row * D + (n - 5888)) = x; }
        else if (n < 9984) { const f32x4 s = sig4(a); u32x2 x; x.x = pk2(s.x, s.y); x.y = pk2(s.z, s.w); *(u32x2*)(GNSA + (size_t)row * D + (n - 7936)) = x; }
        else if (n < 10008) { *(f32x4*)(NG + (size_t)row * 32 + (n - 9984)) = sig4(a); }
    }
};
struct SkLora {
    float *DEC, *AA, *GG; const float *w0, *a0;
    __device__ __forceinline__ int brow(int c, int) const { return c; }
    __device__ __forceinline__ void operator()(int r, int n, const pg8::f32x4 a, const pg8::f32x4) const {
        const int seg = n >> 10, col = n & 1023, row = MP + r; f32x4 v = a;
        if (seg == 0) { const f32x4 sg = sig4(v + *(const f32x4*)(w0 + col));
#pragma unroll
            for (int i = 0; i < 4; ++i) v[i] = __builtin_amdgcn_exp2f(-0.8750387749145276f * sg[i]);
            *(f32x4*)(DEC + (size_t)row * 1024 + col) = v; }
        else if (seg == 1) { *(f32x4*)(AA + (size_t)row * 1024 + col) = sig4(v + *(const f32x4*)(a0 + col)); }
        else { u32x2 w; w.x = pk2(v.x, v.y); w.y = pk2(v.z, v.w); *(u32x2*)((bf16*)GG + (size_t)row * 1024 + col) = w; }
    }
};
template <int STAGE> struct SkMerge {
    const bf16* GATE; bf16* MRG;
    __device__ __forceinline__ int brow(int c, int) const { return c; }
    __device__ __forceinline__ void operator()(int r, int c, const pg8::f32x4 a, const pg8::f32x4) const {
        const size_t off = (size_t)(MP + r) * D + c; const u32x2 gw = *(const u32x2*)(GATE + off);
        f32x4 v = a * (f32x4){bflo(gw.x), bfhi(gw.x), bflo(gw.y), bfhi(gw.y)};
        if (STAGE == 1) { const u32x2 pw = *(const u32x2*)(MRG + off); v += (f32x4){bflo(pw.x), bfhi(pw.x), bflo(pw.y), bfhi(pw.y)}; }
        u32x2 w; w.x = pk2(v.x, v.y); w.y = pk2(v.z, v.w); *(u32x2*)(MRG + off) = w; }
};
template <bool INB, bool OUTB>
__device__ __forceinline__ void thin_phase(Frame& F, const bf16* Fb, const void* xin_p, const void* xin_s, const float* post_g, float half, void* xout, const float* next_g, bf16* H) {
    const int gw = F.bid * NWAVES + F.wave, NGW = F.G * NWAVES, lane = F.lane;
    for (int m0 = 2 * gw; m0 < MT; m0 += 2 * NGW) {
        f32x4 f[2][8], x[2][8]; float s[2] = {0.f, 0.f};
#pragma unroll
        for (int r = 0; r < 2; ++r) { const int m = m0 + r;
#pragma unroll
            for (int j = 0; j < 4; ++j) { const int c = (j * 64 + lane) * 8; const u32x4 w = *(const u32x4*)(Fb + (size_t)m * D + c);
                f[r][2 * j] = (f32x4){bflo(w.x), bfhi(w.x), bflo(w.y), bfhi(w.y)}; f[r][2 * j + 1] = (f32x4){bflo(w.z), bfhi(w.z), bflo(w.w), bfhi(w.w)};
                if (INB) { const bf16* xr = m < MP ? (const bf16*)xin_p + (size_t)m * D : (const bf16*)xin_s + (size_t)(m - MP) * D; const u32x4 xw = *(const u32x4*)(xr + c);
                    x[r][2 * j] = (f32x4){bflo(xw.x), bfhi(xw.x), bflo(xw.y), bfhi(xw.y)}; x[r][2 * j + 1] = (f32x4){bflo(xw.z), bfhi(xw.z), bflo(xw.w), bfhi(xw.w)}; }
                else { const float* xr = m < MP ? (const float*)xin_p + (size_t)m * D : (const float*)xin_s + (size_t)(m - MP) * D; x[r][2 * j] = *(const f32x4*)(xr + c); x[r][2 * j + 1] = *(const f32x4*)(xr + c + 4); } } }
#pragma unroll
        for (int r = 0; r < 2; ++r)
#pragma unroll
            for (int q = 0; q < 8; ++q) s[r] += (f[r][q].x * f[r][q].x + f[r][q].y * f[r][q].y) + (f[r][q].z * f[r][q].z + f[r][q].w * f[r][q].w);
        const float r0 = half / sqrtf(wave_sum(s[0]) * (1.0f / D) + RMS_EPS), r1 = half / sqrtf(wave_sum(s[1]) * (1.0f / D) + RMS_EPS);
        float s2[2] = {0.f, 0.f};
#pragma unroll
        for (int j = 0; j < 4; ++j) { const int c = (j * 64 + lane) * 8; const f32x4 g0 = *(const f32x4*)(post_g + c), g1 = *(const f32x4*)(post_g + c + 4);
#pragma unroll
            for (int r = 0; r < 2; ++r) { const f32x4 o0 = x[r][2 * j] + f[r][2 * j] * (r == 0 ? r0 : r1) * g0, o1 = x[r][2 * j + 1] + f[r][2 * j + 1] * (r == 0 ? r0 : r1) * g1; f[r][2 * j] = o0; f[r][2 * j + 1] = o1;
                if (OUTB) *(u32x4*)((bf16*)xout + (size_t)(m0 + r) * D + c) = pack8(o0, o1);
                else { NT_ST4((float*)xout + (size_t)(m0 + r) * D + c, o0); NT_ST4((float*)xout + (size_t)(m0 + r) * D + c + 4, o1); }
                s2[r] += ((o0.x * o0.x + o0.y * o0.y) + (o0.z * o0.z + o0.w * o0.w)) + ((o1.x * o1.x + o1.y * o1.y) + (o1.z * o1.z + o1.w * o1.w)); } }
        if (next_g) { const float q0 = 1.0f / sqrtf(wave_sum(s2[0]) * (1.0f / D) + RMS_EPS), q1 = 1.0f / sqrtf(wave_sum(s2[1]) * (1.0f / D) + RMS_EPS);
#pragma unroll
            for (int j = 0; j < 4; ++j) { const int c = (j * 64 + lane) * 8; const f32x4 g0 = *(const f32x4*)(next_g + c), g1 = *(const f32x4*)(next_g + c + 4);
#pragma unroll
                for (int r = 0; r < 2; ++r) *(u32x4*)(H + (size_t)(m0 + r) * D + c) = pack8(f[r][2 * j] * (r == 0 ? q0 : q1) * g0, f[r][2 * j + 1] * (r == 0 ? q0 : q1) * g1); } }
    }
}
constexpr int BTX = 2112;
constexpr int A_KT = 0, A_VT = 17408, A_BT = 34816, A_IMP = 68608, A_SELM = 102400, A_UL = 102656, A_UM = 103168, A_NU = 103680, A_SELB = 103936;
constexpr int KT_PITCH = 272, VT_PITCH = 136;
constexpr float NEGB = -1e30f;
#ifndef PREFETCH_TILES
#define PREFETCH_TILES 0
#endif
#define MFMA32(a, b, c) __builtin_amdgcn_mfma_f32_32x32x16_bf16((a), (b), (c), 0, 0, 0)

__device__ __forceinline__ void stage_tile(Frame& F, const void* kp, const void* vp, int pitch, bool isf32, int nvalid) {
    LAS unsigned char* KT = F.lds + A_KT; LAS unsigned char* VT = F.lds + A_VT;
    int tid = F.tid; asm volatile("" : "+v"(tid));
    { const int key = tid >> 3, ch = tid & 7; u32x4 o0 = (u32x4){0u, 0u, 0u, 0u}, o1 = o0;
      if (key < nvalid) {
          if (isf32) { const float* s = (const float*)kp + (size_t)key * pitch + ch * 16; const f32x4 a = *(const f32x4*)s, b = *(const f32x4*)(s + 4), c = *(const f32x4*)(s + 8), d = *(const f32x4*)(s + 12); o0 = pack8(a, b); o1 = pack8(c, d); }
          else { const bf16* s = (const bf16*)kp + (size_t)key * pitch + ch * 16; o0 = *(const u32x4*)s; o1 = *(const u32x4*)(s + 8); } }
      *(LAS u32x4*)(KT + key * KT_PITCH + ch * 32) = o0; *(LAS u32x4*)(KT + key * KT_PITCH + ch * 32 + 16) = o1; }
    { const int key = tid >> 3, dc = tid & 7; u32x4 o0 = (u32x4){0u, 0u, 0u, 0u}, o1 = o0;
      if (key < nvalid) {
          if (isf32) { const float* s = (const float*)vp + (size_t)key * pitch + dc * 16; const f32x4 a = *(const f32x4*)s, b = *(const f32x4*)(s + 4), c = *(const f32x4*)(s + 8), d = *(const f32x4*)(s + 12); o0 = pack8(a, b); o1 = pack8(c, d); }
          else { const bf16* s = (const bf16*)vp + (size_t)key * pitch + dc * 16; o0 = *(const u32x4*)s; o1 = *(const u32x4*)(s + 8); } }
      LAS unsigned short* vt = (LAS unsigned short*)(VT + (dc * 16) * VT_PITCH + key * 2);
      const unsigned w[8] = {o0.x, o0.y, o0.z, o0.w, o1.x, o1.y, o1.z, o1.w};
#pragma unroll
      for (int i = 0; i < 8; ++i) { vt[(2 * i) * (VT_PITCH / 2)] = (unsigned short)(w[i] & 0xffffu); vt[(2 * i + 1) * (VT_PITCH / 2)] = (unsigned short)(w[i] >> 16); } }
}

struct TileRegs { u32x4 k0, k1, v0, v1; };
__device__ __forceinline__ void tile_load(TileRegs& r, const bf16* kp, const bf16* vp, int pitch, int tid) {
    const bf16* ks = kp + (size_t)(tid >> 3) * pitch + (tid & 7) * 16; r.k0 = *(const u32x4*)ks; r.k1 = *(const u32x4*)(ks + 8);
    const bf16* vs = vp + (tid >> 2) * 64 + (tid & 3) * 16; r.v0 = *(const u32x4*)vs; r.v1 = *(const u32x4*)(vs + 8);
}
__device__ __forceinline__ void tile_store(Frame& F, const TileRegs& r, int tid, int boff) {
    LAS unsigned char* kd = F.lds + A_KT + boff + (tid >> 3) * KT_PITCH + (tid & 7) * 32; *(LAS u32x4*)kd = r.k0; *(LAS u32x4*)(kd + 16) = r.k1;
    LAS unsigned char* vd = F.lds + A_VT + boff + (tid >> 2) * VT_PITCH + (tid & 3) * 32;
    *(LAS u32x2*)vd = (u32x2){r.v0.x, r.v0.y}; *(LAS u32x2*)(vd + 8) = (u32x2){r.v0.z, r.v0.w}; *(LAS u32x2*)(vd + 16) = (u32x2){r.v1.x, r.v1.y}; *(LAS u32x2*)(vd + 24) = (u32x2){r.v1.z, r.v1.w};
}
constexpr int A_BUF2 = 106240;
__device__ __forceinline__ void loader_stage(Frame& F, const void* kp, const void* vp, int pitch, bool isf32, int nvalid, int lt, int boff) {
    const int key = lt >> 2, ch = lt & 3;
#pragma unroll
    for (int kv = 0; kv < 2; ++kv) { const void* sp = kv ? vp : kp; u32x2 r[8];
#pragma unroll
        for (int j = 0; j < 8; ++j) r[j] = (u32x2){0u, 0u};
        if (key < nvalid) {
            if (isf32) { const float* s = (const float*)sp + (size_t)key * pitch + 4 * ch; f32x4 a[8];
#pragma unroll
                for (int j = 0; j < 8; ++j) a[j] = *(const f32x4*)(s + 16 * j);
#pragma unroll
                for (int j = 0; j < 8; ++j) { r[j].x = pk2(a[j].x, a[j].y); r[j].y = pk2(a[j].z, a[j].w); } }
            else { const bf16* s = (const bf16*)sp + (size_t)key * pitch + 4 * ch;
#pragma unroll
                for (int j = 0; j < 8; ++j) r[j] = *(const u32x2*)(s + 16 * j); } }
        if (kv == 0) { LAS unsigned char* kd = F.lds + A_KT + boff + key * KT_PITCH + 8 * ch;
#pragma unroll
            for (int j = 0; j < 8; ++j) *(LAS u32x2*)(kd + 32 * j) = r[j]; }
        else { LAS unsigned short* vt = (LAS unsigned short*)(F.lds + A_VT + boff + (4 * ch) * VT_PITCH + key * 2);
#pragma unroll
            for (int j = 0; j < 8; ++j) { const unsigned w[2] = {r[j].x, r[j].y};
#pragma unroll
                for (int e = 0; e < 2; ++e) { vt[(16 * j + 2 * e) * (VT_PITCH / 2)] = (unsigned short)(w[e] & 0xffffu); vt[(16 * j + 2 * e + 1) * (VT_PITCH / 2)] = (unsigned short)(w[e] >> 16); } } } }
}
#define SAMPLE_TILE(ii, kpX, vpX, pitchX, f32X, nvX) do { nvX = 64; \
    if (ph < 2) { kpX = kc_k + (size_t)(64 * (ii)) * 512; vpX = kc_v + (size_t)(64 * (ii)) * 512; pitchX = 512; f32X = true; } \
    else if (ph == 2) { const int j_ = UL[ii]; pitchX = 1024; \
        if (j_ < 128) { const int page_ = pt[j_ >> 1]; const float* kb_ = ckv + ((size_t)(page_ * PAGE + (j_ & 1) * 64) * 4 + 2) * 256 + g * 128; kpX = kb_; vpX = kb_ + 256; f32X = true; } \
        else { const bf16* kb_ = KVN + (size_t)(MP + b * 4) * 1024 + 2 * 256 + g * 128; kpX = kb_; vpX = kb_ + 256; f32X = false; nvX = 4; } } \
    else { pitchX = 512; \
        if ((ii) < 8) { const float* kb_ = cw + ((size_t)(b * 512 + 64 * (ii)) * 2) * 256 + g * 128; kpX = kb_; vpX = kb_ + 256; f32X = true; } \
        else { const bf16* kb_ = WINN + (size_t)(MP + b * 4) * 512 + g * 128; kpX = kb_; vpX = kb_ + 256; f32X = false; nvX = 4; } } } while (0)
constexpr float NEG_M = -1e30f, NEG_S = -3e30f;
template <int MODE>
__device__ __forceinline__ void tile_compute(Frame& F, const int boff, const LAS float* btab, const bf16x8 (&qf)[8], int t, bool lanevalid, int kp0, int kstride, int nvalid, int wlimit, bool far, bool interior,
                                             float& m, float& l, f32x16 (&ot)[4], float invl, LAS float* imp_row, int jbase, bool impwrite) {
    const LAS unsigned char* KT = F.lds + A_KT + boff; const LAS unsigned char* VT = F.lds + A_VT + boff;
    const int ql = F.lane & 31, half = F.lane >> 5;
    const float SC = 0.08838834764831845f * 1.4426950408889634f;
#pragma nounroll
    for (int nt = 0; nt < 2; ++nt) {
        f32x16 st;
#pragma unroll
        for (int i = 0; i < 16; ++i) st[i] = 0.f;
        { const LAS unsigned char* ka = KT + (32 * nt + ql) * KT_PITCH + 16 * half;
#pragma unroll
          for (int kg = 0; kg < 2; ++kg) { bf16x8 kf[4];
#pragma unroll
              for (int ks = 0; ks < 4; ++ks) kf[ks] = *(const LAS bf16x8*)(ka + 32 * (4 * kg + ks));
#pragma unroll
              for (int ks = 0; ks < 4; ++ks) st = MFMA32(kf[ks], qf[4 * kg + ks], st); } }
        float mloc = NEG_S;
        if (far) { const float bfar = btab[1023];
#pragma unroll
            for (int r = 0; r < 16; ++r) { const float s2 = st[r] * SC + bfar; st[r] = s2; mloc = fmaxf(mloc, s2); }
            if (!lanevalid) mloc = NEG_S;
        } else if (interior) {
            const LAS float* bp = btab + (t - kp0 - (32 * nt + 4 * half));
#pragma unroll
            for (int rg = 0; rg < 4; ++rg) { float bv[4];
#pragma unroll
                for (int r4 = 0; r4 < 4; ++r4) bv[r4] = *(bp - (8 * rg + r4));
#pragma unroll
                for (int r4 = 0; r4 < 4; ++r4) asm volatile("" : "+v"(bv[r4]));
#pragma unroll
                for (int r4 = 0; r4 < 4; ++r4) { const int r = 4 * rg + r4; const float s2 = st[r] * SC + bv[r4]; st[r] = s2; mloc = fmaxf(mloc, s2); } }
            if (!lanevalid) mloc = NEG_S;
        } else {
            const int key0 = 32 * nt + 4 * half, d0 = t - kp0 - kstride * key0, nvk = lanevalid ? nvalid - key0 : 0;
#pragma unroll
            for (int rg = 0; rg < 2; ++rg) { float bv[8];
#pragma unroll
                for (int r8 = 0; r8 < 8; ++r8) { const int r = 8 * rg + r8; const int cr = (r & 3) + 8 * (r >> 2); const int dist = d0 - kstride * cr; bv[r8] = btab[min(max(dist, 0), 1023)]; }
#pragma unroll
                for (int r8 = 0; r8 < 8; ++r8) asm volatile("" : "+v"(bv[r8]));
#pragma unroll
                for (int r8 = 0; r8 < 8; ++r8) { const int r = 8 * rg + r8; const int cr = (r & 3) + 8 * (r >> 2); const int dist = d0 - kstride * cr;
                    const bool ok = cr < nvk && (unsigned)dist < (unsigned)wlimit;
                    const float s2 = ok ? st[r] * SC + bv[r8] : NEG_S; st[r] = s2; mloc = fmaxf(mloc, s2); } }
        }
        if (MODE == 0) {
            mloc = fmaxf(mloc, __shfl_xor(mloc, 32));
            const float mnew = mloc > m + 8.0f ? mloc : m;
            if (__ballot(mnew != m) != 0ull) { const float alpha = __builtin_amdgcn_exp2f(m - mnew); m = mnew; l *= alpha;
#pragma unroll
                for (int dt = 0; dt < 4; ++dt)
#pragma unroll
                    for (int i = 0; i < 16; ++i) ot[dt][i] *= alpha; }
            float ls = 0.f; const float meff = lanevalid ? m : 3.0e30f;
#pragma unroll
            for (int r = 0; r < 16; ++r) { const float pv = __builtin_amdgcn_exp2f(st[r] - meff); st[r] = pv; ls += pv; }
            l += ls;
#pragma unroll
            for (int s = 0; s < 2; ++s) {
                u32x4 pb; pb.x = pk2(st[8 * s + 0], st[8 * s + 1]); pb.y = pk2(st[8 * s + 2], st[8 * s + 3]); pb.z = pk2(st[8 * s + 4], st[8 * s + 5]); pb.w = pk2(st[8 * s + 6], st[8 * s + 7]);
                const bf16x8 bfrag = __builtin_bit_cast(bf16x8, pb);
                const LAS unsigned char* va = VT + ql * VT_PITCH + (32 * nt + 16 * s + 4 * half) * 2;
                s16x4 lo[4], hi[4];
#pragma unroll
                for (int dt = 0; dt < 4; ++dt) { lo[dt] = *(const LAS s16x4*)(va + 32 * dt * VT_PITCH); hi[dt] = *(const LAS s16x4*)(va + 32 * dt * VT_PITCH + 16); }
#pragma unroll
                for (int dt = 0; dt < 4; ++dt) { const bf16x8 afrag = __builtin_shufflevector(lo[dt], hi[dt], 0, 1, 2, 3, 4, 5, 6, 7); ot[dt] = MFMA32(afrag, bfrag, ot[dt]); }
            }
        } else {
            if (impwrite) {
                const float meff = lanevalid ? m : 3.0e30f;
#pragma unroll
                for (int r = 0; r < 16; r += 2) { const float p0 = __builtin_amdgcn_exp2f(st[r] - meff) * invl, p1 = __builtin_amdgcn_exp2f(st[r + 1] - meff) * invl;
                    imp_row[jbase + 16 * nt + ((r & 3) >> 1) + 4 * (r >> 2) + 2 * half] = p0 + p1; }
            }
        }
    }
}

__device__ __forceinline__ void attn_item(const P& p, Frame& F, const bool is_s, const int b, const int g, const int c) {
    unsigned char* ws = p.ws;
    const bf16* Q = (const bf16*)(ws + WS_Q); const bf16* KVN = (const bf16*)(ws + WS_KVN); const bf16* WINN = (const bf16*)(ws + WS_WINN);
    const bf16* VTS = (const bf16*)(ws + WS_VTS); const bf16* VTW = (const bf16*)(ws + WS_VTW);
    const float* KC = (const float*)(ws + WS_KC); const float* NGt = (const float*)(ws + WS_NG); bf16* YN = (bf16*)(ws + WS_YNSA);
    { int t_ = threadIdx.x; asm volatile("" : "+v"(t_)); F.tid = t_; F.lane = t_ & 63; }
    const int hh = F.wave & 3, qh = F.wave >> 2, ql = F.lane & 31, half = F.lane >> 5, h = 4 * g + hh, iq = 32 * qh + ql;
    const bool qvalid = is_s ? (qh == 0 && ql < 4) : true;
    const int t = is_s ? PAST + ql : 64 * c + iq;
    const int mrow = is_s ? (qvalid ? MP + b * 4 + ql : MP) : b * TP + t;
    const int item8 = (is_s ? 512 + b * 2 + g : (b * 2 + g) * 32 + c) * 8;
#define PKP(var) unsigned char* var; { int l_ = threadIdx.x; asm volatile("" : "+v"(l_)); var = ws + WS_PARK + (size_t)(item8 + (l_ >> 6)) * 8192 + (l_ & 63) * 16; }
    LAS float* BT4 = (LAS float*)(F.lds + A_BT); LAS float* IMP = (LAS float*)(F.lds + A_IMP); LAS unsigned* SELM = (LAS unsigned*)(F.lds + A_SELM);
    LAS int* UL = (LAS int*)(F.lds + A_UL); LAS int* UM = (LAS int*)(F.lds + A_UM); LAS int* NU = (LAS int*)(F.lds + A_NU); LAS int* SELB = (LAS int*)(F.lds + A_SELB);
    __syncthreads();
    { const float* BTg = (const float*)(ws + WS_BTAB) + (size_t)(4 * g) * 1024;
      constexpr int NBT = (4 * BTX + NTHR - 1) / NTHR; float bt_[NBT];
#pragma unroll
      for (int k = 0; k < NBT; ++k) { const int i = F.tid + k * NTHR; const int hq = i / BTX, dd = i - hq * BTX; bt_[k] = i < 4 * BTX ? BTg[hq * 1024 + (dd < 1023 ? dd : 1023)] : 0.f; }
#pragma unroll
      for (int k = 0; k < NBT; ++k) { const int i = F.tid + k * NTHR; if (i < 4 * BTX) BT4[i] = bt_[k] * 1.4426950408889634f; }
      if (F.tid < 64) SELM[F.tid] = 0u; }
    const LAS float* btab = BT4 + hh * BTX;
    bf16x8 qf[8];
#pragma unroll
    for (int ks = 0; ks < 8; ++ks) { u32x4 w = (u32x4){0u, 0u, 0u, 0u}; if (qvalid) w = *(const u32x4*)(Q + (size_t)mrow * 1024 + h * 128 + 16 * ks + 8 * half); qf[ks] = __builtin_bit_cast(bf16x8, w); }
    f32x16 ot[4];
#pragma unroll
    for (int dt = 0; dt < 4; ++dt)
#pragma unroll
        for (int i = 0; i < 16; ++i) ot[dt][i] = 0.f;
    float m = NEG_M, l = 0.f;
    const int HUGE_W = 0x3fffffff;
    const int ncmp = is_s ? 4 : 1;
    const float* kc_k = KC + (size_t)(is_s ? 1024 + (b * 256) * 2 + g : (b * 64) * 2 + g) * 256;
    const float* kc_v = kc_k + (size_t)CMPROWS * 256;
    const int* pt = (const int*)p.in[I_PT] + b * NPAGES; const float* ckv = p.in[I_CKV]; const float* cw = p.in[I_CWIN];
    unsigned selm = 0u; int nu = 0; float invl = 0.f;
#pragma nounroll
    for (int ph = 0; ph < 4; ++ph) {
        if (ph == 1) { const float lt = l + __shfl_xor(l, 32); invl = lt > 0.f ? 1.0f / lt : 0.f; const float sc = NGt[(size_t)mrow * 32 + 0 * 8 + h] * invl;
            if (qvalid) {
                PKP(PK);
#pragma unroll
                for (int dt = 0; dt < 4; ++dt)
#pragma unroll
                    for (int hf = 0; hf < 2; ++hf) { u32x4 w; w.x = pk2(ot[dt][8 * hf + 0] * sc, ot[dt][8 * hf + 1] * sc); w.y = pk2(ot[dt][8 * hf + 2] * sc, ot[dt][8 * hf + 3] * sc);
                        w.z = pk2(ot[dt][8 * hf + 4] * sc, ot[dt][8 * hf + 5] * sc); w.w = pk2(ot[dt][8 * hf + 6] * sc, ot[dt][8 * hf + 7] * sc); *(u32x4*)(PK + (2 * dt + hf) * 1024) = w; } } }
        if (ph == 2) {
            __syncthreads();
            int tid2 = F.tid; asm volatile("" : "+v"(tid2));
            if (!is_s) {
                { const int q = tid2 >> 3, jg = tid2 & 7; const int tq = 64 * c + q;
#pragma unroll
                  for (int jj = 0; jj < 4; ++jj) { const int j = jg * 4 + jj; float v = ((IMP[(0 * 64 + q) * 33 + j] + IMP[(1 * 64 + q) * 33 + j]) + IMP[(2 * 64 + q) * 33 + j]) + IMP[(3 * 64 + q) * 33 + j];
                      if (j == 0 || j == c || j == c - 1) v += 1e4f; if (j * 64 > tq) v = NEGB; IMP[q * 33 + j] = v; } }
                __syncthreads();
                { const int q = tid2 >> 3, jg = tid2 & 7; unsigned bits = 0u;
                  for (int jj = 0; jj < 4; ++jj) { const int j = jg * 4 + jj; const float vj = IMP[q * 33 + j]; int rank = 0;
#pragma nounroll
                      for (int i = 0; i < 32; ++i) { const float vi = IMP[q * 33 + i]; rank += (vi > vj || (vi == vj && i < j)) ? 1 : 0; }
                      if (rank < 16) bits |= 1u << j; }
                  if (bits) atomicOr((unsigned*)&SELM[q], bits); }
                __syncthreads();
                selm = SELM[iq];
            } else {
                for (int i = tid2; i < 4 * 129; i += NTHR) { const int q = i / 129, j = i % 129; float v = 0.f;
                    if (j < 128) v = ((IMP[(0 * 4 + q) * 132 + j] + IMP[(1 * 4 + q) * 132 + j]) + IMP[(2 * 4 + q) * 132 + j]) + IMP[(3 * 4 + q) * 132 + j];
                    if (j == 0 || j == 128 || j == 127) v += 1e4f;
                    SELB[q * 132 + j] = __float_as_int(v); }
                __syncthreads();
                int sel0 = 0, sel1 = 0;
                { const int i = tid2; const int q = i / 129, j = i % 129; const float vj = __int_as_float(SELB[q * 132 + j]); int rank = 0;
                    for (int x = 0; x < 129; ++x) { const float vi = __int_as_float(SELB[q * 132 + x]); rank += (vi > vj || (vi == vj && x < j)) ? 1 : 0; }
                    sel0 = rank < 16 ? 1 : 0; }
                if (tid2 < 4) { const int i = tid2 + NTHR; const int q = i / 129, j = i % 129; const float vj = __int_as_float(SELB[q * 132 + j]); int rank = 0;
                    for (int x = 0; x < 129; ++x) { const float vi = __int_as_float(SELB[q * 132 + x]); rank += (vi > vj || (vi == vj && x < j)) ? 1 : 0; }
                    sel1 = rank < 16 ? 1 : 0; }
                __syncthreads();
                { const int i = tid2; SELB[(i / 129) * 132 + i % 129] = sel0; }
                if (tid2 < 4) { const int i = tid2 + NTHR; SELB[(i / 129) * 132 + i % 129] = sel1; }
                __syncthreads();
                if (tid2 == 0) { int n = 0; for (int j = 0; j < 129; ++j) { const int msk = SELB[j] | (SELB[132 + j] << 1) | (SELB[264 + j] << 2) | (SELB[396 + j] << 3); if (msk) { UL[n] = j; UM[n] = msk; ++n; } } NU[0] = n; }
                __syncthreads();
                nu = NU[0];
            }
        }
        if (ph >= 2) {
            if (ph == 3) { const float lt = l + __shfl_xor(l, 32); const float sc = lt > 0.f ? NGt[(size_t)mrow * 32 + 1 * 8 + h] / lt : 0.f;
                if (qvalid) { PKP(PK);
#pragma unroll
                    for (int dt = 0; dt < 4; ++dt)
#pragma unroll
                        for (int hf = 0; hf < 2; ++hf) { u32x4* yp = (u32x4*)(PK + (2 * dt + hf) * 1024); const u32x4 o = *yp; u32x4 w;
                            w.x = pk2(bflo(o.x) + ot[dt][8 * hf + 0] * sc, bfhi(o.x) + ot[dt][8 * hf + 1] * sc); w.y = pk2(bflo(o.y) + ot[dt][8 * hf + 2] * sc, bfhi(o.y) + ot[dt][8 * hf + 3] * sc);
                            w.z = pk2(bflo(o.z) + ot[dt][8 * hf + 4] * sc, bfhi(o.z) + ot[dt][8 * hf + 5] * sc); w.w = pk2(bflo(o.w) + ot[dt][8 * hf + 6] * sc, bfhi(o.w) + ot[dt][8 * hf + 7] * sc); *yp = w; } } }
#pragma unroll
            for (int dt = 0; dt < 4; ++dt)
#pragma unroll
                for (int i = 0; i < 16; ++i) ot[dt][i] = 0.f;
            m = NEG_M; l = 0.f;
        }
        const int ntiles = ph < 2 ? ncmp : (ph == 2 ? (is_s ? nu : c + 1) : (is_s ? 9 : (c >= 8 ? 9 : c + 1)));
        const int t_lo = t - ql;
        TileRegs tr;
#pragma nounroll
        for (int i = 0; i < ntiles; ++i) {
            const void* kp; const void* vp; int pitch, nvalid = 64, kp0, kstride = 1, wl = HUGE_W, mode = 2; bool lv = qvalid;
            if (ph < 2) { kp = kc_k + (size_t)(64 * i) * 512; vp = kc_v + (size_t)(64 * i) * 512; pitch = 512; mode = 1; kp0 = 2048 * i + 31; kstride = 32; }
            else if (ph == 2) {
                if (!is_s) { kp = KVN + (size_t)(b * TP + 64 * i) * 1024 + 2 * 256 + g * 128; vp = VTS + ((size_t)((b * 2 + g) * 32 + i) * 128) * 64; pitch = 1024; kp0 = 64 * i; lv = ((selm >> i) & 1u) != 0u; mode = 0; }
                else { const int j = UL[i], msk = UM[i]; kp0 = 64 * j; pitch = 1024; lv = qvalid && ((msk >> (ql & 3)) & 1);
                    if (j < 128) { const int page = pt[j >> 1]; const float* kb = ckv + ((size_t)(page * PAGE + (j & 1) * 64) * 4 + 2) * 256 + g * 128; kp = kb; vp = kb + 256; mode = 1; }
                    else { const bf16* kb = KVN + (size_t)(MP + b * 4) * 1024 + 2 * 256 + g * 128; kp = kb; vp = kb + 256; nvalid = 4; } }
            } else { wl = 512; pitch = 512;
                if (!is_s) { const int j = (c >= 8 ? c - 8 : 0) + i; kp = WINN + (size_t)(b * TP + 64 * j) * 512 + g * 128; vp = VTW + ((size_t)((b * 2 + g) * 32 + j) * 128) * 64; kp0 = 64 * j; mode = 0; }
                else { kp0 = PAST - 512 + 64 * i;
                    if (i < 8) { const float* kb = cw + ((size_t)(b * 512 + 64 * i) * 2) * 256 + g * 128; kp = kb; vp = kb + 256; mode = 1; }
                    else { const bf16* kb = WINN + (size_t)(MP + b * 4) * 512 + g * 128; kp = kb; vp = kb + 256; nvalid = 4; } }
            }
            int tid = F.tid; asm volatile("" : "+v"(tid));
            const bool loader = is_s && tid >= 256;
            const int boff = (is_s || mode == 0) ? (i & 1) * A_BUF2 : 0;
            if (is_s) {
                if (i == 0) { __syncthreads(); if (loader) loader_stage(F, kp, vp, pitch, mode == 1, nvalid, tid - 256, 0); }
                __syncthreads();
                if (loader && i + 1 < ntiles) { const void* kp1; const void* vp1; int pitch1, nv1; bool f1; SAMPLE_TILE(i + 1, kp1, vp1, pitch1, f1, nv1); loader_stage(F, kp1, vp1, pitch1, f1, nv1, tid - 256, ((i + 1) & 1) * A_BUF2); }
            } else if (mode == 0) {
                if (i == 0) { __syncthreads(); tile_load(tr, (const bf16*)kp, (const bf16*)vp, pitch, tid); tile_store(F, tr, tid, 0); if (ntiles > 1) tile_load(tr, (const bf16*)kp + (size_t)64 * pitch, (const bf16*)vp + 128 * 64, pitch, tid); }
                __syncthreads();
                if (i + 1 < ntiles) { tile_store(F, tr, tid, ((i + 1) & 1) * A_BUF2); if (i + 2 < ntiles) tile_load(tr, (const bf16*)kp + (size_t)128 * pitch, (const bf16*)vp + 2 * 128 * 64, pitch, tid); }
            } else if (!(ph == 1 && !is_s)) {
                __syncthreads();
                stage_tile(F, kp, vp, pitch, mode == 1, nvalid);
                __syncthreads();
            }
            const bool far = nvalid == 64 && kstride == 1 && (t_lo - (kp0 + 63) >= 1023) && (t_lo + 31 - kp0 < wl);
            const bool interior = !is_s && nvalid == 64 && kstride == 1 && (kp0 + 63 <= t_lo) && (t_lo + 31 - kp0 < wl);
            if (loader) continue;
            if (ph == 1) { LAS float* imp_row = IMP + (is_s ? (hh * 4 + (ql & 3)) * 132 : (hh * 64 + iq) * 33); tile_compute<1>(F, boff, btab, qf, t, lv, kp0, kstride, nvalid, wl, far, interior, m, l, ot, invl, imp_row, 32 * i, qvalid); }
            else tile_compute<0>(F, boff, btab, qf, t, lv, kp0, kstride, nvalid, wl, far, interior, m, l, ot, 0.f, nullptr, 0, false);
        }
    }
    { const float lt = l + __shfl_xor(l, 32); const float sc = lt > 0.f ? NGt[(size_t)mrow * 32 + 2 * 8 + h] / lt : 0.f;
      if (qvalid) { PKP(PK);
#pragma unroll
          for (int dt = 0; dt < 4; ++dt)
#pragma unroll
              for (int hf = 0; hf < 2; ++hf) { const u32x4 o4 = *(const u32x4*)(PK + (2 * dt + hf) * 1024);
#pragma unroll
                  for (int rr = 0; rr < 2; ++rr) { const int r4 = 2 * hf + rr; const int d0 = 32 * dt + 8 * r4 + 4 * half; const u32x2 o = rr ? (u32x2){o4.z, o4.w} : (u32x2){o4.x, o4.y};
                      u32x2 w; w.x = pk2(bflo(o.x) + ot[dt][4 * r4 + 0] * sc, bfhi(o.x) + ot[dt][4 * r4 + 1] * sc); w.y = pk2(bflo(o.y) + ot[dt][4 * r4 + 2] * sc, bfhi(o.y) + ot[dt][4 * r4 + 3] * sc);
                      *(u32x2*)(YN + (size_t)mrow * 1024 + h * 128 + d0) = w; } } } }
}

#undef PKP
__device__ __forceinline__ void vt_build(const P& p, Frame& F, int wg, int nwg) {
    const bf16* KVN = (const bf16*)(p.ws + WS_KVN); const bf16* WINN = (const bf16*)(p.ws + WS_WINN);
    const int gw = wg * NWAVES + F.wave, NGW = nwg * NWAVES, key = F.lane;
    for (int it = gw; it < 2 * 512 * 8; it += NGW) { const int which = it >> 12, blkid = (it >> 3) & 511, dc = it & 7;
        const int b = blkid >> 6, g = (blkid >> 5) & 1, blk = blkid & 31; const int row = b * TP + 64 * blk + key;
        const bf16* src = which == 0 ? KVN + (size_t)row * 1024 + 3 * 256 + g * 128 + dc * 16 : WINN + (size_t)row * 512 + 256 + g * 128 + dc * 16;
        const u32x4 o0 = *(const u32x4*)src, o1 = *(const u32x4*)(src + 8);
        bf16* dst = (bf16*)(p.ws + (which == 0 ? WS_VTS : WS_VTW)) + ((size_t)blkid * 128 + dc * 16) * 64 + key;
        const unsigned w[8] = {o0.x, o0.y, o0.z, o0.w, o1.x, o1.y, o1.z, o1.w};
#pragma unroll
        for (int i = 0; i < 8; ++i) { dst[(2 * i) * 64] = (bf16)(w[i] & 0xffffu); dst[(2 * i + 1) * 64] = (bf16)(w[i] >> 16); } }
}
__device__ __forceinline__ float prw_prev(const P& p, const bf16* PRW, int m, int col) {
    if (m < MP) { return (m & (TP - 1)) == 0 ? 0.f : bf2f(PRW[(size_t)(m - 1) * RWP + col]); }
    const int x = m - MP; return (x & 3) == 0 ? p.in[I_SSH][(size_t)(x >> 2) * RWP + col] : bf2f(PRW[(size_t)(m - 1) * RWP + col]);
}
__device__ __forceinline__ void lora_prep(const P& p, Frame& F) {
    const bf16* PRW = (const bf16*)(p.ws + WS_PRW); bf16* AL = (bf16*)(p.ws + WS_ALORA); const float* mu = p.in[I_MU];
    const int gt = F.bid * NTHR + F.tid, NGT = F.G * NTHR;
    for (int i = gt; i < MPAD * 256; i += NGT) { const int m = i >> 8, k = i & 255; float v = 0.f;
        if (m < MT) { const int col = 3072 + k; const float pc = bf2f(PRW[(size_t)m * RWP + col]), pp = prw_prev(p, PRW, m, col); const float xs = pc + (pp - pc) * mu[col];
            v = k < 64 ? 1.0f - 2.0f / (1.0f + __expf(2.0f * xs)) : (k < 128 ? xs : sigmoidf_(xs)); }
        AL[i] = (bf16)(pk2(v, 0.f) & 0xffffu); }
}
__device__ __forceinline__ void acmp_build(const P& p, Frame& F) {
    const bf16* KVN = (const bf16*)(p.ws + WS_KVN); bf16* AC = (bf16*)(p.ws + WS_ACMP); const float* pe = p.in[I_PE]; const float* ckv = p.in[I_CKV]; const int* pt = (const int*)p.in[I_PT];
    const int gw = F.bid * NWAVES + F.wave, NGW = F.G * NWAVES, lane = F.lane;
    const int ph = lane >> 4, d = (lane & 15) * 8;
    for (int it = gw; it < 2 * CMPROWS; it += NGW) { const int kv = it / CMPROWS, R = it % CMPROWS; bf16* dst = AC + (size_t)it * 4096;
        if (R < 1024) { const int b = R >> 7, n = (R >> 1) & 63, g = R & 1;
#pragma unroll
            for (int pp = 0; pp < 32; pp += 4) { const int pos = pp + ph; const u32x4 w = *(const u32x4*)(KVN + (size_t)(b * TP + n * 32 + pos) * 1024 + kv * 256 + g * 128 + d);
                const f32x4 e0 = *(const f32x4*)(pe + (pos * 2 + kv) * 128 + d), e1 = *(const f32x4*)(pe + (pos * 2 + kv) * 128 + d + 4);
                *(u32x4*)(dst + pos * 128 + d) = pack8((f32x4){bflo(w.x), bfhi(w.x), bflo(w.y), bfhi(w.y)} + e0, (f32x4){bflo(w.z), bfhi(w.z), bflo(w.w), bfhi(w.w)} + e1); } }
        else { const int Rs = R - 1024, b = Rs >> 9, n = (Rs >> 1) & 255, g = Rs & 1; const int page = pt[b * NPAGES + (n >> 2)];
            const float* src = ckv + ((size_t)(page * PAGE + (n & 3) * 32) * 4 + kv) * 256 + g * 128 + d;
            f32x4 x0[8], x1[8];
#pragma unroll
            for (int i = 0; i < 8; ++i) { const int pos = 4 * i + ph; x0[i] = *(const f32x4*)(src + (size_t)pos * 1024); x1[i] = *(const f32x4*)(src + (size_t)pos * 1024 + 4); }
#pragma unroll
            for (int i = 0; i < 8; ++i) { const int pos = 4 * i + ph; const f32x4 e0 = *(const f32x4*)(pe + (pos * 2 + kv) * 128 + d), e1 = *(const f32x4*)(pe + (pos * 2 + kv) * 128 + d + 4);
                *(u32x4*)(dst + pos * 128 + d) = pack8(x0[i] + e0, x1[i] + e1); } }
    }
}
__device__ __forceinline__ float red16(float x) {
    x += __builtin_bit_cast(float, __builtin_amdgcn_update_dpp(0, __builtin_bit_cast(int, x), 0xB1, 0xF, 0xF, true));
    x += __builtin_bit_cast(float, __builtin_amdgcn_update_dpp(0, __builtin_bit_cast(int, x), 0x4E, 0xF, 0xF, true));
    x += __builtin_bit_cast(float, __builtin_amdgcn_update_dpp(0, __builtin_bit_cast(int, x), 0x141, 0xF, 0xF, true));
    x += __builtin_bit_cast(float, __builtin_amdgcn_update_dpp(0, __builtin_bit_cast(int, x), 0x140, 0xF, 0xF, true));
    return x;
}
__device__ __forceinline__ f32x4 bf4(const u32x2 w) { return (f32x4){bflo(w.x), bfhi(w.x), bflo(w.y), bfhi(w.y)}; }
__device__ __forceinline__ void scan_prep(const P& p, Frame& F) {
    const bf16* PRW = (const bf16*)(p.ws + WS_PRW); const float* AA = (const float*)(p.ws + WS_AA); const float* DEC = (const float*)(p.ws + WS_DEC);
    bf16* OPSB = (bf16*)(p.ws + WS_OPS); float* WQ = (float*)(p.ws + WS_WQ); bf16* VVB = (bf16*)(p.ws + WS_VV); float* CB = (float*)(p.ws + WS_CB); const float* mu = p.in[I_MU];
    const int gw = F.bid * NWAVES + F.wave, NGW = F.G * NWAVES, q = F.lane >> 4, c = F.lane & 15;
    for (int it = MP * 4 + gw; it < MT * 4; it += NGW) { const int m = it >> 2, h = 4 * (it & 3) + q, c0 = h * 64 + 4 * c;
        const bool first = m < MP ? (m & (TP - 1)) == 0 : ((m - MP) & 3) == 0;
        f32x4 pc[3], pp[3];
#pragma unroll
        for (int x = 0; x < 3; ++x) { const int col = x * 1024 + c0; pc[x] = bf4(*(const u32x2*)(PRW + (size_t)m * RWP + col));
            if (!first) pp[x] = bf4(*(const u32x2*)(PRW + (size_t)(m - 1) * RWP + col));
            else if (m < MP) pp[x] = (f32x4){0.f, 0.f, 0.f, 0.f};
            else pp[x] = *(const f32x4*)(p.in[I_SSH] + (size_t)((m - MP) >> 2) * RWP + col); }
        const f32x4 a = *(const f32x4*)(AA + (size_t)m * 1024 + c0), w = *(const f32x4*)(DEC + (size_t)m * 1024 + c0);
        f32x4 xs[3];
#pragma unroll
        for (int x = 0; x < 3; ++x) xs[x] = pc[x] + (pp[x] - pc[x]) * *(const f32x4*)(mu + x * 1024 + c0);
        const f32x4 kmod = xs[1] * (1.0f + (a - 1.0f) * *(const f32x4*)(p.in[I_KA] + c0)); const f32x4 kkr = xs[1] * *(const f32x4*)(p.in[I_KK] + c0);
        const float nrm = sqrtf(red16((kkr.x * kkr.x + kkr.y * kkr.y) + (kkr.z * kkr.z + kkr.w * kkr.w))); const f32x4 kk = kkr * (1.0f / fmaxf(nrm, 1e-12f));
        const f32x4 rk = *(const f32x4*)(p.in[I_RK] + c0); const f32x4 t3 = xs[0] * kmod * rk; const float cb = red16((t3.x + t3.y) + (t3.z + t3.w));
        size_t sr; if (m < MP) sr = (size_t)((m >> 11) * RWH + h) * TP + (m & (TP - 1)); else { const int x = m - MP; sr = (size_t)NSEQ_P * TP + (size_t)((x >> 2) * RWH + h) * TS + (x & 3); }
        bf16* o = OPSB + sr * 256 + 4 * c;
        { const f32x4 na = -(kk * a); u32x2 u; u.x = pk2(kk.x, kk.y); u.y = pk2(kk.z, kk.w); *(u32x2*)o = u; u.x = pk2(na.x, na.y); u.y = pk2(na.z, na.w); *(u32x2*)(o + 64) = u;
          u.x = pk2(kmod.x, kmod.y); u.y = pk2(kmod.z, kmod.w); *(u32x2*)(o + 128) = u; u.x = pk2(xs[0].x, xs[0].y); u.y = pk2(xs[0].z, xs[0].w); *(u32x2*)(o + 192) = u;
          u.x = pk2(xs[2].x, xs[2].y); u.y = pk2(xs[2].z, xs[2].w); *(u32x2*)(VVB + sr * 64 + 4 * c) = u; }
        *(f32x4*)(WQ + sr * 64 + 4 * c) = w;
        if (c == 0) CB[(size_t)m * 16 + h] = cb; }
}
__device__ __forceinline__ float red8(float x) {
    x += __builtin_bit_cast(float, __builtin_amdgcn_update_dpp(0, __builtin_bit_cast(int, x), 0xB1, 0xF, 0xF, true));
    x += __builtin_bit_cast(float, __builtin_amdgcn_update_dpp(0, __builtin_bit_cast(int, x), 0x4E, 0xF, 0xF, true));
    x += __builtin_bit_cast(float, __builtin_amdgcn_update_dpp(0, __builtin_bit_cast(int, x), 0x141, 0xF, 0xF, true));
    return x;
}
constexpr int S_OPL = 0, S_VL = 81920, S_YL = 98304;
__device__ __forceinline__ void scan_half(const P& p, Frame& F, size_t sr0, int T, const float* S0, float* Sout, int m0, int h, int hf) {
    const bf16* OPSB = (const bf16*)(p.ws + WS_OPS); const float* WQ = (const float*)(p.ws + WS_WQ); const bf16* VVB = (const bf16*)(p.ws + WS_VV); bf16* YRAW = (bf16*)(p.ws + WS_YRAW);
    const int lane = F.lane, wave = F.wave, tid = F.tid, r = lane >> 4, c = lane & 15, rowl = 4 * wave + r, row = 32 * hf + rowl;
    f32x2 S2[2];
#pragma unroll
    for (int j = 0; j < 2; ++j) S2[j] = S0 ? *(const f32x2*)(S0 + row * 64 + 4 * c + 2 * j) : (f32x2){0.f, 0.f};
    const int nch = (T + 31) >> 5;
    u32x4 pb0, pb1; f32x4 pw; u32x2 pv;
    const int stt = tid >> 4, sq = (tid & 15) >> 2, scol = (tid & 3) * 16;
    const int lo_ = stt * 320 + (sq == 0 ? 0 : sq + 1) * 64 + scol, lw_ = stt * 320 + 64 + (tid & 15) * 4, lv_ = stt * 64 + (tid & 15) * 4;
#define SCAN_FETCH(srow) do { const char* so_ = (const char*)(OPSB + (srow) * 256); pb0 = *(const u32x4*)(so_ + (size_t)tid * 32); pb1 = *(const u32x4*)(so_ + (size_t)tid * 32 + 16); \
        pw = *(const f32x4*)((const char*)(WQ + (srow) * 64) + (size_t)tid * 16); pv = *(const u32x2*)((const char*)(VVB + (srow) * 64) + (size_t)tid * 8); } while (0)
#define SCAN_PUT(bufi) do { LAS float* d_ = (LAS float*)(F.lds + S_OPL + (bufi) * 40960); \
        *(LAS f32x4*)(d_ + lo_) = (f32x4){bflo(pb0.x), bfhi(pb0.x), bflo(pb0.y), bfhi(pb0.y)}; *(LAS f32x4*)(d_ + lo_ + 4) = (f32x4){bflo(pb0.z), bfhi(pb0.z), bflo(pb0.w), bfhi(pb0.w)}; \
        *(LAS f32x4*)(d_ + lo_ + 8) = (f32x4){bflo(pb1.x), bfhi(pb1.x), bflo(pb1.y), bfhi(pb1.y)}; *(LAS f32x4*)(d_ + lo_ + 12) = (f32x4){bflo(pb1.z), bfhi(pb1.z), bflo(pb1.w), bfhi(pb1.w)}; \
        *(LAS f32x4*)(d_ + lw_) = pw; *(LAS f32x4*)((LAS float*)(F.lds + S_VL + (bufi) * 8192) + lv_) = (f32x4){bflo(pv.x), bfhi(pv.x), bflo(pv.y), bfhi(pv.y)}; } while (0)
    SCAN_FETCH(sr0);
    __syncthreads();
    SCAN_PUT(0);
    __syncthreads();
    for (int k = 0; k < nch; ++k) {
        const int buf = k & 1, t0 = k * 32, ns = (T - t0) < 32 ? (T - t0) : 32;
        if (k + 1 < nch) SCAN_FETCH(sr0 + t0 + 32);
        const LAS float* opl = (const LAS float*)(F.lds + S_OPL + buf * 40960) + c * 4;
        const LAS float* vl = (const LAS float*)(F.lds + S_VL + buf * 8192) + row;
        LAS float* yl = (LAS float*)(F.lds + S_YL + buf * 4096) + rowl;
#define SCAN_LOAD(o, v, tt) do { const LAS f32x4* o4_ = (const LAS f32x4*)(opl + (tt) * 320); _Pragma("unroll") for (int q_ = 0; q_ < 5; ++q_) o[q_] = o4_[16 * q_]; v = vl[(tt) * 64]; } while (0)
#define SCAN_STEP(o, v, tt) do { \
            f32x2 acc_ = S2[0] * (f32x2){o[0].x, o[0].y}; acc_ = S2[1] * (f32x2){o[0].z, o[0].w} + acc_; \
            const float sk_ = red16(acc_.x + acc_.y); const f32x2 sk2_ = (f32x2){sk_, sk_}, v2_ = (f32x2){v, v}; \
            S2[0] = S2[0] * (f32x2){o[1].x, o[1].y} + (sk2_ * (f32x2){o[2].x, o[2].y} + v2_ * (f32x2){o[3].x, o[3].y}); \
            S2[1] = S2[1] * (f32x2){o[1].z, o[1].w} + (sk2_ * (f32x2){o[2].z, o[2].w} + v2_ * (f32x2){o[3].z, o[3].w}); \
            f32x2 ya_ = S2[0] * (f32x2){o[4].x, o[4].y}; ya_ = S2[1] * (f32x2){o[4].z, o[4].w} + ya_; \
            const float y_ = red16(ya_.x + ya_.y); if (c == 0) yl[(tt) * 32] = y_; } while (0)
        { f32x4 oa[5], ob[5]; float va, vb;
          SCAN_LOAD(oa, va, 0);
          int tt = 0;
          for (; tt + 1 < ns; tt += 2) {
              SCAN_LOAD(ob, vb, tt + 1);
              SCAN_STEP(oa, va, tt);
              if (tt + 2 < ns) SCAN_LOAD(oa, va, tt + 2);
              SCAN_STEP(ob, vb, tt + 1);
          }
          if (tt < ns) SCAN_STEP(oa, va, tt);
        }
#undef SCAN_LOAD
#undef SCAN_STEP
        __syncthreads();
        { const int tt = tid >> 4, rl = (tid & 15) * 2;
          if (tt < ns) { const LAS float* ys = (const LAS float*)(F.lds + S_YL + buf * 4096) + tt * 32 + rl;
              *(unsigned*)(YRAW + (size_t)(m0 + t0 + tt) * 1024 + h * 64 + 32 * hf + rl) = pk2(ys[0], ys[1]); } }
        if (k + 1 < nch) SCAN_PUT(buf ^ 1);
        __syncthreads();
    }
#pragma unroll
    for (int j = 0; j < 2; ++j) *(f32x2*)(Sout + row * 64 + 4 * c + 2 * j) = S2[j];
#undef SCAN_FETCH
#undef SCAN_PUT
}
__device__ __forceinline__ void scan_sample(const P& p, Frame& F, int wg, int nwg) {
    for (int task = wg; task < 2 * NSEQ_S; task += nwg) { const int s = task >> 1, hf = task & 1;
        scan_half(p, F, (size_t)NSEQ_P * TP + (size_t)s * TS, TS, p.in[I_SRW] + (size_t)s * 4096, p.out + O_RS + (size_t)s * 4096, MP + (s >> 4) * TS, s & 15, hf); }
}
__device__ __forceinline__ void rwkv_post(const P& p, Frame& F) {
    const bf16* YRAW = (const bf16*)(p.ws + WS_YRAW); const bf16* VVB = (const bf16*)(p.ws + WS_VV); const float* CB = (const float*)(p.ws + WS_CB); const bf16* GG = (const bf16*)(p.ws + WS_GG);
    bf16* YRW = (bf16*)(p.ws + WS_YRW);
    const int gw = F.bid * NWAVES + F.wave, NGW = F.G * NWAVES, q = F.lane >> 4, c = F.lane & 15;
    for (int it = gw; it < MT * 4; it += NGW) { const int m = it >> 2, h = 4 * (it & 3) + q, c0 = h * 64 + 4 * c;
        size_t sr; if (m < MP) sr = (size_t)((m >> 11) * RWH + h) * TP + (m & (TP - 1)); else { const int x = m - MP; sr = (size_t)NSEQ_P * TP + (size_t)((x >> 2) * RWH + h) * TS + (x & 3); }
        const f32x4 y = bf4(*(const u32x2*)(YRAW + (size_t)m * 1024 + c0)), vv = bf4(*(const u32x2*)(VVB + sr * 64 + 4 * c)), g = bf4(*(const u32x2*)(GG + (size_t)m * 1024 + c0));
        const float cb = CB[(size_t)m * 16 + h];
        const float mean = red16((y.x + y.y) + (y.z + y.w)) * (1.0f / 64.0f); const f32x4 dd = y - mean;
        const float var = red16((dd.x * dd.x + dd.y * dd.y) + (dd.z * dd.z + dd.w * dd.w)) * (1.0f / 64.0f);
        const f32x4 yn = dd * (1.0f / sqrtf(var + RW_LN_EPS)) * *(const f32x4*)(p.in[I_LNW] + c0) + *(const f32x4*)(p.in[I_LNB] + c0);
        const f32x4 o = (yn + vv * cb) * g;
        u32x2 w; w.x = pk2(o.x, o.y); w.y = pk2(o.z, o.w); *(u32x2*)(YRW + (size_t)m * 1024 + c0) = w; }
}
constexpr int CK_SLOT = 8192, CK_GC = 16 * CK_SLOT, CK_PAR = CK_GC + 256 + 2048;
constexpr size_t CK_TASK_BYTES = 4 * 8192;
__device__ __forceinline__ int ck_crow(int r, int half) { return (r & 3) + 8 * (r >> 2) + 4 * half; }
__device__ __forceinline__ f32x16 ck_zero() { f32x16 z;
#pragma unroll
    for (int i = 0; i < 16; ++i) z[i] = 0.f;
    return z; }
__device__ __forceinline__ f32x16 ck_mm(const LAS unsigned char* A, const LAS unsigned char* BT, int mt, int nt, int ql, int half, f32x16 acc) {
    const LAS unsigned char* ar = A + (32 * mt + ql) * 128; const LAS unsigned char* br = BT + (32 * nt + ql) * 128; const int sw = ql & 7;
    f32x16 acc2 = ck_zero();
#pragma unroll
    for (int ks = 0; ks < 4; ++ks) { const int off = ((2 * ks + half) ^ sw) << 4; const bf16x8 a = *(const LAS bf16x8*)(ar + off), b = *(const LAS bf16x8*)(br + off); if (ks & 1) acc2 = MFMA32(a, b, acc2); else acc = MFMA32(a, b, acc); }
#pragma unroll
    for (int i = 0; i < 16; ++i) acc[i] += acc2[i];
    return acc;
}
__device__ __forceinline__ void ck_store_t(LAS unsigned char* IMG, const f32x16& v, int mt, int nt, int ql, int half) {
    const int n = 32 * nt + ql; LAS unsigned char* row = IMG + n * 128;
#pragma unroll
    for (int g = 0; g < 4; ++g) { const int m0 = 32 * mt + 8 * g + 4 * half; u32x2 w; w.x = pk2(v[4 * g], v[4 * g + 1]); w.y = pk2(v[4 * g + 2], v[4 * g + 3]);
        *(LAS u32x2*)(row + (((m0 >> 3) ^ (n & 7)) << 4) + (m0 & 4) * 2) = w; }
}
__device__ __forceinline__ void ck_store_n(LAS unsigned char* IMG, const f32x16& v, int mt, int nt, int ql, int half) {
    const int n = 32 * nt + ql;
#pragma unroll
    for (int r = 0; r < 16; ++r) { const int m = 32 * mt + ck_crow(r, half);
        *(LAS unsigned short*)(IMG + m * 128 + (((n >> 3) ^ (m & 7)) << 4) + (n & 7) * 2) = (unsigned short)(pk2(v[r], 0.f) & 0xffffu); }
}
__device__ __forceinline__ void ck_tr(const LAS unsigned char* SRC, LAS unsigned char* DST, int mt, int nt, int ql, int half) {
    const LAS unsigned char* ar = SRC + (32 * mt + ql) * 128; const int sw = ql & 7;
    f32x16 acc = ck_zero();
#pragma unroll
    for (int d = 0; d < 2; ++d) { const int ks = 2 * nt + d, off = ((2 * ks + half) ^ sw) << 4; const bf16x8 a = *(const LAS bf16x8*)(ar + off);
        const int e = ql - 16 * d - 8 * half; const unsigned val = (e & 1) ? 0x3F800000u : 0x00003F80u; const int w = (e >= 0 && e < 8) ? (e >> 1) : -1;
        const u32x4 bw = (u32x4){w == 0 ? val : 0u, w == 1 ? val : 0u, w == 2 ? val : 0u, w == 3 ? val : 0u};
        acc = MFMA32(a, __builtin_bit_cast(bf16x8, bw), acc); }
    ck_store_t(DST, acc, mt, nt, ql, half);
}
#define CKIN_DECL(PFX) u32x4 PFX##cr, PFX##ck, PFX##cv, PFX##pr, PFX##pk, PFX##pv; f32x4 PFX##a0, PFX##a1, PFX##w0, PFX##w1
#define CKIN_LOAD(PFX, task_) do { const int s_ = (task_) >> 5, c_ = (task_) & 31, b_ = s_ >> 4, h_ = s_ & 15, tid_ = threadIdx.x, t_ = tid_ >> 3, jg_ = tid_ & 7, m_ = b_ * TP + 64 * c_ + t_, c0_ = h_ * 64 + 8 * jg_; \
    const bf16* PRW_ = (const bf16*)(p.ws + WS_PRW); const float* AA_ = (const float*)(p.ws + WS_AA); const float* DEC_ = (const float*)(p.ws + WS_DEC); \
    PFX##cr = *(const u32x4*)(PRW_ + (size_t)m_ * RWP + c0_); PFX##ck = *(const u32x4*)(PRW_ + (size_t)m_ * RWP + 1024 + c0_); PFX##cv = *(const u32x4*)(PRW_ + (size_t)m_ * RWP + 2048 + c0_); \
    const int mp_ = (c_ == 0 && t_ == 0) ? m_ : m_ - 1;     \
    PFX##pr = *(const u32x4*)(PRW_ + (size_t)mp_ * RWP + c0_); PFX##pk = *(const u32x4*)(PRW_ + (size_t)mp_ * RWP + 1024 + c0_); PFX##pv = *(const u32x4*)(PRW_ + (size_t)mp_ * RWP + 2048 + c0_); \
    PFX##a0 = *(const f32x4*)(AA_ + (size_t)m_ * 1024 + c0_); PFX##a1 = *(const f32x4*)(AA_ + (size_t)m_ * 1024 + c0_ + 4); PFX##w0 = *(const f32x4*)(DEC_ + (size_t)m_ * 1024 + c0_); PFX##w1 = *(const f32x4*)(DEC_ + (size_t)m_ * 1024 + c0_ + 4); } while (0)
__device__ __forceinline__ void chunk_pre(const P& p, Frame& F, int task, int next_task, u32x4& icr, u32x4& ick, u32x4& icv, u32x4& ipr, u32x4& ipk, u32x4& ipv, f32x4& ia0, f32x4& ia1, f32x4& iw0, f32x4& iw1, int& ptag0, int& ptag1) {
    const int s = task >> 5, c = task & 31, b = s >> 4, h = s & 15, mbase = b * TP + 64 * c;
    const bf16* PRW = (const bf16*)(p.ws + WS_PRW); const float* AA = (const float*)(p.ws + WS_AA); const float* DEC = (const float*)(p.ws + WS_DEC);
    bf16* VVB = (bf16*)(p.ws + WS_VV); float* CB = (float*)(p.ws + WS_CB);
    unsigned char* outp = p.ws + WS_CHK + (size_t)task * CK_TASK_BYTES;
    int tid = threadIdx.x; asm volatile("" : "+v"(tid));
    const int lane = tid & 63, wave = __builtin_amdgcn_readfirstlane(tid >> 6), ql = lane & 31, half = lane >> 5, grp = wave >> 2, mt = (wave >> 1) & 1, nt = wave & 1;
    LAS unsigned char* L = F.lds;
#define SLOT(k) (L + (k) * CK_SLOT)
    LAS float* GC = (LAS float*)(L + CK_GC);
    { const int slot_ = (h >> 3) & 1;
      if ((slot_ ? ptag1 : ptag0) != h) {
          if (tid < 384) { const int vec = tid >> 6, j = tid & 63;
              const float* src = vec < 3 ? p.in[I_MU] + vec * 1024 : vec == 3 ? p.in[I_KA] : vec == 4 ? p.in[I_KK] : p.in[I_RK];
              ((LAS float*)(L + CK_PAR))[slot_ * 384 + tid] = src[h * 64 + j]; }
          if (slot_) ptag1 = h; else ptag0 = h;
          __syncthreads(); } }
    { const int t = tid >> 3, jg = tid & 7, tl = t & 7, m = mbase + t; const bool first = (c == 0 && t == 0);
      const LAS float* PR = (const LAS float*)(L + CK_PAR) + ((h >> 3) & 1) * 384 + 8 * jg;
      float xr[8], xk[8], xv[8], av[8], wv[8];
      { const u32x4 cr = icr, ck = ick, cv = icv; u32x4 pr = ipr, pk = ipk, pv = ipv; if (first) { pr = (u32x4){0u, 0u, 0u, 0u}; pk = pr; pv = pr; }
        const unsigned cw[3][4] = {{cr.x, cr.y, cr.z, cr.w}, {ck.x, ck.y, ck.z, ck.w}, {cv.x, cv.y, cv.z, cv.w}}, pw[3][4] = {{pr.x, pr.y, pr.z, pr.w}, {pk.x, pk.y, pk.z, pk.w}, {pv.x, pv.y, pv.z, pv.w}};
        float mr[8], mk[8], mv[8];
        { const f32x4 a0 = *(const LAS f32x4*)(PR), a1 = *(const LAS f32x4*)(PR + 4), b0 = *(const LAS f32x4*)(PR + 64), b1 = *(const LAS f32x4*)(PR + 68), d0 = *(const LAS f32x4*)(PR + 128), d1 = *(const LAS f32x4*)(PR + 132);
#pragma unroll
          for (int e = 0; e < 4; ++e) { mr[e] = a0[e]; mr[4 + e] = a1[e]; mk[e] = b0[e]; mk[4 + e] = b1[e]; mv[e] = d0[e]; mv[4 + e] = d1[e]; } }
#pragma unroll
        for (int e = 0; e < 8; ++e) { const int wi = e >> 1; const bool hi = e & 1;
            const float c_r = hi ? bfhi(cw[0][wi]) : bflo(cw[0][wi]), c_k = hi ? bfhi(cw[1][wi]) : bflo(cw[1][wi]), c_v = hi ? bfhi(cw[2][wi]) : bflo(cw[2][wi]);
            const float p_r = hi ? bfhi(pw[0][wi]) : bflo(pw[0][wi]), p_k = hi ? bfhi(pw[1][wi]) : bflo(pw[1][wi]), p_v = hi ? bfhi(pw[2][wi]) : bflo(pw[2][wi]);
            xr[e] = c_r + (p_r - c_r) * mr[e]; xk[e] = c_k + (p_k - c_k) * mk[e]; xv[e] = c_v + (p_v - c_v) * mv[e]; }
        { const f32x4 a0 = ia0, a1 = ia1, w0 = iw0, w1 = iw1;
#pragma unroll
          for (int e = 0; e < 4; ++e) { av[e] = a0[e]; av[4 + e] = a1[e]; wv[e] = w0[e]; wv[4 + e] = w1[e]; } } }
      CKIN_LOAD(i, next_task);
      float kmod[8], kk[8]; float n2 = 0.f, cbp = 0.f;
      { float ka_[8], kk_[8], rk_[8];
        { const f32x4 a0 = *(const LAS f32x4*)(PR + 192), a1 = *(const LAS f32x4*)(PR + 196), b0 = *(const LAS f32x4*)(PR + 256), b1 = *(const LAS f32x4*)(PR + 260), d0 = *(const LAS f32x4*)(PR + 320), d1 = *(const LAS f32x4*)(PR + 324);
#pragma unroll
          for (int e = 0; e < 4; ++e) { ka_[e] = a0[e]; ka_[4 + e] = a1[e]; kk_[e] = b0[e]; kk_[4 + e] = b1[e]; rk_[e] = d0[e]; rk_[4 + e] = d1[e]; } }
#pragma unroll
        for (int e = 0; e < 8; ++e) { kmod[e] = xk[e] * (1.0f + (av[e] - 1.0f) * ka_[e]); kk[e] = xk[e] * kk_[e]; n2 += kk[e] * kk[e]; cbp += xr[e] * kmod[e] * rk_[e]; } }
      const float inrm = 1.0f / fmaxf(sqrtf(red8(n2)), 1e-12f); const float cb = red8(cbp);
      if (jg == 0) CB[(size_t)m * 16 + h] = cb;
      { u32x4 o; o.x = pk2(xv[0], xv[1]); o.y = pk2(xv[2], xv[3]); o.z = pk2(xv[4], xv[5]); o.w = pk2(xv[6], xv[7]); *(u32x4*)(VVB + ((size_t)s * TP + 64 * c + t) * 64 + 8 * jg) = o; }
      float lw[8], lx[8];
#pragma unroll
      for (int e = 0; e < 8; ++e) { lw[e] = __log2f(wv[e]); lx[e] = lw[e]; }
#pragma unroll
      for (int e = 0; e < 8; ++e) lx[e] += __builtin_bit_cast(float, __builtin_amdgcn_update_dpp(0, __builtin_bit_cast(int, lx[e]), 0x118, 0xF, 0xF, true));
      { const int src2 = (jg + 8 * ((tl & 4) | 1)) << 2; const bool add2 = (tl & 2) != 0;
#pragma unroll
        for (int e = 0; e < 8; ++e) { const float y = __builtin_bit_cast(float, __builtin_amdgcn_ds_bpermute(src2, __builtin_bit_cast(int, lx[e]))); lx[e] += add2 ? y : 0.f; } }
      { const int src3 = (jg + 24) << 2; const bool add3 = (tl & 4) != 0;
#pragma unroll
        for (int e = 0; e < 8; ++e) { const float y = __builtin_bit_cast(float, __builtin_amdgcn_ds_bpermute(src3, __builtin_bit_cast(int, lx[e]))); lx[e] += add3 ? y : 0.f; } }
      LAS float* SEG = (LAS float*)(L + CK_GC + 256);
      if (tl == 7) { *(LAS f32x4*)(SEG + wave * 64 + 8 * jg) = (f32x4){lx[0], lx[1], lx[2], lx[3]}; *(LAS f32x4*)(SEG + wave * 64 + 8 * jg + 4) = (f32x4){lx[4], lx[5], lx[6], lx[7]}; }
      __syncthreads();
#pragma unroll
      for (int q = 0; q < 7; ++q) if (q < wave) { const f32x4 s0 = *(const LAS f32x4*)(SEG + q * 64 + 8 * jg), s1 = *(const LAS f32x4*)(SEG + q * 64 + 8 * jg + 4);
#pragma unroll
          for (int e = 0; e < 4; ++e) { lx[e] += s0[e]; lx[4 + e] += s1[e]; } }
      float ka[8], bt[8], kt[8], rt[8];
#pragma unroll
      for (int e = 0; e < 8; ++e) { const float lt = lx[e], lp = lt - lw[e];
          const float gt = __builtin_amdgcn_exp2f(lt), gp = __builtin_amdgcn_exp2f(lp), ig = __builtin_amdgcn_exp2f(-lt); const float kap = kk[e] * inrm;
          ka[e] = kap * gp; bt[e] = kap * av[e] * ig; kt[e] = kmod[e] * ig; rt[e] = xr[e] * gt; if (t == 63) GC[8 * jg + e] = gt; }
      { const int roff = t * 128 + ((jg ^ (t & 7)) << 4);
        u32x4 o; o.x = pk2(ka[0], ka[1]); o.y = pk2(ka[2], ka[3]); o.z = pk2(ka[4], ka[5]); o.w = pk2(ka[6], ka[7]); *(LAS u32x4*)(SLOT(0) + roff) = o;
        o.x = pk2(bt[0], bt[1]); o.y = pk2(bt[2], bt[3]); o.z = pk2(bt[4], bt[5]); o.w = pk2(bt[6], bt[7]); *(LAS u32x4*)(SLOT(1) + roff) = o;
        o.x = pk2(kt[0], kt[1]); o.y = pk2(kt[2], kt[3]); o.z = pk2(kt[4], kt[5]); o.w = pk2(kt[6], kt[7]); *(LAS u32x4*)(SLOT(2) + roff) = o;
        o.x = pk2(rt[0], rt[1]); o.y = pk2(rt[2], rt[3]); o.z = pk2(rt[4], rt[5]); o.w = pk2(rt[6], rt[7]); *(LAS u32x4*)(SLOT(3) + roff) = o;
        o.x = pk2(xv[0], xv[1]); o.y = pk2(xv[2], xv[3]); o.z = pk2(xv[4], xv[5]); o.w = pk2(xv[6], xv[7]); *(LAS u32x4*)(SLOT(15) + roff) = o; } }
    __syncthreads();
    f32x16 rtile = ck_zero();
    f32x16 aY = ck_zero(), aN = ck_zero();
    if (grp == 0) {
        { f32x16 a = ck_mm(SLOT(2), SLOT(0), mt, nt, ql, half, ck_zero());
#pragma unroll
          for (int r = 0; r < 16; ++r) { const int m = 32 * mt + ck_crow(r, half), n = 32 * nt + ql; a[r] = m < n ? a[r] : 0.f; }
          ck_store_t(SLOT(11), a, mt, nt, ql, half); }
        { f32x16 a = ck_mm(SLOT(2), SLOT(3), mt, nt, ql, half, ck_zero());
#pragma unroll
          for (int r = 0; r < 16; ++r) { const int m = 32 * mt + ck_crow(r, half), n = 32 * nt + ql; a[r] = m <= n ? a[r] : 0.f; }
          ck_store_t(SLOT(13), a, mt, nt, ql, half); }
        ck_tr(SLOT(0), SLOT(4), mt, nt, ql, half); ck_tr(SLOT(1), SLOT(5), mt, nt, ql, half); }
    else {
        { f32x16 a = ck_mm(SLOT(1), SLOT(0), mt, nt, ql, half, ck_zero());
#pragma unroll
          for (int r = 0; r < 16; ++r) { const int m = 32 * mt + ck_crow(r, half), n = 32 * nt + ql; a[r] = m < n ? -a[r] : 0.f; rtile[r] = a[r] + (m == n ? 1.0f : 0.f); }
          ck_store_t(SLOT(8), a, mt, nt, ql, half); ck_store_n(SLOT(9), a, mt, nt, ql, half); ck_store_t(SLOT(10), rtile, mt, nt, ql, half); }
        { f32x16 a = ck_mm(SLOT(1), SLOT(3), mt, nt, ql, half, ck_zero());
#pragma unroll
          for (int r = 0; r < 16; ++r) { const int m = 32 * mt + ck_crow(r, half), n = 32 * nt + ql; a[r] = m <= n ? a[r] : 0.f; }
          ck_store_t(SLOT(12), a, mt, nt, ql, half); }
        ck_tr(SLOT(2), SLOT(6), mt, nt, ql, half); ck_tr(SLOT(15), SLOT(7), mt, nt, ql, half); }
    __syncthreads();
#pragma unroll
    for (int lev = 1; lev <= 6; ++lev) {
        const int px = (lev & 1) ? 8 : 0, pxt = (lev & 1) ? 9 : 1, nx = (lev & 1) ? 0 : 8, nxt = (lev & 1) ? 1 : 9;
        const int rcur = (lev & 1) ? 2 : 10, rnxt = (lev & 1) ? 10 : 2;
        if (grp == 0) {
            if (lev <= 5) { const f32x16 a = ck_mm(SLOT(px), SLOT(pxt), mt, nt, ql, half, ck_zero());
                ck_store_t(SLOT(nxt), a, mt, nt, ql, half); ck_store_n(SLOT(nx), a, mt, nt, ql, half); }
            else aN = ck_mm(SLOT(6), SLOT(7), mt, nt, ql, half, ck_zero()); }
        else { if (lev == 1) { f32x16 a = ck_mm(SLOT(11), SLOT(7), mt, nt, ql, half, ck_zero()); ck_store_t(SLOT(14), a, mt, nt, ql, half);
                               aY = ck_mm(SLOT(7), SLOT(13), mt, nt, ql, half, ck_zero()); }
          if (lev >= 2) {
            const f32x16 a = ck_mm(SLOT(pxt), SLOT(rcur), mt, nt, ql, half, ck_zero());
#pragma unroll
            for (int r = 0; r < 16; ++r) rtile[r] += a[r];
            ck_store_t(SLOT(rnxt), rtile, mt, nt, ql, half); } }
        __syncthreads();
    }
    if (grp == 0) { f32x16 a = ck_mm(SLOT(2), SLOT(4), mt, nt, ql, half, ck_zero()); ck_store_t(SLOT(11), a, mt, nt, ql, half); }
    else { f32x16 a = ck_mm(SLOT(2), SLOT(14), mt, nt, ql, half, ck_zero()); ck_store_t(SLOT(15), a, mt, nt, ql, half); }
    __syncthreads();
    if (grp == 0) {
        { f32x16 a = ck_mm(SLOT(11), SLOT(5), mt, nt, ql, half, ck_zero());
          const int n = 32 * nt + ql; const float gc = GC[n];
#pragma unroll
          for (int r = 0; r < 16; ++r) { const int m = 32 * mt + ck_crow(r, half); a[r] = ((m == n ? 1.0f : 0.f) - a[r]) * gc; }
          ck_store_t(SLOT(8), a, mt, nt, ql, half); }
        { const f32x16 a2 = ck_mm(SLOT(5), SLOT(15), mt, nt, ql, half, ck_zero());
          unsigned char* N = outp + 16384 + (mt * 2 + nt) * 2048 + lane * 16; u32x4 w0, w1; unsigned pw[8];
#pragma unroll
          for (int g = 0; g < 4; ++g) { const int m0 = 32 * mt + 8 * g + 4 * half; float v[4];
#pragma unroll
              for (int e = 0; e < 4; ++e) v[e] = (aN[4 * g + e] - a2[4 * g + e]) * GC[m0 + e];
              pw[2 * g] = pk2(v[0], v[1]); pw[2 * g + 1] = pk2(v[2], v[3]); }
          w0 = (u32x4){pw[0], pw[1], pw[2], pw[3]}; w1 = (u32x4){pw[4], pw[5], pw[6], pw[7]}; *(u32x4*)N = w0; *(u32x4*)(N + 1024) = w1; } }
    else {
        { f32x16 a = ck_mm(SLOT(11), SLOT(12), mt, nt, ql, half, ck_zero());
          const int n = 32 * nt + ql;
#pragma unroll
          for (int g = 0; g < 4; ++g) { const int m0 = 32 * mt + 8 * g + 4 * half; const u32x2 rw = *(const LAS u32x2*)(SLOT(3) + n * 128 + (((m0 >> 3) ^ (n & 7)) << 4) + (m0 & 4) * 2);
              a[4 * g] = bflo(rw.x) - a[4 * g]; a[4 * g + 1] = bfhi(rw.x) - a[4 * g + 1]; a[4 * g + 2] = bflo(rw.y) - a[4 * g + 2]; a[4 * g + 3] = bfhi(rw.y) - a[4 * g + 3]; }
          ck_store_t(SLOT(9), a, mt, nt, ql, half); }
        { const f32x16 a2 = ck_mm(SLOT(15), SLOT(12), mt, nt, ql, half, ck_zero());
          unsigned char* Yl = outp + 24576 + (mt * 2 + nt) * 2048 + lane * 16; unsigned pw[8];
#pragma unroll
          for (int g = 0; g < 4; ++g) { pw[2 * g] = pk2(aY[4 * g] - a2[4 * g], aY[4 * g + 1] - a2[4 * g + 1]); pw[2 * g + 1] = pk2(aY[4 * g + 2] - a2[4 * g + 2], aY[4 * g + 3] - a2[4 * g + 3]); }
          *(u32x4*)Yl = (u32x4){pw[0], pw[1], pw[2], pw[3]}; *(u32x4*)(Yl + 1024) = (u32x4){pw[4], pw[5], pw[6], pw[7]}; } }
    __syncthreads();
    { const int row = tid >> 3, ch = tid & 7; const int off = row * 128 + ((ch ^ (row & 7)) << 4);
      *(u32x4*)(outp + tid * 16) = *(const LAS u32x4*)(SLOT(8) + off); *(u32x4*)(outp + 8192 + tid * 16) = *(const LAS u32x4*)(SLOT(9) + off); }
#undef SLOT
}
__device__ __forceinline__ void chunk_chain(const P& p, Frame& F, int s) {
    const int b = s >> 4, h = s & 15;
    bf16* YRAW = (bf16*)(p.ws + WS_YRAW);
    int tid = threadIdx.x; asm volatile("" : "+v"(tid));
    const int lane = tid & 63, wave = __builtin_amdgcn_readfirstlane(tid >> 6), ql = lane & 31, half = lane >> 5, grp = wave >> 2, mt = (wave >> 1) & 1, nt = wave & 1;
    LAS unsigned char* L = F.lds;
    __syncthreads();
    for (int i = tid; i < 2048; i += NTHR) ((LAS unsigned*)L)[i] = 0u;
    f32x16 sacc = ck_zero();
    const int n = 32 * nt + ql;
    const int noff = (grp == 0 ? 16384 : 24576) + (mt * 2 + nt) * 2048 + lane * 16;
    const unsigned char* base = p.ws + WS_CHK + (size_t)(s * 32) * CK_TASK_BYTES;
    u32x4 pmR[4], pqR[4], n0R[4], n1R[4];
#define CH_LOAD(slot, cc) do { const unsigned char* src_ = base + (size_t)(cc) * CK_TASK_BYTES; pmR[slot] = *(const u32x4*)(src_ + tid * 16); pqR[slot] = *(const u32x4*)(src_ + 8192 + tid * 16); \
        n0R[slot] = *(const u32x4*)(src_ + noff); n1R[slot] = *(const u32x4*)(src_ + noff + 1024); } while (0)
#pragma unroll
    for (int u = 0; u < 4; ++u) CH_LOAD(u, u);
    const int ioff = (tid >> 3) * 128 + (((tid & 7) ^ ((tid >> 3) & 7)) << 4);
    *(LAS u32x4*)(L + 2 * CK_SLOT + ioff) = pmR[0]; *(LAS u32x4*)(L + 4 * CK_SLOT + ioff) = pqR[0];
    __syncthreads();
    for (int c4 = 0; c4 < 32; c4 += 4) {
#pragma unroll
      for (int u = 0; u < 4; ++u) { const int c = c4 + u, cur = u & 1;
        f32x4 ad[4];
        { const u32x4 w0 = n0R[u], w1 = n1R[u];
          ad[0] = (f32x4){bflo(w0.x), bfhi(w0.x), bflo(w0.y), bfhi(w0.y)}; ad[1] = (f32x4){bflo(w0.z), bfhi(w0.z), bflo(w0.w), bfhi(w0.w)};
          ad[2] = (f32x4){bflo(w1.x), bfhi(w1.x), bflo(w1.y), bfhi(w1.y)}; ad[3] = (f32x4){bflo(w1.z), bfhi(w1.z), bflo(w1.w), bfhi(w1.w)}; }
        if (c + 4 < 32) CH_LOAD(u, c + 4);
        if (grp == 0) {
            sacc = ck_mm(L + (2 + cur) * CK_SLOT, L + cur * CK_SLOT, mt, nt, ql, half, ck_zero());
#pragma unroll
            for (int g = 0; g < 4; ++g)
#pragma unroll
                for (int e = 0; e < 4; ++e) sacc[4 * g + e] += ad[g][e];
            ck_store_t(L + (cur ^ 1) * CK_SLOT, sacc, mt, nt, ql, half);
        } else {
            const f32x16 a = ck_mm(L + cur * CK_SLOT, L + (4 + cur) * CK_SLOT, mt, nt, ql, half, ck_zero());
            bf16* yrow = YRAW + (size_t)(b * TP + 64 * c + n) * 1024 + h * 64;
#pragma unroll
            for (int g = 0; g < 4; ++g) { u32x2 w; w.x = pk2(a[4 * g] + ad[g][0], a[4 * g + 1] + ad[g][1]); w.y = pk2(a[4 * g + 2] + ad[g][2], a[4 * g + 3] + ad[g][3]);
                *(u32x2*)(yrow + 32 * mt + 8 * g + 4 * half) = w; } }
        if (c + 1 < 32) { *(LAS u32x4*)(L + (2 + (cur ^ 1)) * CK_SLOT + ioff) = pmR[(u + 1) & 3]; *(LAS u32x4*)(L + (4 + (cur ^ 1)) * CK_SLOT + ioff) = pqR[(u + 1) & 3]; }
        __syncthreads();
      }
    }
#undef CH_LOAD
    if (grp == 0) { float* So = p.out + O_RP + (size_t)s * 4096;
#pragma unroll
        for (int g = 0; g < 4; ++g) *(f32x4*)(So + n * 64 + 32 * mt + 8 * g + 4 * half) = (f32x4){sacc[4 * g], sacc[4 * g + 1], sacc[4 * g + 2], sacc[4 * g + 3]}; }
}
constexpr int CS_A = 160 * 128, CS_BUF = CS_A + 256 * 128;
__device__ __forceinline__ void cmp1_fused(const P& p, Frame& F) {
    const bf16* KVN = (const bf16*)(p.ws + WS_KVN); bf16* HID = (bf16*)(p.ws + WS_HID); const float* pe = p.in[I_PE]; const float* ckv = p.in[I_CKV]; const int* pt = (const int*)p.in[I_PT];
    int tid = threadIdx.x; asm volatile("" : "+v"(tid));
    const int lane = tid & 63, wave = __builtin_amdgcn_readfirstlane(tid >> 6), ql = lane & 31, half = lane >> 5, l16 = tid & 15, r32 = tid >> 4, p8 = tid & 7, r64 = tid >> 3;
    const bool pth = lane < 8; const int pr = wave, pp = lane & 7;
    LAS unsigned char* L = F.lds;
    __syncthreads();
    for (int unit = F.bid; unit < 256; unit += F.G) {
        const int kv = unit >> 7, blk = unit & 127;
        unsigned aoff[4];
#pragma unroll
        for (int j = 0; j < 4; ++j) { const int Rs = blk * 128 + r32 + 32 * j, b = Rs >> 9, n = (Rs >> 1) & 255, g = Rs & 1; const int page = pt[b * NPAGES + (n >> 2)];
            aoff[j] = (unsigned)(((page * PAGE + (n & 3) * 32) * 4 + kv) * 256 + g * 128 + 4 * l16); }
        unsigned poff = 0;
        if (pth) { const int R = blk * 8 + pr, b = R >> 7, n = (R >> 1) & 63, g = R & 1; poff = (unsigned)((b * TP + n * 32) * 1024 + kv * 256 + g * 128 + 8 * pp); }
        const bf16* W = (const bf16*)(p.ws + WS_CW1) + (size_t)kv * 256 * 4096 + (size_t)r64 * 4096 + 8 * p8;
        f32x16 acc[5];
#pragma unroll
        for (int mt = 0; mt < 5; ++mt) acc[mt] = ck_zero();
        for (int i = tid; i < 24 * 32; i += NTHR) { ((LAS unsigned*)(L + 136 * 128))[i] = 0u; ((LAS unsigned*)(L + CS_BUF + 136 * 128))[i] = 0u; }
        f32x4 ga[2][4], gp[2]; u32x4 gb[2][4], gq[2]; f32x4 gq0[2], gq1[2];
#define C1_LOAD(set, s_) do { const int pos_ = (s_) >> 1, dh_ = (s_) & 1; const unsigned ko_ = (unsigned)(pos_ * 1024 + dh_ * 64); \
            _Pragma("unroll") for (int j_ = 0; j_ < 4; ++j_) ga[set][j_] = __builtin_nontemporal_load((const f32x4*)(ckv + (aoff[j_] + ko_)));     \
            gp[set] = *(const f32x4*)(pe + (pos_ * 2 + kv) * 128 + dh_ * 64 + 4 * l16); \
            _Pragma("unroll") for (int j_ = 0; j_ < 4; ++j_) gb[set][j_] = *(const u32x4*)(W + (size_t)(64 * j_) * 4096 + (s_) * 64); \
            if (pth) { gq[set] = *(const u32x4*)(KVN + (poff + ko_)); const float* pq_ = pe + (pos_ * 2 + kv) * 128 + dh_ * 64 + 8 * pp; gq0[set] = *(const f32x4*)pq_; gq1[set] = *(const f32x4*)(pq_ + 4); } } while (0)
#define C1_PUT(set, buf_) do { LAS unsigned char* A_ = L + (buf_) * CS_BUF; LAS unsigned char* B_ = A_ + CS_A; \
            _Pragma("unroll") for (int j_ = 0; j_ < 4; ++j_) { const int rr_ = r32 + 32 * j_; const f32x4 v_ = ga[set][j_] + gp[set]; u32x2 w_; w_.x = pk2(v_.x, v_.y); w_.y = pk2(v_.z, v_.w); \
                *(LAS u32x2*)(A_ + rr_ * 128 + (((l16 >> 1) ^ (rr_ & 7)) << 4) + (l16 & 1) * 8) = w_; } \
            _Pragma("unroll") for (int j_ = 0; j_ < 4; ++j_) { const int nb_ = r64 + 64 * j_; *(LAS u32x4*)(B_ + nb_ * 128 + ((p8 ^ (nb_ & 7)) << 4)) = gb[set][j_]; } \
            if (pth) { const u32x4 q_ = gq[set]; const int rr_ = 128 + pr; \
                const f32x4 a_ = (f32x4){bflo(q_.x), bfhi(q_.x), bflo(q_.y), bfhi(q_.y)} + gq0[set], b_ = (f32x4){bflo(q_.z), bfhi(q_.z), bflo(q_.w), bfhi(q_.w)} + gq1[set]; \
                u32x4 o_; o_.x = pk2(a_.x, a_.y); o_.y = pk2(a_.z, a_.w); o_.z = pk2(b_.x, b_.y); o_.w = pk2(b_.z, b_.w); *(LAS u32x4*)(A_ + rr_ * 128 + ((pp ^ (rr_ & 7)) << 4)) = o_; } } while (0)
        C1_LOAD(0, 0); C1_LOAD(1, 1);
        __syncthreads();
        C1_PUT(0, 0); C1_LOAD(0, 2);
        __syncthreads();
#pragma nounroll
        for (int s2 = 0; s2 < 64; s2 += 2) {
#pragma unroll
            for (int u = 0; u < 2; ++u) { const int s = s2 + u;
                const LAS unsigned char* A_ = L + u * CS_BUF; const LAS unsigned char* B_ = A_ + CS_A; const int sw = ql & 7;
#pragma unroll
                for (int ks = 0; ks < 4; ++ks) { const int off = ((2 * ks + half) ^ sw) << 4; const bf16x8 bfr = *(const LAS bf16x8*)(B_ + (32 * wave + ql) * 128 + off);
#pragma unroll
                    for (int mt = 0; mt < 5; ++mt) { const bf16x8 afr = *(const LAS bf16x8*)(A_ + (32 * mt + ql) * 128 + off); acc[mt] = MFMA32(bfr, afr, acc[mt]); } }
                if (s + 1 < 64) C1_PUT(u ^ 1, u ^ 1);
                if (s + 3 < 64) C1_LOAD(u ^ 1, s + 3);
                __syncthreads();
            }
        }
#undef C1_LOAD
#undef C1_PUT
#pragma unroll
        for (int mt = 0; mt < 5; ++mt) { const int rl = 32 * mt + ql; if (rl < 136) { const size_t row = (size_t)kv * CMPROWS + (rl < 128 ? 1024 + blk * 128 + rl : blk * 8 + (rl - 128));
#pragma unroll
                for (int g = 0; g < 4; ++g) { u32x2 w; w.x = pk2(gelu_tanh(acc[mt][4 * g]), gelu_tanh(acc[mt][4 * g + 1])); w.y = pk2(gelu_tanh(acc[mt][4 * g + 2]), gelu_tanh(acc[mt][4 * g + 3]));
                    *(u32x2*)(HID + row * 256 + 32 * wave + 8 * g + 4 * half) = w; } } }
    }
}
#define PG8_ALIGN true
#define PG8_SP2 true
template <int LO, int HI> __global__ void __launch_bounds__(NTHR, 2) mega(P p) {
    extern __shared__ __attribute__((aligned(16))) unsigned char lds_[];
    Frame F; F.lds = (LAS unsigned char*)lds_; F.tid = threadIdx.x; F.lane = F.tid & 63; F.wave = __builtin_amdgcn_readfirstlane(F.tid >> 6); F.G = gridDim.x; F.bid = blockIdx.x;
    volatile LAS unsigned* MISC = (volatile LAS unsigned*)(F.lds + MISC_OFF);
    if (F.tid < 32) MISC[F.tid] = 0u;
    __syncthreads();
    unsigned char* ws = p.ws;
    constexpr bool fused = (HI - LO) > 1;
    XcdBarrier bar; bar.bar = (unsigned*)(ws + WS_CTL) + CW_BAR; bar.x = 0; bar.st = MISC + 8;
    if (fused) bar = xcd_barrier_post((unsigned*)(ws + WS_CTL) + CW_BAR, MISC + 8);
#define IN(k) (LO <= (k) && (k) < HI)
#define SEAM(k) do { if (IN(k) && IN((k) + 1)) xcd_barrier(bar); { int t_ = threadIdx.x; asm volatile("" : "+v"(t_)); F.tid = t_; F.lane = t_ & 63; F.wave = __builtin_amdgcn_readfirstlane(t_ >> 6); } } while (0)
    bf16* H = (bf16*)(ws + WS_H); bf16* ACT = (bf16*)(ws + WS_ACT); bf16* FB = (bf16*)(ws + WS_F); bf16* X1 = (bf16*)(ws + WS_X1);

    if (IN(0)) { p0_prologue(p, F); }
    SEAM(0);
    if (IN(1)) {
        pg8::Gemm g{H, (const bf16*)(ws + WS_W13A), MP, 2 * DFF, D}; pg8::StaticOrder S; S.init(MP, 2 * DFF, F.G, F.bid);
        EpiSwiglu E{ACT};
        pg8::gemm_phase<EpiSwiglu, pg8::StaticOrder, PG8_ALIGN, PG8_SP2>(F.lds + RING_OFF, g, S, E);
        skinny_gemm<32, 2, 2>(F, H + (size_t)MP * D, D, (const bf16*)(ws + WS_W13A), DFF / 32, SkSwiglu{ACT});
    }
    SEAM(1);
    if (IN(2)) {
        pg8::Gemm g{ACT, (const bf16*)(ws + WS_W2A), MP, D, DFF}; pg8::StaticOrder S; S.init(MP, D, F.G, F.bid);
        EpiStore E{FB, D};
        pg8::gemm_phase<EpiStore, pg8::StaticOrder, PG8_ALIGN, PG8_SP2>(F.lds + RING_OFF, g, S, E);
        skinny_gemm2d<8>(F, ACT + (size_t)MP * DFF, DFF, (const bf16*)(ws + WS_W2A), SkStore{FB, D});
    }
    SEAM(2);
    if (IN(3)) { thin_phase<false, true>(F, FB, p.in[I_XP], p.in[I_XS], p.in[I_F1POST], 0.5f, X1, p.in[I_MIXPRE], H); }
    SEAM(3);
    if (IN(4)) {
        pg8::Gemm g{H, (const bf16*)(ws + WS_WINT), MP, NPADW, D}; pg8::StaticOrder S; S.init(MP, NPADW, F.G, F.bid);
        EpiWin E{(bf16*)(ws + WS_PRW), (bf16*)(ws + WS_Q), (bf16*)(ws + WS_KVN), (bf16*)(ws + WS_WINN), (bf16*)(ws + WS_GRW), (bf16*)(ws + WS_GNSA), (float*)(ws + WS_NG), p.out};
        pg8::gemm_phase<EpiWin, pg8::StaticOrder, PG8_ALIGN, PG8_SP2>(F.lds + RING_OFF, g, S, E);
        skinny_gemm<40, 1, 3>(F, H + (size_t)MP * D, D, (const bf16*)(ws + WS_WINT), NPADW / 40, SkWin{E.PRW, E.Q, E.KVN, E.WINN, E.GRW, E.GNSA, E.NG, E.out});
    }
    SEAM(4);
    if (IN(5)) { lora_prep(p, F); }
    SEAM(5);
    if (IN(6)) {
#pragma nounroll
        for (int half_ = 0; half_ < 2; ++half_) {
            if ((half_ ^ (F.bid & 1)) == 0) {
                { int kl = 256; asm volatile("" : "+s"(kl));
                  pg8::Gemm g{(const bf16*)(ws + WS_ALORA), (const bf16*)(ws + WS_WLORA), MP, 3072, kl}; pg8::StaticOrder S; S.init(MP, 3072, F.G, F.bid);
                  EpiLora E{(float*)(ws + WS_DEC), (float*)(ws + WS_AA), (float*)(ws + WS_GG), p.in[I_W0], p.in[I_A0]};
                  pg8::gemm_phase<EpiLora, pg8::StaticOrder, PG8_ALIGN, PG8_SP2>(F.lds + RING_OFF, g, S, E);
                  skinny_gemm<12, 1, 2>(F, (const bf16*)(ws + WS_ALORA) + (size_t)MP * 256, kl, (const bf16*)(ws + WS_WLORA), 3072 / 12, SkLora{E.DEC, E.AA, E.GG, E.w0, E.a0}); }
                vt_build(p, F, F.bid, F.G);
            } else cmp1_fused(p, F);
            __syncthreads();
        }
    }
    SEAM(6);
    if (IN(7)) {
        { pg8::Gemm g{(const bf16*)(ws + WS_HID), (const bf16*)(ws + WS_CW2), 2 * CMPROWS, 512, 256}; DiagOrder S{F.G, F.bid};
          EpiCmp2 E{(float*)(ws + WS_KC)};
          pg8::gemm_phase<EpiCmp2, DiagOrder, PG8_ALIGN, PG8_SP2>(F.lds + RING_OFF, g, S, E); }
        __syncthreads();
        scan_prep(p, F);
        if (F.bid < NSEQ_P * 32) {
            CKIN_DECL(i); CKIN_LOAD(i, F.bid); int ptag0 = -1, ptag1 = -1;
            __syncthreads();
            for (int task = F.bid; task < NSEQ_P * 32; task += F.G) chunk_pre(p, F, task, task + F.G < NSEQ_P * 32 ? task + F.G : task, icr, ick, icv, ipr, ipk, ipv, ia0, ia1, iw0, iw1, ptag0, ptag1); }
    }
    SEAM(7);
    if (IN(8)) {
        if (F.G >= 256) { if (F.bid < NSEQ_P) chunk_chain(p, F, F.bid); else scan_sample(p, F, F.bid - NSEQ_P, F.G - NSEQ_P); }
        else { for (int s = F.bid; s < NSEQ_P; s += F.G) chunk_chain(p, F, s); scan_sample(p, F, F.bid, F.G); }
        __syncthreads();
        { unsigned* qctr = (unsigned*)(ws + WS_CTL) + 8192;
#pragma nounroll
          for (;;) {
              if (F.tid == 0) MISC[0] = __hip_atomic_fetch_add(qctr, 1u, __ATOMIC_RELAXED, __HIP_MEMORY_SCOPE_AGENT);
              __syncthreads();
              const int k = (int)MISC[0];
              __syncthreads();
              constexpr int NATT = 576, NCONV = (TR_NLATE + 15) / 16;
              if (k >= NATT + NCONV) break;
              int ia = -1, ic = -1;
              if (k < 2 * NATT) { if (k & 1) ic = k >> 1; else ia = k >> 1; } else ic = k - NATT;
              if (ic >= 0) { tr_late_batch(p, F, ic); continue; }
              const bool is_s = ia < 64; const int kk = is_s ? ia : ia - 64;
              attn_item(p, F, is_s, is_s ? kk >> 1 : (kk & 15) >> 1, kk & 1, is_s ? 0 : 31 - (kk >> 4)); } }
    }
    SEAM(8);
    if (IN(9)) { rwkv_post(p, F); }
    SEAM(9);
    if (IN(10)) {
        pg8::Gemm g{(const bf16*)(ws + WS_YRW), (const bf16*)(ws + WS_WBRW), MP, D, 1024}; pg8::StaticOrder S; S.init(MP, D, F.G, F.bid);
        EpiMerge<0> E{(const bf16*)(ws + WS_GRW), (bf16*)(ws + WS_MRG), (bf16*)(ws + WS_PARK)};
        pg8::gemm_phase<EpiMerge<0>, pg8::StaticOrder, PG8_ALIGN, PG8_SP2>(F.lds + RING_OFF, g, S, E);
        skinny_gemm2d<8>(F, (const bf16*)(ws + WS_YRW) + (size_t)MP * 1024, 1024, (const bf16*)(ws + WS_WBRW), SkMerge<0>{E.GATE, E.MRG});
        __syncthreads();
    }
    if (IN(10)) {
        pg8::Gemm g{(const bf16*)(ws + WS_YNSA), (const bf16*)(ws + WS_WBNSA), MP, D, 1024}; pg8::StaticOrder S; S.init(MP, D, F.G, F.bid);
        EpiMerge<1> E{(const bf16*)(ws + WS_GNSA), (bf16*)(ws + WS_MRG), (bf16*)(ws + WS_PARK)};
        pg8::gemm_phase<EpiMerge<1>, pg8::StaticOrder, PG8_ALIGN, PG8_SP2>(F.lds + RING_OFF, g, S, E);
        skinny_gemm2d<8>(F, (const bf16*)(ws + WS_YNSA) + (size_t)MP * 1024, 1024, (const bf16*)(ws + WS_WBNSA), SkMerge<1>{E.GATE, E.MRG});
    }
    SEAM(11);
    if (IN(12)) {
        pg8::Gemm g{(const bf16*)(ws + WS_MRG), (const bf16*)(ws + WS_WOUT), MP, D, D}; pg8::StaticOrder S; S.init(MP, D, F.G, F.bid);
        EpiStore E{FB, D};
        pg8::gemm_phase<EpiStore, pg8::StaticOrder, PG8_ALIGN, PG8_SP2>(F.lds + RING_OFF, g, S, E);
        skinny_gemm2d<8>(F, (const bf16*)(ws + WS_MRG) + (size_t)MP * D, D, (const bf16*)(ws + WS_WOUT), SkStore{FB, D});
    }
    SEAM(12);
    if (IN(13)) { thin_phase<true, true>(F, FB, X1, X1 + (size_t)MP * D, p.in[I_MIXPOST], 1.0f, X1, p.in[I_F2PRE], H); }
    SEAM(13);
    if (IN(14)) {
        pg8::Gemm g{H, (const bf16*)(ws + WS_W13B), MP, 2 * DFF, D}; pg8::StaticOrder S; S.init(MP, 2 * DFF, F.G, F.bid);
        EpiSwiglu E{ACT};
        pg8::gemm_phase<EpiSwiglu, pg8::StaticOrder, PG8_ALIGN, PG8_SP2>(F.lds + RING_OFF, g, S, E);
        skinny_gemm<32, 2, 2>(F, H + (size_t)MP * D, D, (const bf16*)(ws + WS_W13B), DFF / 32, SkSwiglu{ACT});
    }
    SEAM(14);
    if (IN(15)) {
        pg8::Gemm g{ACT, (const bf16*)(ws + WS_W2B), MP, D, DFF}; pg8::StaticOrder S; S.init(MP, D, F.G, F.bid);
        EpiStore E{FB, D};
        pg8::gemm_phase<EpiStore, pg8::StaticOrder, PG8_ALIGN, PG8_SP2>(F.lds + RING_OFF, g, S, E);
        skinny_gemm2d<8>(F, ACT + (size_t)MP * DFF, DFF, (const bf16*)(ws + WS_W2B), SkStore{FB, D});
    }
    SEAM(15);
    if (IN(16)) { thin_phase<true, false>(F, FB, X1, X1 + (size_t)MP * D, p.in[I_F2POST], 0.5f, p.out + O_Y, nullptr, nullptr); }
#undef IN
#undef SEAM
}
constexpr int NPHASES = 17;

template <int K> struct PhaseLaunch {
    static bool setup() { if (hipFuncSetAttribute((const void*)mega<K, K + 1>, hipFuncAttributeMaxDynamicSharedMemorySize, LDS_BYTES) != hipSuccess) return false; return PhaseLaunch<K + 1>::setup(); }
    static void run(const P& p, int grid, hipStream_t stream) { hipLaunchKernelGGL((mega<K, K + 1>), dim3(grid), dim3(NTHR), LDS_BYTES, stream, p); PhaseLaunch<K + 1>::run(p, grid, stream); }
};
template <> struct PhaseLaunch<NPHASES> { static bool setup() { return true; } static void run(const P&, int, hipStream_t) {} };
static bool setup_all() {
#if MK_FUSED
    return hipFuncSetAttribute((const void*)mega<0, NPHASES>, hipFuncAttributeMaxDynamicSharedMemorySize, LDS_BYTES) == hipSuccess;
#else
    return PhaseLaunch<0>::setup();
#endif
}
static void launch_all(const P& p, int grid, hipStream_t stream) {
#if !MK_FUSED
    PhaseLaunch<0>::run(p, grid, stream);
#endif
}
extern "C" void kernel_launch(void* const* d_in, const int* in_sizes, int n_in, void* d_out, int out_size, void* d_ws, size_t ws_size, hipStream_t stream) {
    static int grid = 0;
    if (grid == 0) {
        if (n_in != 38 || out_size != (int)O_END || ws_size < WS_END) { fprintf(stderr, "kernel_launch: unexpected shapes: n_in %d out %d ws %zu (need %zu)\n", n_in, out_size, ws_size, (size_t)WS_END); grid = -1; return; }
        int dev = 0, cus = 0, per_cu = 0;
        if (hipGetDevice(&dev) != hipSuccess || hipDeviceGetAttribute(&cus, hipDeviceAttributeMultiprocessorCount, dev) != hipSuccess) { grid = -1; return; }
        if (!setup_all()) { fprintf(stderr, "kernel_launch: hipFuncSetAttribute failed\n"); grid = -1; return; }
        grid = cus;
    }
    if (grid < 0) return;
    (void)hipMemsetAsync((char*)d_ws + WS_CTL, 0, CTL_BYTES, stream);
    P p{};
    for (int i = 0; i < 38; ++i) p.in[i] = (const float*)d_in[i];
    p.out = (float*)d_out; p.ws = (unsigned char*)d_ws;
#if MK_FUSED
    hipLaunchKernelGGL((mega<0, NPHASES>), dim3(grid), dim3(NTHR), LDS_BYTES, stream, p);
#else
    launch_all(p, grid, stream);
#endif
}
```
